# Optimizing an MI355X kernel written in HIP

```python
import math
import jax
import jax.numpy as jnp
from jax import lax
import numpy as np

D_MODEL = 2048
BATCH = 8
SEQ = 2048
DEPTH = 2

GRID_W = 64
CTX_LEN = 256
EPS = 1e-6
N_SUB = 3
N_MOD = 3 * N_SUB
D_FF = 5632
MIX_WIDTH = D_MODEL
S5_WIDTH = D_MODEL // 2
S5_GROUP = 16
S5_GROUPS = S5_WIDTH // S5_GROUP
S5_STATE = 64
NA_HEADS = 8
NA_HEAD_DIM = 128
NA_WIDTH = NA_HEADS * NA_HEAD_DIM
NA_KH_MAX = 8
NA_KW = 16
EVEN_IN = S5_WIDTH + 3 * NA_WIDTH
HY_WIDTH = D_MODEL // 2
HY_ORDER = 2
HY_SHORT = 3
HY_BANDS = 16
HY_EMB = 1 + 2 * HY_BANDS
HY_HIDDEN = 64
HY_N_MID = 2
HY_DECAY_TARGET = 1e-2
HY_FAST_PCT = 0.3
HY_SLOW_PCT = 1.5
HY_FILTER_STD = 0.007
SSD_INNER = D_MODEL // 2
SSD_HEAD_DIM = 64
SSD_HEADS = SSD_INNER // SSD_HEAD_DIM
SSD_GROUPS = 4
SSD_STATE = 128
SSD_CONV = 3
SSD_CHUNK = 128
SSD_BC = SSD_GROUPS * SSD_STATE
SSD_XBC = SSD_INNER + 2 * SSD_BC
ODD_IN = 3 * HY_WIDTH + SSD_INNER + SSD_XBC + 2 * SSD_HEADS
F32 = jnp.float32

kernel_name = 'hybrid_s5_natten_hyena_ssd_prefix_dit'


def _rmsnorm(x, g):
    xf = x.astype(F32)
    y = xf * lax.rsqrt(jnp.mean(xf * xf, axis=-1, keepdims=True) + EPS)
    return (y * g.astype(F32)).astype(x.dtype)


def _pre(h, g, m, i):
    return _rmsnorm(h, g) * (1 + m[:, 3 * i + 1]) + m[:, 3 * i]


def _swiglu(h, wg, wu, wd):
    return (jax.nn.silu(h @ wg) * (h @ wu)) @ wd


def _dwconv(u, w, b):
    k = w.shape[0]
    y = lax.conv_general_dilated(u, w[:, None, :].astype(u.dtype), (1,), [(k // 2, k // 2)],
                                 dimension_numbers=('NWC', 'WIO', 'NWC'),
                                 feature_group_count=u.shape[-1])
    return y + b.astype(u.dtype)


def _lin_combine(left, right):
    a_l, b_l = left
    a_r, b_r = right
    return a_l * a_r, a_r * b_l + b_r


def _s5_discretize(a_re, a_im, log_dt, b_re, b_im):
    lam = lax.complex(a_re.astype(F32), a_im.astype(F32))
    dt = jnp.exp(log_dt.astype(F32))[:, None]
    a_bar = jnp.exp(lam * dt)
    b_bar = ((a_bar - 1.0) / lam)[..., None] * lax.complex(b_re.astype(F32), b_im.astype(F32))
    return a_bar, b_bar


def _s5_scan(u, a_bar, b_bar, s0, reverse):
    if reverse:
        u = jnp.flip(u, 1)
    bu = jnp.einsum('gph,blgh->blgp', b_bar, u.astype(jnp.complex64))
    if s0 is not None:
        bu = bu.at[:, 0].add(a_bar * s0)
    a = jnp.broadcast_to(a_bar, (1,) + bu.shape[1:])
    _, s = lax.associative_scan(_lin_combine, (a, bu), axis=1)
    final = s[:, -1]
    if reverse:
        s = jnp.flip(s, 1)
    return s, final


def _s5_readout(c_mat, s):
    return jnp.einsum('ghp,blgp->blgh', c_mat, s).real


def _s5_mixer(uc, ul, a_re, a_im, log_dt, b_re, b_im, c_re, c_im, d, glu_w, glu_b, ctx_out):
    def grp(u):
        return u.astype(F32).reshape(u.shape[0], u.shape[1], S5_GROUPS, S5_GROUP)
    uc, ul = grp(uc), grp(ul)
    d = d.astype(F32)
    yl = d * ul
    yc = d * uc if ctx_out else None
    for k, rev in ((0, False), (1, True)):
        a_bar, b_bar = _s5_discretize(a_re[k], a_im[k], log_dt[k], b_re[k], b_im[k])
        c_mat = lax.complex(c_re[k].astype(F32), c_im[k].astype(F32))
        sc, fin = _s5_scan(uc, a_bar, b_bar, None, rev)
        sl, _ = _s5_scan(ul, a_bar, b_bar, fin, rev)
        yl = yl + _s5_readout(c_mat, sl)
        if ctx_out:
            yc = yc + _s5_readout(c_mat, sc)

    def glu(y):
        y = jax.nn.gelu(y.reshape(y.shape[0], y.shape[1], S5_WIDTH))
        return y * jax.nn.sigmoid(y @ glu_w.astype(F32) + glu_b.astype(F32))
    return (glu(yc) if ctx_out else None), glu(yl)


def _split_qkv(p):
    qkv = p[..., S5_WIDTH:].reshape(p.shape[0], p.shape[1], 3, NA_HEADS, NA_HEAD_DIM)
    return qkv[:, :, 0], qkv[:, :, 1], qkv[:, :, 2]


def _na_latent(q, k, v, kc, vc, rpb):
    bsz, length, heads, hd = q.shape
    rows = length // GRID_W
    kh = min(NA_KH_MAX, rows)
    scale = hd ** -0.5
    qg = q.reshape(bsz, rows, GRID_W, heads, hd)
    kg = k.reshape(bsz, rows, GRID_W, heads, hd)
    vg = v.reshape(bsz, rows, GRID_W, heads, hd)
    col = jnp.arange(GRID_W)
    cs = jnp.clip(col - NA_KW // 2, 0, GRID_W - NA_KW)
    col_mask = (col[None, :] >= cs[:, None]) & (col[None, :] < cs[:, None] + NA_KW)
    dc_idx = jnp.clip(col[None, :] - col[:, None] + NA_KW - 1, 0, 2 * NA_KW - 2)
    rpb_c = rpb.astype(F32)[:, :, dc_idx]
    n_loc = kh * GRID_W

    def row_block(r):
        rs = jnp.clip(r - kh // 2, 0, rows - kh)
        qr = lax.dynamic_index_in_dim(qg, r, axis=1, keepdims=False)
        kr = lax.dynamic_slice_in_dim(kg, rs, kh, axis=1)
        vr = lax.dynamic_slice_in_dim(vg, rs, kh, axis=1)
        dr_idx = rs + jnp.arange(kh) - r + NA_KH_MAX - 1
        bias = jnp.transpose(rpb_c[:, dr_idx], (0, 2, 1, 3))
        s_loc = jnp.einsum('bqhd,bjkhd->bhqjk', qr, kr).astype(F32) * scale + bias[None]
        s_loc = jnp.where(col_mask[None, None, :, None, :], s_loc, -jnp.inf)
        s_ctx = jnp.einsum('bqhd,bchd->bhqc', qr, kc).astype(F32) * scale
        p = jax.nn.softmax(jnp.concatenate([s_loc.reshape(bsz, heads, GRID_W, n_loc), s_ctx], -1), axis=-1)
        p_loc = p[..., :n_loc].reshape(bsz, heads, GRID_W, kh, GRID_W).astype(v.dtype)
        p_ctx = p[..., n_loc:].astype(v.dtype)
        return (jnp.einsum('bhqjk,bjkhd->bqhd', p_loc, vr)
                + jnp.einsum('bhqc,bchd->bqhd', p_ctx, vc))

    out = lax.map(row_block, jnp.arange(rows))
    return jnp.transpose(out, (1, 0, 2, 3, 4)).reshape(bsz, length, heads * hd)


def _attend_dense(q, k, v):
    s = jnp.einsum('bqhd,bkhd->bhqk', q, k).astype(F32) * q.shape[-1] ** -0.5
    p = jax.nn.softmax(s, axis=-1).astype(v.dtype)
    return jnp.einsum('bhqk,bkhd->bqhd', p, v).reshape(q.shape[0], q.shape[1], -1)


def _even_mixer(hc, hl, w_in, w_out, s5_params, rpb, ctx_out):
    pc = hc @ w_in
    pl = hl @ w_in
    s5_c, s5_l = _s5_mixer(pc[..., :S5_WIDTH], pl[..., :S5_WIDTH], *s5_params, ctx_out)
    qc, kc, vc = _split_qkv(pc)
    ql, kl, vl = _split_qkv(pl)
    yl = jnp.concatenate([s5_l, _na_latent(ql, kl, vl, kc, vc, rpb)], axis=-1) @ w_out
    if not ctx_out:
        return None, yl
    yc = jnp.concatenate([s5_c, _attend_dense(qc, kc, vc)], axis=-1) @ w_out
    return yc, yl


def _hyena_filters(length, w_in, b_in, w_mid, b_mid, w_out, freq):
    t = jnp.linspace(0.0, 1.0, length, dtype=F32)[:, None]
    w = 2.0 * math.pi * jnp.arange(length, dtype=F32)[:, None] / length
    f = jnp.linspace(1e-4, HY_BANDS - 1, HY_BANDS, dtype=F32)[None, :]
    z = jnp.concatenate([t, jnp.cos(f * w), -jnp.sin(f * w)], axis=-1)
    freq = freq.astype(F32)
    h = jnp.sin(freq * (z @ w_in.astype(F32) + b_in.astype(F32)))
    for i in range(HY_N_MID):
        h = jnp.sin(freq * (h @ w_mid[i].astype(F32) + b_mid[i].astype(F32)))
    h = (h @ w_out.astype(F32)).reshape(length, HY_ORDER, 2, HY_WIDTH)
    max_decay = math.log(HY_DECAY_TARGET) / HY_FAST_PCT
    min_decay = math.log(HY_DECAY_TARGET) / HY_SLOW_PCT
    deltas = jnp.abs(jnp.linspace(min_decay, max_decay, HY_WIDTH, dtype=F32))
    decay = jnp.exp(-t * deltas[None, :])
    return h * decay[:, None, None, :]


def _bidir_fftconv(u, h_fwd, h_bwd, bias):
    length, ch = h_fwd.shape
    n = 2 * length
    k = jnp.concatenate([h_fwd, jnp.zeros((1, ch), F32), jnp.flip(h_bwd[1:], 0)], axis=0)
    uf = jnp.fft.rfft(u.astype(F32), n=n, axis=1)
    kf = jnp.fft.rfft(k, n=n, axis=0)
    y = jnp.fft.irfft(uf * kf[None], n=n, axis=1)[:, :length]
    return y + u.astype(F32) * bias.astype(F32)


def _hyena(p, short_w, short_b, w_in, b_in, w_mid, b_mid, w_out, freq, fbias):
    x1, x2, v = jnp.split(_dwconv(p, short_w, short_b).astype(F32), 3, axis=-1)
    h = _hyena_filters(p.shape[1], w_in, b_in, w_mid, b_mid, w_out, freq)
    z = x1 * _bidir_fftconv(v, h[:, 0, 0], h[:, 0, 1], fbias[0])
    return x2 * _bidir_fftconv(z, h[:, 1, 0], h[:, 1, 1], fbias[1])


def _ssd_chunked(x, dt, a, b, c, s0, with_output):
    bsz, length = x.shape[:2]
    q = min(SSD_CHUNK, length)
    nc = length // q
    e = SSD_HEADS // SSD_GROUPS
    xdt = (x * dt[..., None]).reshape(bsz, nc, q, SSD_GROUPS, e, SSD_HEAD_DIM)
    cum = jnp.cumsum((dt * a).reshape(bsz, nc, q, SSD_GROUPS, e), axis=2)
    bq = b.reshape(bsz, nc, q, SSD_GROUPS, SSD_STATE)
    xdt_w = xdt * jnp.exp(cum[:, :, -1:] - cum)[..., None]
    states = jnp.einsum('bcsgn,bcsgep->bcgepn', bq, xdt_w)
    chunk_decay = jnp.exp(cum[:, :, -1])
    if s0 is None:
        s0 = jnp.zeros((bsz, SSD_GROUPS, e, SSD_HEAD_DIM, SSD_STATE), F32)

    def step(s, inp):
        st, dec = inp
        return s * dec[..., None, None] + st, s
    s_final, s_prev = lax.scan(step, s0, (jnp.moveaxis(states, 1, 0), jnp.moveaxis(chunk_decay, 1, 0)))
    if not with_output:
        return None, s_final
    cq = c.reshape(bsz, nc, q, SSD_GROUPS, SSD_STATE)
    seg = cum[:, :, :, None] - cum[:, :, None, :]
    tri = jnp.tril(jnp.ones((q, q), bool))[None, None, :, :, None, None]
    lmat = jnp.exp(jnp.where(tri, seg, -jnp.inf))
    cb = jnp.einsum('bclgn,bcsgn->bclsg', cq, bq)
    y_diag = jnp.einsum('bclsge,bcsgep->bclgep', cb[..., None] * lmat, xdt)
    y_off = jnp.einsum('bclgn,cbgepn->bclgep', cq, s_prev) * jnp.exp(cum)[..., None]
    return (y_diag + y_off).reshape(bsz, length, SSD_HEADS, SSD_HEAD_DIM), s_final


def _ssd_bidir(xbc, dt_raw, dt_bias, a_log, s0, with_output):
    bsz, length = xbc.shape[:2]
    xbc = xbc.astype(F32)
    xs = xbc[..., :SSD_INNER].reshape(bsz, length, SSD_HEADS, SSD_HEAD_DIM)
    bm = xbc[..., SSD_INNER:SSD_INNER + SSD_BC].reshape(bsz, length, SSD_GROUPS, SSD_STATE)
    cm = xbc[..., SSD_INNER + SSD_BC:].reshape(bsz, length, SSD_GROUPS, SSD_STATE)
    ys, finals = [], []
    for k in range(2):
        dt = jax.nn.softplus(dt_raw[..., k * SSD_HEADS:(k + 1) * SSD_HEADS].astype(F32) + dt_bias[k].astype(F32))
        a = -jnp.exp(a_log[k].astype(F32))
        seq = (xs, dt, bm, cm)
        if k == 1:
            seq = tuple(jnp.flip(s, 1) for s in seq)
        y, fin = _ssd_chunked(seq[0], seq[1], a, seq[2], seq[3], None if s0 is None else s0[k], with_output)
        if with_output:
            ys.append(jnp.flip(y, 1) if k == 1 else y)
        finals.append(fin)
    return ys, xs, finals


def _odd_mixer(hc, hl, w_in, w_out, hy_params, conv_w, conv_b, dt_bias, a_log, d_skip, norm_g, ctx_out):
    o_z = 3 * HY_WIDTH
    o_xbc = o_z + SSD_INNER
    o_dt = o_xbc + SSD_XBC
    pc = hc @ w_in
    pl = hl @ w_in
    xbc_c = jax.nn.silu(_dwconv(pc[..., o_xbc:o_dt], conv_w, conv_b))
    xbc_l = jax.nn.silu(_dwconv(pl[..., o_xbc:o_dt], conv_w, conv_b))
    ys_c, xs_c, fin_c = _ssd_bidir(xbc_c, pc[..., o_dt:], dt_bias, a_log, None, ctx_out)
    ys_l, xs_l, _ = _ssd_bidir(xbc_l, pl[..., o_dt:], dt_bias, a_log, fin_c, True)

    def ssd_out(p, ys, xs):
        y = ys[0] + ys[1] + d_skip.astype(F32)[:, None] * xs
        y = y.reshape(xs.shape[0], xs.shape[1], SSD_INNER) * jax.nn.silu(p[..., o_z:o_xbc].astype(F32))
        return _rmsnorm(y, norm_g)

    yl = jnp.concatenate([_hyena(pl[..., :o_z], *hy_params), ssd_out(pl, ys_l, xs_l)], axis=-1) @ w_out
    if not ctx_out:
        return None, yl
    yc = jnp.concatenate([_hyena(pc[..., :o_z], *hy_params), ssd_out(pc, ys_c, xs_c)], axis=-1) @ w_out
    return yc, yl


def setup_inputs(seed: int = 0) -> dict:
    key = jax.random.key(seed)
    keys = jax.random.split(key, 48)
    it = iter(range(48))

    def nrm(shape, std):
        return std * jax.random.normal(keys[next(it)], shape, F32)

    def unif(shape, lo, hi):
        return jax.random.uniform(keys[next(it)], shape, F32, lo, hi)

    ne, no = (DEPTH + 1) // 2, DEPTH // 2
    dt0 = jnp.exp(unif((no, 2, SSD_HEADS), math.log(1e-3), math.log(1e-1)))
    return {
        'x': nrm((BATCH, SEQ, D_MODEL), 1.0),
        'c': nrm((BATCH, D_MODEL), 1.0),
        'ctx': nrm((BATCH, CTX_LEN, D_MODEL), 1.0),
        'c_ctx': nrm((D_MODEL,), 1.0),
        'mod_w': nrm((DEPTH, D_MODEL, N_MOD * D_MODEL), 0.5 * D_MODEL ** -0.5),
        'mod_b': nrm((DEPTH, N_MOD * D_MODEL), 0.02),
        'norm_g': 1.0 + nrm((DEPTH, N_SUB, D_MODEL), 0.02),
        'ffn_wg': nrm((DEPTH, 2, D_MODEL, D_FF), D_MODEL ** -0.5),
        'ffn_wu': nrm((DEPTH, 2, D_MODEL, D_FF), D_MODEL ** -0.5),
        'ffn_wd': nrm((DEPTH, 2, D_FF, D_MODEL), D_FF ** -0.5),
        'final_g': 1.0 + nrm((D_MODEL,), 0.02),
        'ev_w_in': nrm((ne, D_MODEL, EVEN_IN), D_MODEL ** -0.5),
        'ev_w_out': nrm((ne, MIX_WIDTH, D_MODEL), MIX_WIDTH ** -0.5),
        's5_a_re': -0.5 + nrm((ne, 2, S5_GROUPS, S5_STATE), 0.01),
        's5_a_im': math.pi * jnp.arange(S5_STATE, dtype=F32) + nrm((ne, 2, S5_GROUPS, S5_STATE), 0.01),
        's5_log_dt': unif((ne, 2, S5_GROUPS), math.log(1e-3), math.log(1e-1)),
        's5_b_re': nrm((ne, 2, S5_GROUPS, S5_STATE, S5_GROUP), (2 * S5_GROUP) ** -0.5),
        's5_b_im': nrm((ne, 2, S5_GROUPS, S5_STATE, S5_GROUP), (2 * S5_GROUP) ** -0.5),
        's5_c_re': nrm((ne, 2, S5_GROUPS, S5_GROUP, S5_STATE), S5_STATE ** -0.5),
        's5_c_im': nrm((ne, 2, S5_GROUPS, S5_GROUP, S5_STATE), S5_STATE ** -0.5),
        's5_d': nrm((ne, S5_GROUPS, S5_GROUP), 1.0),
        's5_glu_w': nrm((ne, S5_WIDTH, S5_WIDTH), S5_WIDTH ** -0.5),
        's5_glu_b': nrm((ne, S5_WIDTH), 0.02),
        'na_rpb': nrm((ne, NA_HEADS, 2 * NA_KH_MAX - 1, 2 * NA_KW - 1), 0.1),
        'od_w_in': nrm((no, D_MODEL, ODD_IN), D_MODEL ** -0.5),
        'od_w_out': nrm((no, MIX_WIDTH, D_MODEL), MIX_WIDTH ** -0.5),
        'hy_short_w': nrm((no, HY_SHORT, 3 * HY_WIDTH), HY_SHORT ** -0.5),
        'hy_short_b': nrm((no, 3 * HY_WIDTH), 0.02),
        'hy_w_in': nrm((no, HY_EMB, HY_HIDDEN), HY_EMB ** -0.5),
        'hy_b_in': nrm((no, HY_HIDDEN), 0.1),
        'hy_w_mid': nrm((no, HY_N_MID, HY_HIDDEN, HY_HIDDEN), HY_HIDDEN ** -0.5),
        'hy_b_mid': nrm((no, HY_N_MID, HY_HIDDEN), 0.1),
        'hy_w_out': nrm((no, HY_HIDDEN, HY_ORDER * 2 * HY_WIDTH), HY_FILTER_STD),
        'hy_freq': 1.0 + nrm((no, HY_HIDDEN), 0.02),
        'hy_fbias': nrm((no, HY_ORDER, HY_WIDTH), 0.5),
        'ssd_conv_w': nrm((no, SSD_CONV, SSD_XBC), SSD_CONV ** -0.5),
        'ssd_conv_b': nrm((no, SSD_XBC), 0.02),
        'ssd_dt_bias': dt0 + jnp.log(-jnp.expm1(-dt0)),
        'ssd_a_log': jnp.log(unif((no, 2, SSD_HEADS), 1.0, 16.0)),
        'ssd_d': 1.0 + nrm((no, SSD_HEADS), 0.1),
        'ssd_norm_g': 1.0 + nrm((no, SSD_INNER), 0.02),
    }


def reference(x, c, ctx, c_ctx, mod_w, mod_b, norm_g, ffn_wg, ffn_wu, ffn_wd, final_g,
              ev_w_in, ev_w_out, s5_a_re, s5_a_im, s5_log_dt, s5_b_re, s5_b_im, s5_c_re, s5_c_im,
              s5_d, s5_glu_w, s5_glu_b, na_rpb,
              od_w_in, od_w_out, hy_short_w, hy_short_b, hy_w_in, hy_b_in, hy_w_mid, hy_b_mid,
              hy_w_out, hy_freq, hy_fbias,
              ssd_conv_w, ssd_conv_b, ssd_dt_bias, ssd_a_log, ssd_d, ssd_norm_g):
    bsz = c.shape[0]
    xl, xc = x, ctx
    for layer in range(DEPTH):
        last = layer == DEPTH - 1
        j = layer // 2
        ml = (jax.nn.silu(c) @ mod_w[layer] + mod_b[layer]).reshape(bsz, N_MOD, 1, D_MODEL)
        mc = (jax.nn.silu(c_ctx)[None] @ mod_w[layer] + mod_b[layer]).reshape(1, N_MOD, 1, D_MODEL)
        ffn_a = (ffn_wg[layer, 0], ffn_wu[layer, 0], ffn_wd[layer, 0])
        ffn_b = (ffn_wg[layer, 1], ffn_wu[layer, 1], ffn_wd[layer, 1])
        xl = xl + 0.5 * ml[:, 2] * _swiglu(_pre(xl, norm_g[layer, 0], ml, 0), *ffn_a)
        xc = xc + 0.5 * mc[:, 2] * _swiglu(_pre(xc, norm_g[layer, 0], mc, 0), *ffn_a)
        hl = _pre(xl, norm_g[layer, 1], ml, 1)
        hc = _pre(xc, norm_g[layer, 1], mc, 1)
        if layer % 2 == 0:
            s5_params = (s5_a_re[j], s5_a_im[j], s5_log_dt[j], s5_b_re[j], s5_b_im[j],
                         s5_c_re[j], s5_c_im[j], s5_d[j], s5_glu_w[j], s5_glu_b[j])
            yc, yl = _even_mixer(hc, hl, ev_w_in[j], ev_w_out[j], s5_params, na_rpb[j], not last)
        else:
            hy_params = (hy_short_w[j], hy_short_b[j], hy_w_in[j], hy_b_in[j], hy_w_mid[j],
                         hy_b_mid[j], hy_w_out[j], hy_freq[j], hy_fbias[j])
            yc, yl = _odd_mixer(hc, hl, od_w_in[j], od_w_out[j], hy_params, ssd_conv_w[j], ssd_conv_b[j],
                                ssd_dt_bias[j], ssd_a_log[j], ssd_d[j], ssd_norm_g[j], not last)
        xl = xl + ml[:, 5] * yl
        xl = xl + 0.5 * ml[:, 8] * _swiglu(_pre(xl, norm_g[layer, 2], ml, 2), *ffn_b)
        if not last:
            xc = xc + mc[:, 5] * yc
            xc = xc + 0.5 * mc[:, 8] * _swiglu(_pre(xc, norm_g[layer, 2], mc, 2), *ffn_b)
    return _rmsnorm(xl, final_g)
```

```cpp
#include <hip/hip_runtime.h>
#include <cstdio>
#include <cstdint>
namespace pg8 {
#define PG8_LAS __attribute__((address_space(3)))
typedef unsigned short bf16_t;
typedef short bf16x8 __attribute__((ext_vector_type(8)));
typedef float f32x4 __attribute__((ext_vector_type(4)));
typedef unsigned u32x4 __attribute__((ext_vector_type(4)));
constexpr int BM = 256, BK = 64, HALF = 128, HTB = HALF * BK * 2  , STAGE_BYTES = 8 * HTB, NXCD = 8, WGM = 8;

__host__ __device__ __forceinline__ int lds_byte(int r, int c) { const int st = (r >> 4) * 2 + (c >> 5), rr = r & 15, cc = c & 31, ob = rr * 64 + cc * 2; return st * 1024 + (ob ^ (((ob >> 9) & 1) << 5)); }
__host__ __device__ __forceinline__ void stage_rc(int b, int& R, int& C) { const int st = b / 1024, sb = b % 1024, swz = sb ^ (((sb >> 9) & 1) << 5); R = (st >> 1) * 16 + swz / 64; C = (st & 1) * 32 + (swz % 64) / 2; }
__host__ __device__ __forceinline__ int perm32(int rho) { const int n = rho >> 4, i = rho & 15; return 8 * (i >> 2) + 4 * n + (i & 3); }

struct Unit { int pm, pn; };
struct Gemm { const bf16_t* A; const bf16_t* Bt; int M, N, K; };

struct StaticOrder {
    int nM, nN, nwg, G, c;
    __host__ __device__ void init(int M, int N, int G_, int c_) { nM = M / BM; nN = N / BM; nwg = nM * nN; G = G_; c = c_; }
    __host__ __device__ bool next(int i, Unit& u) const {
        const long L = (long)i * G + c; if (L >= nwg) return false;
        int wgid = (int)L; { const int q = nwg / NXCD, r = nwg % NXCD, xcd = wgid % NXCD, off = wgid / NXCD; wgid = (xcd < r ? xcd * (q + 1) : r * (q + 1) + (xcd - r) * q) + off; }
        const int nig = WGM * nN, gid = wgid / nig, fm = gid * WGM, gsz = (nM - fm) < WGM ? (nM - fm) : WGM;
        u.pm = fm + ((wgid % nig) % gsz); u.pn = (wgid % nig) / gsz; return true;
    }
    __device__ __forceinline__ void a_ready(const Unit&) const {}
    __device__ __forceinline__ void done(const Unit&) const {}
};
__device__ __forceinline__ unsigned cvt_pk_bf16(float lo, float hi) { unsigned r; asm volatile("v_cvt_pk_bf16_f32 %0, %1, %2" : "=v"(r) : "v"(lo), "v"(hi)); return r; }

__device__ __forceinline__ float fast_sigmoid(float x) { return __builtin_amdgcn_rcpf(1.0f + __builtin_amdgcn_exp2f(-1.4426950408889634f * x)); }
struct EpiSwiglu {
    static constexpr bool PERM = true, AFTER_DRAIN = false;
    bf16_t* O; int ldc;
    __device__ __forceinline__ void operator()(const f32x4 (&acc)[2][2][4][2], const Unit& u, int wr, int wc, int fr, int fq) const {
        const int row0 = u.pm * BM + wr * 64 + fr, col0 = u.pn * HALF + wc * 32 + 8 * fq;
#pragma unroll
        for (int ai = 0; ai < 2; ++ai)
#pragma unroll
            for (int m = 0; m < 4; ++m) { bf16_t* rowp = O + (size_t)(row0 + ai * HALF + m * 16) * ldc + col0;
                float h[8];
#pragma unroll
                for (int n = 0; n < 2; ++n)
#pragma unroll
                    for (int j = 0; j < 4; ++j) { const float g = acc[ai][0][m][n][j], up = acc[ai][1][m][n][j]; h[4 * n + j] = g * fast_sigmoid(g) * up; }
                u32x4 w; w.x = cvt_pk_bf16(h[0], h[1]); w.y = cvt_pk_bf16(h[2], h[3]); w.z = cvt_pk_bf16(h[4], h[5]); w.w = cvt_pk_bf16(h[6], h[7]);
                *(u32x4*)rowp = w; }
    }
};
struct EpiResid {
    static constexpr bool PERM = false, AFTER_DRAIN = false;
    const float* baseL; const float* baseC; float* out; const float* modv; int gidx; float scale;
    __device__ __forceinline__ void operator()(const f32x4 (&acc)[2][2][4][2], const Unit& u, int wr, int wc, int fr, int fq) const {
        const int pm = u.pm, r = pm < 64 ? (pm >> 3) : 8;
        const float* gv = modv + (size_t)r * 18432 + gidx * 2048;
        const float* base = pm < 64 ? baseL + (size_t)pm * 256 * 2048 : baseC + (size_t)(pm - 64) * 256 * 2048;
        float* o = out + (size_t)pm * 256 * 2048;
        const int rowl = wr * 64 + fr, col0 = u.pn * BM + wc * 32 + 4 * fq;
        f32x4 gvv[2][2];
#pragma unroll
        for (int bj = 0; bj < 2; ++bj)
#pragma unroll
            for (int n = 0; n < 2; ++n) gvv[bj][n] = *(const f32x4*)(gv + col0 + bj * HALF + n * 16) * scale;
#pragma unroll
        for (int ai = 0; ai < 2; ++ai)
#pragma unroll
            for (int m = 0; m < 4; ++m) { const size_t off = (size_t)(rowl + ai * HALF + m * 16) * 2048 + col0;
#pragma unroll
                for (int bj = 0; bj < 2; ++bj)
#pragma unroll
                    for (int n = 0; n < 2; ++n) { const f32x4 bs = *(const f32x4*)(base + off + bj * HALF + n * 16); *(f32x4*)(o + off + bj * HALF + n * 16) = bs + gvv[bj][n] * acc[ai][bj][m][n]; } }
    }
};
struct EpiPlain {
    static constexpr bool PERM = true, AFTER_DRAIN = false;
    bf16_t* O; int ldc; float* DT;
    __device__ __forceinline__ void operator()(const f32x4 (&acc)[2][2][4][2], const Unit& u, int wr, int wc, int fr, int fq) const {
        const int row0 = u.pm * BM + wr * 64 + fr;
        if (u.pn * BM >= ldc) {
            if (DT != nullptr && wc == 0) {
#pragma unroll
                for (int ai = 0; ai < 2; ++ai)
#pragma unroll
                    for (int m = 0; m < 4; ++m) { float* rowp = DT + (size_t)(row0 + ai * HALF + m * 16) * 32 + 8 * fq;
                        *(f32x4*)(rowp) = acc[ai][0][m][0]; *(f32x4*)(rowp + 4) = acc[ai][0][m][1]; }
            }
            return;
        }
        const int col0 = u.pn * BM + wc * 32 + 8 * fq;
#pragma unroll
        for (int ai = 0; ai < 2; ++ai)
#pragma unroll
            for (int m = 0; m < 4; ++m) { bf16_t* rowp = O + (size_t)(row0 + ai * HALF + m * 16) * ldc + col0;
#pragma unroll
                for (int bj = 0; bj < 2; ++bj) { const f32x4 v0 = acc[ai][bj][m][0], v1 = acc[ai][bj][m][1];
                    u32x4 w; w.x = cvt_pk_bf16(v0[0], v0[1]); w.y = cvt_pk_bf16(v0[2], v0[3]); w.z = cvt_pk_bf16(v1[0], v1[1]); w.w = cvt_pk_bf16(v1[2], v1[3]);
                    *(u32x4*)(rowp + bj * HALF) = w; } }
    }
};
struct EpiGlu {
    static constexpr bool PERM = true, AFTER_DRAIN = false;
    const bf16_t* G; const float* bias; bf16_t* O;
    __device__ __forceinline__ void operator()(const f32x4 (&acc)[2][2][4][2], const Unit& u, int wr, int wc, int fr, int fq) const {
        const int row0 = u.pm * BM + wr * 64 + fr, col0 = u.pn * BM + wc * 32 + 8 * fq;
#pragma unroll
        for (int ai = 0; ai < 2; ++ai)
#pragma unroll
            for (int m = 0; m < 4; ++m) { const size_t row = (size_t)(row0 + ai * HALF + m * 16);
#pragma unroll
                for (int bj = 0; bj < 2; ++bj) { const int c = col0 + bj * HALF;
                    const u32x4 gw = *(const u32x4*)(G + row * 1024 + c);
                    const f32x4 b0 = *(const f32x4*)(bias + c), b1 = *(const f32x4*)(bias + c + 4);
                    const f32x4 v0 = acc[ai][bj][m][0] + b0, v1 = acc[ai][bj][m][1] + b1;
                    float o[8];
#pragma unroll
                    for (int j = 0; j < 4; ++j) { const unsigned gq = gw[j]; const float ga = __uint_as_float(gq << 16), gb = __uint_as_float(gq & 0xffff0000u);
                        const float sa = (j < 2) ? v0[2 * j] : v1[2 * j - 4], sb = (j < 2) ? v0[2 * j + 1] : v1[2 * j - 3];
                        o[2 * j] = ga * fast_sigmoid(sa); o[2 * j + 1] = gb * fast_sigmoid(sb); }
                    u32x4 w; w.x = cvt_pk_bf16(o[0], o[1]); w.y = cvt_pk_bf16(o[2], o[3]); w.z = cvt_pk_bf16(o[4], o[5]); w.w = cvt_pk_bf16(o[6], o[7]);
                    *(u32x4*)(O + row * 2048 + c) = w; } }
    }
};
template <class Epi, class Sched, bool ALIGN_EPI = false, bool SP2 = false>
__device__ __forceinline__ void gemm_phase(PG8_LAS unsigned char* lds, const Gemm g, const Sched& S, const Epi& E) {
    const int tid = threadIdx.x, wid = __builtin_amdgcn_readfirstlane(tid >> 6), lane = tid & 63, wr = wid >> 2, wc = wid & 3, fr = lane & 15, fq = lane >> 4;
    const int K = g.K, nt = K / BK;
    unsigned voffA[2], voffB[2];
#pragma unroll
    for (int i = 0; i < 2; ++i) { int R, C; stage_rc(tid * 16 + i * 8192, R, C); const int Rb = Epi::PERM ? ((R & ~31) + perm32(R & 31)) : R;
        voffA[i] = (unsigned)(R * K + C) * 2u; voffB[i] = (unsigned)(Rb * K + C) * 2u; }
    const size_t kstep = (size_t)(BK * 2);
    const size_t hstep = (size_t)HALF * K * 2;
    const size_t tstep = 2 * hstep;
    const unsigned ldsw = (unsigned)wid * 1024u;
    const int aoff = lds_byte(wr * 64 + fr, fq * 8), boff = lds_byte(wc * 32 + fr, fq * 8);
#define PG8_SA(b, h) (((b) * 2 + (h)) * HTB)
#define PG8_SB(b, h) ((4 + (b) * 2 + (h)) * HTB)
#define PG8_STAGE(bufoff, gbase, voff) do { _Pragma("unroll") for (int _i = 0; _i < 2; ++_i) \
        __builtin_amdgcn_global_load_lds((const unsigned*)((const char*)(gbase) + (voff)[_i]), (PG8_LAS unsigned*)(lds + (bufoff) + ldsw + _i * 8192), 16, 0, 0); } while (0)
#define PG8_LDA(dst, b, h) do { _Pragma("unroll") for (int m = 0; m < 4; ++m) _Pragma("unroll") for (int k = 0; k < 2; ++k) dst[m][k] = *(const PG8_LAS bf16x8*)(lds + PG8_SA(b, h) + aoff + m * 2048 + k * 1024); } while (0)
#define PG8_LDB(dst, b, h) do { _Pragma("unroll") for (int n = 0; n < 2; ++n) _Pragma("unroll") for (int k = 0; k < 2; ++k) dst[n][k] = *(const PG8_LAS bf16x8*)(lds + PG8_SB(b, h) + boff + n * 2048 + k * 1024); } while (0)
#define PG8_MMA(ai, bj, At, Bt) do { __builtin_amdgcn_s_setprio(1); _Pragma("unroll") for (int m = 0; m < 4; ++m) _Pragma("unroll") for (int n = 0; n < 2; ++n) _Pragma("unroll") for (int k = 0; k < 2; ++k) \
        acc[ai][bj][m][n] = __builtin_amdgcn_mfma_f32_16x16x32_bf16(Bt[n][k], At[m][k], acc[ai][bj][m][n], 0, 0, 0); __builtin_amdgcn_s_setprio(0); } while (0)
#define PG8_WAIT_V(n) asm volatile("s_waitcnt vmcnt(" #n ")" ::: "memory")
#define PG8_WAIT_L(n) asm volatile("s_waitcnt lgkmcnt(" #n ")" ::: "memory")
#define PG8_BAR __builtin_amdgcn_s_barrier()
#define PG8_SCHED __builtin_amdgcn_sched_barrier(0)
    Unit cur, nxt; int ui = 0;
    if (!S.next(0, cur)) return;
    f32x4 acc[2][2][4][2];
#pragma unroll
    for (int a = 0; a < 2; ++a)
#pragma unroll
        for (int b = 0; b < 2; ++b)
#pragma unroll
            for (int m = 0; m < 4; ++m)
#pragma unroll
                for (int n = 0; n < 2; ++n) acc[a][b][m][n] = (f32x4){0.f, 0.f, 0.f, 0.f};
    bf16x8 At[4][2], B0[2][2], B1[2][2];
    const char* cA = (const char*)g.A + (size_t)cur.pm * tstep; const char* cB = (const char*)g.Bt + (size_t)cur.pn * tstep;
    S.a_ready(cur);
    if constexpr (SP2) {
        PG8_STAGE(PG8_SB(0, 0), cB, voffB); PG8_STAGE(PG8_SB(0, 1), cB + hstep, voffB); PG8_STAGE(PG8_SA(0, 0), cA, voffA); PG8_STAGE(PG8_SA(0, 1), cA + hstep, voffA);
        if (wr == 1) PG8_BAR;
        PG8_WAIT_V(2); PG8_BAR;
        PG8_STAGE(PG8_SB(1, 0), cB + kstep, voffB); PG8_STAGE(PG8_SA(1, 0), cA + kstep, voffA); PG8_STAGE(PG8_SB(1, 1), cB + hstep + kstep, voffB);
        PG8_WAIT_V(6); PG8_BAR;
    } else {
        PG8_STAGE(PG8_SB(0, 0), cB, voffB); PG8_STAGE(PG8_SA(0, 0), cA, voffA); PG8_STAGE(PG8_SB(0, 1), cB + hstep, voffB); PG8_STAGE(PG8_SA(0, 1), cA + hstep, voffA);
        if (wr == 1) PG8_BAR;
        PG8_WAIT_V(4); PG8_BAR;
        PG8_STAGE(PG8_SB(1, 0), cB + kstep, voffB); PG8_STAGE(PG8_SA(1, 0), cA + kstep, voffA); PG8_STAGE(PG8_SB(1, 1), cB + hstep + kstep, voffB);
        PG8_WAIT_V(6); PG8_BAR;
    }
    for (;;) {
        const bool has_next = S.next(ui + 1, nxt);
        const char* nA = has_next ? (const char*)g.A + (size_t)nxt.pm * tstep : cA; const char* nB = has_next ? (const char*)g.Bt + (size_t)nxt.pn * tstep : cB;
        for (int t = 0; t < nt; t += 2) {
            const bool last = (t == nt - 2);
            const char* a1 = cA + (size_t)(t + 1) * kstep;
            const char* a2 = last ? nA : cA + (size_t)(t + 2) * kstep; const char* b2 = last ? nB : cB + (size_t)(t + 2) * kstep;
            const char* a3 = a2 + kstep; const char* b3 = b2 + kstep;
            if (last && has_next) S.a_ready(nxt);
            if constexpr (SP2) {
            PG8_LDB(B0, 0, 0); PG8_LDB(B1, 0, 1); PG8_SCHED; PG8_LDA(At, 0, 0); PG8_STAGE(PG8_SA(1, 1), a1 + hstep, voffA);
            PG8_WAIT_V(8); PG8_WAIT_L(0); PG8_BAR; PG8_MMA(0, 0, At, B0); PG8_MMA(0, 1, At, B1); PG8_BAR; PG8_SCHED;
            PG8_LDA(At, 0, 1); PG8_STAGE(PG8_SB(0, 0), b2, voffB); PG8_STAGE(PG8_SB(0, 1), b2 + hstep, voffB); PG8_STAGE(PG8_SA(0, 0), a2, voffA);
            PG8_WAIT_V(8); PG8_WAIT_L(0); PG8_BAR; PG8_MMA(1, 0, At, B0); PG8_MMA(1, 1, At, B1); PG8_BAR; PG8_SCHED;
            PG8_LDB(B0, 1, 0); PG8_LDB(B1, 1, 1); PG8_SCHED; PG8_LDA(At, 1, 0); PG8_STAGE(PG8_SA(0, 1), a2 + hstep, voffA);
            PG8_WAIT_V(8); PG8_WAIT_L(0); PG8_BAR; PG8_MMA(0, 0, At, B0); PG8_MMA(0, 1, At, B1); PG8_BAR; PG8_SCHED;
            PG8_LDA(At, 1, 1); PG8_STAGE(PG8_SB(1, 0), b3, voffB); PG8_STAGE(PG8_SB(1, 1), b3 + hstep, voffB); PG8_STAGE(PG8_SA(1, 0), a3, voffA);
            PG8_WAIT_V(8); PG8_WAIT_L(0); PG8_BAR; PG8_MMA(1, 0, At, B0); PG8_MMA(1, 1, At, B1); PG8_BAR; PG8_SCHED;
            } else {
            PG8_LDB(B0, 0, 0); PG8_SCHED; PG8_LDA(At, 0, 0); PG8_STAGE(PG8_SA(1, 1), a1 + hstep, voffA);
            PG8_WAIT_L(8); PG8_BAR; PG8_WAIT_L(0); PG8_MMA(0, 0, At, B0); PG8_BAR; PG8_SCHED;
            PG8_LDB(B1, 0, 1); PG8_STAGE(PG8_SB(0, 0), b2, voffB);
            PG8_BAR; PG8_WAIT_L(0); PG8_MMA(0, 1, At, B1); PG8_BAR;
            PG8_LDA(At, 0, 1); PG8_STAGE(PG8_SA(0, 0), a2, voffA);
            PG8_BAR; PG8_WAIT_L(0); PG8_MMA(1, 0, At, B0); PG8_BAR; PG8_SCHED;
            PG8_STAGE(PG8_SB(0, 1), b2 + hstep, voffB);
            PG8_WAIT_V(6); PG8_BAR; PG8_MMA(1, 1, At, B1); PG8_BAR;
            PG8_LDB(B0, 1, 0); PG8_SCHED; PG8_LDA(At, 1, 0); PG8_STAGE(PG8_SA(0, 1), a2 + hstep, voffA);
            PG8_WAIT_L(8); PG8_BAR; PG8_WAIT_L(0); PG8_MMA(0, 0, At, B0); PG8_BAR; PG8_SCHED;
            PG8_LDB(B1, 1, 1); PG8_STAGE(PG8_SB(1, 0), b3, voffB);
            PG8_BAR; PG8_WAIT_L(0); PG8_MMA(0, 1, At, B1); PG8_BAR;
            PG8_LDA(At, 1, 1); PG8_STAGE(PG8_SA(1, 0), a3, voffA);
            PG8_BAR; PG8_WAIT_L(0); PG8_MMA(1, 0, At, B0); PG8_BAR; PG8_SCHED;
            PG8_STAGE(PG8_SB(1, 1), b3 + hstep, voffB);
            PG8_WAIT_V(6); PG8_BAR; PG8_MMA(1, 1, At, B1); PG8_BAR;
            }
        }
        if constexpr (ALIGN_EPI) { if (wr == 0) PG8_BAR; }
        if constexpr (!Epi::AFTER_DRAIN) { E(acc, cur, wr, wc, fr, fq); S.done(cur); }
        if (!has_next) break;
#pragma unroll
        for (int a = 0; a < 2; ++a)
#pragma unroll
            for (int b = 0; b < 2; ++b)
#pragma unroll
                for (int m = 0; m < 4; ++m)
#pragma unroll
                    for (int n = 0; n < 2; ++n) acc[a][b][m][n] = (f32x4){0.f, 0.f, 0.f, 0.f};
        cur = nxt; cA = nA; cB = nB; ++ui;
        if constexpr (ALIGN_EPI) { if (wr == 1) PG8_BAR; }
    }
    PG8_WAIT_V(0);
    if constexpr (!ALIGN_EPI) { if (wr == 0) PG8_BAR; }
    PG8_BAR;
    if constexpr (Epi::AFTER_DRAIN) { E.fused(acc, cur, wr, wc, fr, fq, lds, wid, lane); S.done(cur); }
#undef PG8_SA
#undef PG8_SB
#undef PG8_STAGE
#undef PG8_LDA
#undef PG8_LDB
#undef PG8_MMA
#undef PG8_WAIT_V
#undef PG8_WAIT_L
#undef PG8_BAR
#undef PG8_SCHED
}
}

#define LAS __attribute__((address_space(3)))
typedef unsigned short bf16;
typedef float f32x4 __attribute__((ext_vector_type(4)));
typedef unsigned v4u __attribute__((ext_vector_type(4)));
typedef unsigned v2u __attribute__((ext_vector_type(2)));
constexpr int NWAVES = 8;
constexpr int DM = 2048, NB = 8, SEQ = 2048, CTXL = 256, DFF = 5632;
constexpr int ML = NB * SEQ, MC = NB * CTXL, MT = ML + MC;
constexpr int NMODC = 9 * DM;
constexpr int EVEN_IN = 4096, ODD_IN = 6176, ODD_INP = 6400, ODD_LD = 6144;
constexpr float EPS = 1e-6f;
enum { I_X = 0, I_C, I_CTX, I_CCTX, I_MODW, I_MODB, I_NORMG, I_WG, I_WU, I_WD, I_FINALG, I_EVWIN, I_EVWOUT, I_S5ARE, I_S5AIM, I_S5LOGDT, I_S5BRE, I_S5BIM, I_S5CRE, I_S5CIM,
       I_S5D, I_GLUW, I_GLUB, I_RPB, I_ODWIN, I_ODWOUT, I_HYSW, I_HYSB, I_HYWIN, I_HYBIN, I_HYWMID, I_HYBMID, I_HYWOUT, I_HYFREQ, I_HYFBIAS, I_SSDCW, I_SSDCB, I_SSDDTB, I_SSDALOG,
       I_SSDD, I_SSDNG, N_IN };
constexpr size_t MiB = 1u << 20;
constexpr size_t WS_CTL = 0, CTL_ZERO_BYTES = 1 * MiB;
constexpr size_t SZ_WGU = (size_t)2 * DFF * DM * 2, SZ_WD = (size_t)DM * DFF * 2;
constexpr size_t WS_WGU = 1 * MiB;
constexpr size_t WS_WD = WS_WGU + 4 * SZ_WGU;
constexpr size_t WS_WEVIN = WS_WD + 4 * SZ_WD;
constexpr size_t WS_WEVOUT = WS_WEVIN + (size_t)EVEN_IN * DM * 2;
constexpr size_t WS_WGLU = WS_WEVOUT + (size_t)DM * DM * 2;
constexpr size_t WS_WODIN = WS_WGLU + (size_t)1024 * 1024 * 2;
constexpr size_t WS_WODOUT = WS_WODIN + (size_t)ODD_INP * DM * 2;
constexpr size_t WS_MODP = WS_WODOUT + (size_t)DM * DM * 2;
constexpr size_t WS_MODV = WS_MODP + (size_t)2 * 16 * 9 * NMODC * 4;
constexpr size_t WS_XS = WS_MODV + (size_t)2 * 9 * NMODC * 4;
constexpr size_t WS_H = WS_XS + (size_t)MT * DM * 4;
constexpr size_t WS_BIG = WS_H + (size_t)MT * DM * 2;
constexpr size_t SZ_BIG = (size_t)MT * ODD_LD * 2;
constexpr size_t WS_MIX = WS_BIG + SZ_BIG;
constexpr size_t WS_FILT = WS_MIX + (size_t)MT * DM * 2;
constexpr size_t WS_SCR = WS_FILT + (size_t)2 * 1024 * 4096 * 4;
constexpr size_t WS_YF = WS_SCR, WS_YR = WS_YF + (size_t)MT * 1024 * 4, WS_G = WS_YR + (size_t)MT * 1024 * 4, WS_SCR0_END = WS_G + (size_t)MT * 1024 * 2;
constexpr size_t SZ_CM = (size_t)1024 * ML * 2;
constexpr size_t WS_X1C = WS_SCR, WS_X2C = WS_X1C + SZ_CM, WS_VC = WS_X2C + SZ_CM, WS_ZC = WS_VC + SZ_CM, WS_XBC = WS_ZC + SZ_CM, WS_DT = WS_XBC + (size_t)MT * 2048 * 2, WS_SCR1_END = WS_DT + (size_t)MT * 32 * 4;
constexpr size_t WS_YS = WS_H;
constexpr size_t WS_END = (WS_SCR0_END > WS_SCR1_END ? WS_SCR0_END : WS_SCR1_END);
static_assert(WS_END <= (size_t)1152 * MiB, "workspace map exceeds the guaranteed d_ws size");
static_assert((size_t)2 * ML * 1024 * 2 <= (size_t)MT * DM * 2, "YS fits in H");
constexpr int CW_TMO = 0, CW_BAR = 4096;
constexpr int RING_BYTES = 131072, LDSCTL_OFF = RING_BYTES, MISC_OFF = LDSCTL_OFF + 320, LDS_BYTES = 147456;

__device__ __forceinline__ float bf2f(unsigned v) { return __uint_as_float(v << 16); }
__device__ __forceinline__ unsigned f2bf(float f) { unsigned u = __float_as_uint(f); return (u + 0x7fffu + ((u >> 16) & 1u)) >> 16; }
__device__ __forceinline__ unsigned pk2(float lo, float hi) { return f2bf(lo) | (f2bf(hi) << 16); }
__device__ __forceinline__ float wave_sum(float v) {
#pragma unroll
    for (int o = 1; o < 64; o <<= 1) v += __shfl_xor(v, o);
    return v;
}
__device__ __forceinline__ float wave_max(float v) {
#pragma unroll
    for (int o = 1; o < 64; o <<= 1) v = fmaxf(v, __shfl_xor(v, o));
    return v;
}
__device__ __forceinline__ float silu_f(float x) { return x / (1.0f + __expf(-x)); }
__device__ __forceinline__ float rdlane(float v, int l) { return __int_as_float(__builtin_amdgcn_readlane(__float_as_int(v), l)); }

struct Args { const float* in[N_IN]; float* out; unsigned char* ws; int ph_lo, ph_hi; };
struct Frame {
    LAS unsigned char* lds; const float* const* in; float* out; unsigned char* ws;
    int tid, lane, wave, gw, ngw, G;
};

__device__ __forceinline__ void transpose_item(const float* W, int K, int N, bf16* WT, int k0, int n0, int drow0, LAS float* scr, int lane) {
#pragma unroll 8
    for (int i = 0; i < 32; ++i) { const int kk = 2 * i + (lane >> 5); scr[kk * 33 + (lane & 31)] = W[(size_t)(k0 + kk) * N + n0 + (lane & 31)]; }
    asm volatile("s_waitcnt lgkmcnt(0)" ::: "memory");
    const int c = lane & 7;
#pragma unroll
    for (int j = 0; j < 4; ++j) { const int n = (lane >> 3) + 8 * j; const LAS float* s = scr + (8 * c) * 33 + n;
        v4u o; o.x = pk2(s[0 * 33], s[1 * 33]); o.y = pk2(s[2 * 33], s[3 * 33]); o.z = pk2(s[4 * 33], s[5 * 33]); o.w = pk2(s[6 * 33], s[7 * 33]);
        *(v4u*)(WT + (size_t)(drow0 + n) * K + k0 + 8 * c) = o; }
    asm volatile("s_waitcnt lgkmcnt(0)" ::: "memory");
}
__device__ __forceinline__ void p0_prologue(Frame& F) {
    LAS float* scr = (LAS float*)(F.lds + F.wave * 16384);
    const float* const* in = F.in; unsigned char* ws = F.ws; const int lane = F.lane;
    constexpr int I_FFN1 = (DM / 64) * (DFF / 32);
    constexpr int I_FFN = 12 * I_FFN1;
    constexpr int I_EVIN = (DM / 64) * (EVEN_IN / 32), I_EVOUT = (DM / 64) * (DM / 32), I_GLU = (1024 / 64) * (1024 / 32), I_ODIN = (DM / 64) * (ODD_IN / 32), I_ODOUT = I_EVOUT;
    constexpr int NITEMS = I_FFN + I_EVIN + I_EVOUT + I_GLU + I_ODIN + I_ODOUT;
    for (int it = F.gw; it < NITEMS; it += F.ngw) {
        int r = it;
        if (r < I_FFN) { const int q = r / I_FFN1, rr = r % I_FFN1, mat = q % 3, lab = q / 3;
            if (mat < 2) { const int nblk = DFF / 32, kb = rr / nblk, nb = rr % nblk, n0 = nb * 32;
                const float* W = (mat == 0 ? in[I_WG] : in[I_WU]) + (size_t)lab * DM * DFF;
                transpose_item(W, DM, DFF, (bf16*)(ws + WS_WGU + (size_t)lab * SZ_WGU), kb * 64, n0, (n0 >> 7) * 256 + (n0 & 127) + mat * 128, scr, lane); }
            else { const int nblk = DM / 32, kb = rr / nblk, nb = rr % nblk;
                transpose_item(in[I_WD] + (size_t)lab * DFF * DM, DFF, DM, (bf16*)(ws + WS_WD + (size_t)lab * SZ_WD), kb * 64, nb * 32, nb * 32, scr, lane); }
            continue; }
        r -= I_FFN;
        if (r < I_EVIN) { const int nblk = EVEN_IN / 32; transpose_item(in[I_EVWIN], DM, EVEN_IN, (bf16*)(ws + WS_WEVIN), (r / nblk) * 64, (r % nblk) * 32, (r % nblk) * 32, scr, lane); continue; }
        r -= I_EVIN;
        if (r < I_EVOUT) { const int nblk = DM / 32; transpose_item(in[I_EVWOUT], DM, DM, (bf16*)(ws + WS_WEVOUT), (r / nblk) * 64, (r % nblk) * 32, (r % nblk) * 32, scr, lane); continue; }
        r -= I_EVOUT;
        if (r < I_GLU) { const int nblk = 1024 / 32; transpose_item(in[I_GLUW], 1024, 1024, (bf16*)(ws + WS_WGLU), (r / nblk) * 64, (r % nblk) * 32, (r % nblk) * 32, scr, lane); continue; }
        r -= I_GLU;
        if (r < I_ODIN) { const int nblk = ODD_IN / 32; transpose_item(in[I_ODWIN], DM, ODD_IN, (bf16*)(ws + WS_WODIN), (r / nblk) * 64, (r % nblk) * 32, (r % nblk) * 32, scr, lane); continue; }
        r -= I_ODIN;
        { const int nblk = DM / 32; transpose_item(in[I_ODWOUT], DM, DM, (bf16*)(ws + WS_WODOUT), (r / nblk) * 64, (r % nblk) * 32, (r % nblk) * 32, scr, lane); }
    }
    { v4u* z = (v4u*)(ws + WS_WODIN + (size_t)ODD_IN * DM * 2); const int nz = (ODD_INP - ODD_IN) * DM * 2 / 16;
      for (int i = F.gw * 64 + lane; i < nz; i += F.ngw * 64) z[i] = (v4u){0u, 0u, 0u, 0u}; }
    { LAS float* sv = scr;
      for (int it = F.gw; it < 2 * 72 * 16; it += F.ngw) {
          const int kc = it & 15, cb = (it >> 4) % 72, l = it / (72 * 16);
          for (int idx = lane; idx < 9 * 128; idx += 64) { const int r = idx >> 7, kk = idx & 127; const float v = r < 8 ? in[I_C][r * DM + kc * 128 + kk] : in[I_CCTX][kc * 128 + kk]; sv[idx] = silu_f(v); }
          asm volatile("s_waitcnt lgkmcnt(0)" ::: "memory");
          f32x4 acc[9];
#pragma unroll
          for (int r = 0; r < 9; ++r) acc[r] = (f32x4){0.f, 0.f, 0.f, 0.f};
          const float* wp = in[I_MODW] + ((size_t)l * DM + kc * 128) * NMODC + cb * 256 + lane * 4;
#pragma unroll 4
          for (int kk = 0; kk < 128; ++kk) { const f32x4 w = *(const f32x4*)(wp + (size_t)kk * NMODC);
#pragma unroll
              for (int r = 0; r < 9; ++r) acc[r] += w * sv[r * 128 + kk]; }
          float* op = (float*)(ws + WS_MODP) + ((size_t)(l * 16 + kc) * 9) * NMODC + cb * 256 + lane * 4;
#pragma unroll
          for (int r = 0; r < 9; ++r) *(f32x4*)(op + (size_t)r * NMODC) = acc[r];
          asm volatile("s_waitcnt lgkmcnt(0)" ::: "memory");
      } }
    { const float PI2 = 6.283185307179586f;
      const float min_decay = -3.0701134573253943f, max_decay = -15.350567286626972f;
      float* FILT = (float*)(ws + WS_FILT);
      for (int pos = F.gw; pos < SEQ; pos += F.ngw) {
          const float t = (float)pos / 2047.0f, w = PI2 * (float)pos / 2048.0f;
          float pre = in[I_HYBIN][lane] + t * in[I_HYWIN][lane];
#pragma unroll 4
          for (int i = 0; i < 16; ++i) { const float f = 1e-4f + (float)i * ((15.0f - 1e-4f) / 15.0f); const float a = f * w;
              pre += cosf(a) * in[I_HYWIN][(1 + i) * 64 + lane] - sinf(a) * in[I_HYWIN][(17 + i) * 64 + lane]; }
          const float fr = in[I_HYFREQ][lane];
          float h = sinf(fr * pre);
#pragma unroll
          for (int l2 = 0; l2 < 2; ++l2) { float p2 = in[I_HYBMID][l2 * 64 + lane]; const float* wm = in[I_HYWMID] + l2 * 4096 + lane;
              for (int i = 0; i < 64; ++i) p2 += __shfl(h, i) * wm[i * 64];
              h = sinf(fr * p2); }
          for (int q = 0; q < 64; ++q) { const int col = q * 64 + lane; const float* wo = in[I_HYWOUT] + col; float acc = 0.f;
              for (int i = 0; i < 64; ++i) acc += __shfl(h, i) * wo[i * 4096];
              const int o = col >> 11, d = (col >> 10) & 1, c = col & 1023;
              const float delta = fabsf(min_decay + (float)c * ((max_decay - min_decay) / 1023.0f));
              const float val = acc * expf(-t * delta);
              float* fp = FILT + (size_t)(o * 1024 + c) * 4096;
              if (d == 0) fp[2047 + pos] = val; else if (pos >= 1) fp[2047 - pos] = val; }
      } }
}
__device__ __forceinline__ void p1_modred(Frame& F) {
    const float* MP = (const float*)(F.ws + WS_MODP); float* MV = (float*)(F.ws + WS_MODV);
    for (int i = blockIdx.x * 512 + F.tid; i < 2 * 9 * NMODC; i += F.G * 512) {
        const int col = i % NMODC, r = (i / NMODC) % 9, l = i / (9 * NMODC); float s = F.in[I_MODB][l * NMODC + col];
#pragma unroll
        for (int kc = 0; kc < 16; ++kc) s += MP[((size_t)(l * 16 + kc) * 9 + r) * NMODC + col];
        MV[i] = s; }
}
__device__ __forceinline__ void prenorm_phase(Frame& F, const float* xl, const float* xc, int rows, int layer, int sub) {
    const float* g = F.in[I_NORMG] + (layer * 3 + sub) * DM; const float* MV = (const float*)(F.ws + WS_MODV) + (size_t)layer * 9 * NMODC; bf16* H = (bf16*)(F.ws + WS_H);
    for (int row = F.gw; row < rows; row += F.ngw) {
        const float* xr = row < ML ? xl + (size_t)row * DM : xc + (size_t)(row - ML) * DM; const int r = row < ML ? row / SEQ : 8;
        const float* sh = MV + (size_t)r * NMODC + (3 * sub) * DM; const float* sc = sh + DM;
        f32x4 v[8]; float s = 0.f;
#pragma unroll
        for (int j = 0; j < 8; ++j) { v[j] = *(const f32x4*)(xr + 4 * (F.lane + 64 * j)); s += (v[j].x * v[j].x + v[j].y * v[j].y) + (v[j].z * v[j].z + v[j].w * v[j].w); }
        const float rstd = 1.0f / sqrtf(wave_sum(s) * (1.0f / DM) + EPS);
#pragma unroll
        for (int j = 0; j < 8; ++j) { const int c = 4 * (F.lane + 64 * j); const f32x4 gg = *(const f32x4*)(g + c), ss = *(const f32x4*)(sc + c), hh = *(const f32x4*)(sh + c);
            const f32x4 y = (v[j] * rstd * gg) * (ss + 1.0f) + hh; v2u o; o.x = pk2(y.x, y.y); o.y = pk2(y.z, y.w); *(v2u*)(H + (size_t)row * DM + c) = o; }
    }
}
__device__ __forceinline__ void final_norm_phase(Frame& F) {
    const float* X = (const float*)(F.ws + WS_XS); const float* g = F.in[I_FINALG];
    for (int row = F.gw; row < ML; row += F.ngw) {
        const float* xr = X + (size_t)row * DM; f32x4 v[8]; float s = 0.f;
#pragma unroll
        for (int j = 0; j < 8; ++j) { v[j] = *(const f32x4*)(xr + 4 * (F.lane + 64 * j)); s += (v[j].x * v[j].x + v[j].y * v[j].y) + (v[j].z * v[j].z + v[j].w * v[j].w); }
        const float rstd = 1.0f / sqrtf(wave_sum(s) * (1.0f / DM) + EPS);
#pragma unroll
        for (int j = 0; j < 8; ++j) { const int c = 4 * (F.lane + 64 * j); *(f32x4*)(F.out + (size_t)row * DM + c) = v[j] * rstd * *(const f32x4*)(g + c); }
    }
}
__device__ __forceinline__ int s5_row(int i, int dir, int b) { if (i < CTXL) { const int j = dir ? CTXL - 1 - i : i; return ML + b * CTXL + j; } const int t = i - CTXL; return b * SEQ + (dir ? SEQ - 1 - t : t); }
__device__ __forceinline__ void s5_scan_phase(Frame& F) {
    const float* const* in = F.in; const bf16* P = (const bf16*)(F.ws + WS_BIG); const int lane = F.lane;
    for (int item = F.gw; item < NB * 64 * 2; item += F.ngw) {
        const int dir = item & 1, g = (item >> 1) & 63, b = item >> 7, gp = (dir * 64 + g) * 64 + lane;
        const float are = in[I_S5ARE][gp], aim = in[I_S5AIM][gp], dt = expf(in[I_S5LOGDT][dir * 64 + g]);
        const float er = expf(are * dt); float sn, cs; sincosf(aim * dt, &sn, &cs);
        const float abr = er * cs, abi = er * sn, nr = abr - 1.0f, ni = abi, den = are * are + aim * aim;
        const float cr = (nr * are + ni * aim) / den, ci = (ni * are - nr * aim) / den;
        float Br[16], Bi[16], Cr[16], Ci[16];
#pragma unroll
        for (int h = 0; h < 16; ++h) { const float br = in[I_S5BRE][(size_t)gp * 16 + h], bi = in[I_S5BIM][(size_t)gp * 16 + h]; Br[h] = cr * br - ci * bi; Bi[h] = cr * bi + ci * br;
            Cr[h] = in[I_S5CRE][((size_t)(dir * 64 + g) * 16 + h) * 64 + lane]; Ci[h] = in[I_S5CIM][((size_t)(dir * 64 + g) * 16 + h) * 64 + lane]; }
        float* Y = (float*)(F.ws + (dir ? WS_YR : WS_YF));
        float sr = 0.f, si = 0.f;
        float cur = bf2f(P[(size_t)s5_row(lane >> 4, dir, b) * EVEN_IN + g * 16 + (lane & 15)]);
        for (int i0 = 0; i0 < CTXL + SEQ; i0 += 4) {
            float nxt = 0.f;
            if (i0 + 4 < CTXL + SEQ) nxt = bf2f(P[(size_t)s5_row(i0 + 4 + (lane >> 4), dir, b) * EVEN_IN + g * 16 + (lane & 15)]);
#pragma unroll
            for (int s = 0; s < 4; ++s) {
                if (i0 + s == CTXL && false) {}
                float bur = 0.f, bui = 0.f;
#pragma unroll
                for (int h = 0; h < 16; ++h) { const float u = rdlane(cur, s * 16 + h); bur += Br[h] * u; bui += Bi[h] * u; }
                const float nsr = abr * sr - abi * si + bur, nsi = abr * si + abi * sr + bui; sr = nsr; si = nsi;
                float v[16];
#pragma unroll
                for (int h = 0; h < 16; ++h) v[h] = Cr[h] * sr - Ci[h] * si;
                float w8[8];
#pragma unroll
                for (int k = 0; k < 8; ++k) { const bool hi = (lane & 32) != 0; const float send = hi ? v[k] : v[k + 8], keep = hi ? v[k + 8] : v[k]; w8[k] = keep + __shfl_xor(send, 32); }
                float w4[4];
#pragma unroll
                for (int k = 0; k < 4; ++k) { const bool hi = (lane & 16) != 0; const float send = hi ? w8[k] : w8[k + 4], keep = hi ? w8[k + 4] : w8[k]; w4[k] = keep + __shfl_xor(send, 16); }
                float w2[2];
#pragma unroll
                for (int k = 0; k < 2; ++k) { const bool hi = (lane & 8) != 0; const float send = hi ? w4[k] : w4[k + 2], keep = hi ? w4[k + 2] : w4[k]; w2[k] = keep + __shfl_xor(send, 8); }
                float w1; { const bool hi = (lane & 4) != 0; const float send = hi ? w2[0] : w2[1], keep = hi ? w2[1] : w2[0]; w1 = keep + __shfl_xor(send, 4); }
                w1 += __shfl_xor(w1, 1); w1 += __shfl_xor(w1, 2);
                if ((lane & 3) == 0) Y[(size_t)s5_row(i0 + s, dir, b) * 1024 + g * 16 + (lane >> 2)] = w1;
            }
            cur = nxt;
        }
    }
}
__device__ __forceinline__ float gelu_tanh(float x) { return 0.5f * x * (1.0f + tanhf(0.7978845608028654f * (x + 0.044715f * x * x * x))); }
__device__ __forceinline__ void s5_post_phase(Frame& F) {
    const bf16* P = (const bf16*)(F.ws + WS_BIG); const float* YF = (const float*)(F.ws + WS_YF); const float* YR = (const float*)(F.ws + WS_YR); bf16* G = (bf16*)(F.ws + WS_G); const float* dd = F.in[I_S5D];
    for (size_t i = (size_t)blockIdx.x * 512 + F.tid; i < (size_t)MT * 512; i += (size_t)F.G * 512) {
        const size_t row = i >> 9; const int c = (int)(i & 511) * 2;
        const unsigned uu = *(const unsigned*)(P + row * EVEN_IN + c);
        const float y0 = dd[c] * bf2f(uu & 0xffffu) + YF[row * 1024 + c] + YR[row * 1024 + c], y1 = dd[c + 1] * bf2f(uu >> 16) + YF[row * 1024 + c + 1] + YR[row * 1024 + c + 1];
        *(unsigned*)(G + row * 1024 + c) = pk2(gelu_tanh(y0), gelu_tanh(y1)); }
}
__device__ __forceinline__ void na_naive_phase(Frame& F) {
    const bf16* P = (const bf16*)(F.ws + WS_BIG); bf16* MIX = (bf16*)(F.ws + WS_MIX); const float* rpb = F.in[I_RPB]; const int lane = F.lane;
    LAS float* qs = (LAS float*)(F.lds + F.wave * 2048); LAS float* ps = qs + 128;
    const float scale = 0.08838834764831845f;
    for (int item = F.gw; item < NB * 8 * (SEQ + CTXL); item += F.ngw) {
        int b, h, qrow, nloc, r = 0, qc = 0, rs = 0, cs = 0;
        if (item < NB * 8 * SEQ) { const int t = item & 2047; h = (item >> 11) & 7; b = item >> 14; qrow = b * SEQ + t; nloc = 128; r = t >> 6; qc = t & 63;
            rs = min(max(r - 4, 0), 24); cs = min(max(qc - 8, 0), 48); }
        else { const int i2 = item - NB * 8 * SEQ, j = i2 & 255; h = (i2 >> 8) & 7; b = i2 >> 11; qrow = ML + b * CTXL + j; nloc = 0; }
        const int nkeys = nloc + CTXL;
        { const unsigned qq = *(const unsigned*)(P + (size_t)qrow * EVEN_IN + 1024 + h * 128 + 2 * lane); qs[2 * lane] = bf2f(qq & 0xffffu); qs[2 * lane + 1] = bf2f(qq >> 16); }
        asm volatile("s_waitcnt lgkmcnt(0)" ::: "memory");
        float sc[6]; float mx = -3.0e38f;
#pragma unroll
        for (int it = 0; it < 6; ++it) {
            const int kk = it * 64 + lane; sc[it] = -3.0e38f;
            if (kk < nkeys) {
                int krow; float bias = 0.f;
                if (kk < nloc) { const int jj = kk >> 4, ci = kk & 15; krow = b * SEQ + (rs + jj) * 64 + cs + ci; const int dc = min(max(cs + ci - qc + 15, 0), 30); bias = rpb[(h * 15 + (rs + jj - r + 7)) * 31 + dc]; }
                else krow = ML + b * CTXL + (kk - nloc);
                const v4u* kp = (const v4u*)(P + (size_t)krow * EVEN_IN + 2048 + h * 128); float dot = 0.f;
#pragma unroll 4
                for (int c8 = 0; c8 < 16; ++c8) { const v4u kv = kp[c8]; const LAS f32x4* q4 = (const LAS f32x4*)(qs + c8 * 8); const f32x4 qa = q4[0], qb = q4[1];
                    dot += qa.x * bf2f(kv.x & 0xffffu) + qa.y * bf2f(kv.x >> 16) + qa.z * bf2f(kv.y & 0xffffu) + qa.w * bf2f(kv.y >> 16)
                         + qb.x * bf2f(kv.z & 0xffffu) + qb.y * bf2f(kv.z >> 16) + qb.z * bf2f(kv.w & 0xffffu) + qb.w * bf2f(kv.w >> 16); }
                sc[it] = dot * scale + bias; }
            mx = fmaxf(mx, sc[it]); }
        mx = wave_max(mx); float sum = 0.f;
#pragma unroll
        for (int it = 0; it < 6; ++it) { const int kk = it * 64 + lane; const float p = (kk < nkeys) ? __expf(sc[it] - mx) : 0.f; sum += p; ps[kk] = p; }
        sum = wave_sum(sum);
        asm volatile("s_waitcnt lgkmcnt(0)" ::: "memory");
        float o0 = 0.f, o1 = 0.f;
#pragma unroll 4
        for (int kk = 0; kk < nkeys; ++kk) {
            int krow; if (kk < nloc) krow = b * SEQ + (rs + (kk >> 4)) * 64 + cs + (kk & 15); else krow = ML + b * CTXL + (kk - nloc);
            const unsigned vv = *(const unsigned*)(P + (size_t)krow * EVEN_IN + 3072 + h * 128 + 2 * lane); const float p = ps[kk];
            o0 += p * bf2f(vv & 0xffffu); o1 += p * bf2f(vv >> 16); }
        const float inv = 1.0f / sum;
        *(unsigned*)(MIX + (size_t)qrow * DM + 1024 + h * 128 + 2 * lane) = pk2(o0 * inv, o1 * inv);
        asm volatile("s_waitcnt lgkmcnt(0)" ::: "memory");
    }
}
__device__ __forceinline__ void ssd_prep_phase(Frame& F) {
    const bf16* P1 = (const bf16*)(F.ws + WS_BIG); bf16* XBC = (bf16*)(F.ws + WS_XBC); const float* cw = F.in[I_SSDCW]; const float* cb = F.in[I_SSDCB];
    for (size_t i = (size_t)blockIdx.x * 512 + F.tid; i < (size_t)MT * 256; i += (size_t)F.G * 512) {
        const int row = (int)(i >> 8), c0 = (int)(i & 255) * 8; int pos, len; if (row < ML) { pos = row & 2047; len = SEQ; } else { pos = (row - ML) & 255; len = CTXL; }
        const bf16* pr = P1 + (size_t)row * ODD_LD + 4096 + c0; const v4u z4 = (v4u){0u, 0u, 0u, 0u};
        const v4u a = pos > 0 ? *(const v4u*)(pr - ODD_LD) : z4, m = *(const v4u*)pr, n = pos < len - 1 ? *(const v4u*)(pr + ODD_LD) : z4;
        unsigned o[4];
#pragma unroll
        for (int j = 0; j < 4; ++j) { const int c = c0 + 2 * j;
            const float y0 = cw[c] * bf2f(a[j] & 0xffffu) + cw[2048 + c] * bf2f(m[j] & 0xffffu) + cw[4096 + c] * bf2f(n[j] & 0xffffu) + cb[c];
            const float y1 = cw[c + 1] * bf2f(a[j] >> 16) + cw[2048 + c + 1] * bf2f(m[j] >> 16) + cw[4096 + c + 1] * bf2f(n[j] >> 16) + cb[c + 1];
            o[j] = pk2(silu_f(y0), silu_f(y1)); }
        *(v4u*)(XBC + (size_t)row * 2048 + c0) = (v4u){o[0], o[1], o[2], o[3]}; }
}
__device__ __forceinline__ float softplus_f(float x) { return x > 20.f ? x : log1pf(expf(x)); }
__device__ __forceinline__ void ssd_scan_phase(Frame& F) {
    const bf16* XBC = (const bf16*)(F.ws + WS_XBC); const float* DT = (const float*)(F.ws + WS_DT); bf16* YS = (bf16*)(F.ws + WS_YS);
    for (int item = blockIdx.x; item < NB * 16 * 2; item += F.G) {
        const int dir = item & 1, hd = (item >> 1) & 15, b = item >> 5, g = hd >> 2, p = F.tid >> 3, ns = F.tid & 7;
        const float dtb = F.in[I_SSDDTB][dir * 16 + hd], a = -expf(F.in[I_SSDALOG][dir * 16 + hd]);
        float S[16];
#pragma unroll
        for (int i = 0; i < 16; ++i) S[i] = 0.f;
        int row = s5_row(0, dir, b);
        float dtr = DT[(size_t)row * 32 + dir * 16 + hd]; unsigned xr = XBC[(size_t)row * 2048 + hd * 64 + p];
        v4u bq0 = *(const v4u*)(XBC + (size_t)row * 2048 + 1024 + g * 128 + ns * 16), bq1 = *(const v4u*)(XBC + (size_t)row * 2048 + 1024 + g * 128 + ns * 16 + 8);
        v4u cq0 = *(const v4u*)(XBC + (size_t)row * 2048 + 1536 + g * 128 + ns * 16), cq1 = *(const v4u*)(XBC + (size_t)row * 2048 + 1536 + g * 128 + ns * 16 + 8);
        for (int i = 0; i < CTXL + SEQ; ++i) {
            const int rown = s5_row(i + 1 < CTXL + SEQ ? i + 1 : i, dir, b);
            const float dtr_n = DT[(size_t)rown * 32 + dir * 16 + hd]; const unsigned xr_n = XBC[(size_t)rown * 2048 + hd * 64 + p];
            const v4u bn0 = *(const v4u*)(XBC + (size_t)rown * 2048 + 1024 + g * 128 + ns * 16), bn1 = *(const v4u*)(XBC + (size_t)rown * 2048 + 1024 + g * 128 + ns * 16 + 8);
            const v4u cn0 = *(const v4u*)(XBC + (size_t)rown * 2048 + 1536 + g * 128 + ns * 16), cn1 = *(const v4u*)(XBC + (size_t)rown * 2048 + 1536 + g * 128 + ns * 16 + 8);
            const float dt = softplus_f(dtr + dtb), dA = __expf(dt * a), dx = dt * bf2f(xr);
            float y = 0.f;
#pragma unroll
            for (int j = 0; j < 4; ++j) {
                S[2 * j] = S[2 * j] * dA + dx * bf2f(bq0[j] & 0xffffu); S[2 * j + 1] = S[2 * j + 1] * dA + dx * bf2f(bq0[j] >> 16);
                S[8 + 2 * j] = S[8 + 2 * j] * dA + dx * bf2f(bq1[j] & 0xffffu); S[8 + 2 * j + 1] = S[8 + 2 * j + 1] * dA + dx * bf2f(bq1[j] >> 16);
                y += S[2 * j] * bf2f(cq0[j] & 0xffffu) + S[2 * j + 1] * bf2f(cq0[j] >> 16) + S[8 + 2 * j] * bf2f(cq1[j] & 0xffffu) + S[8 + 2 * j + 1] * bf2f(cq1[j] >> 16); }
            y += __shfl_xor(y, 1); y += __shfl_xor(y, 2); y += __shfl_xor(y, 4);
            if (ns == 0 && row < ML) YS[((size_t)dir * ML + row) * 1024 + hd * 64 + p] = (bf16)f2bf(y);
            row = rown; dtr = dtr_n; xr = xr_n; bq0 = bn0; bq1 = bn1; cq0 = cn0; cq1 = cn1;
        }
    }
}
__device__ __forceinline__ void ssd_out_phase(Frame& F) {
    const bf16* XBC = (const bf16*)(F.ws + WS_XBC); const bf16* YS = (const bf16*)(F.ws + WS_YS); const bf16* P1 = (const bf16*)(F.ws + WS_BIG); bf16* MIX = (bf16*)(F.ws + WS_MIX);
    const float* dsk = F.in[I_SSDD]; const float* ng = F.in[I_SSDNG];
    for (int row = F.gw; row < ML; row += F.ngw) {
        float y[16]; float s = 0.f;
#pragma unroll
        for (int j = 0; j < 2; ++j) { const int c0 = 8 * F.lane + 512 * j;
            const v4u a0 = *(const v4u*)(YS + (size_t)row * 1024 + c0), a1 = *(const v4u*)(YS + ((size_t)ML + row) * 1024 + c0), xx = *(const v4u*)(XBC + (size_t)row * 2048 + c0), zz = *(const v4u*)(P1 + (size_t)row * ODD_LD + 3072 + c0);
            const float dk = dsk[c0 >> 6];
#pragma unroll
            for (int q = 0; q < 4; ++q) {
                const float v0 = (bf2f(a0[q] & 0xffffu) + bf2f(a1[q] & 0xffffu) + dk * bf2f(xx[q] & 0xffffu)) * silu_f(bf2f(zz[q] & 0xffffu));
                const float v1 = (bf2f(a0[q] >> 16) + bf2f(a1[q] >> 16) + dk * bf2f(xx[q] >> 16)) * silu_f(bf2f(zz[q] >> 16));
                y[8 * j + 2 * q] = v0; y[8 * j + 2 * q + 1] = v1; s += v0 * v0 + v1 * v1; } }
        const float rstd = 1.0f / sqrtf(wave_sum(s) * (1.0f / 1024.0f) + EPS);
#pragma unroll
        for (int j = 0; j < 2; ++j) { const int c0 = 8 * F.lane + 512 * j; unsigned o[4];
#pragma unroll
            for (int q = 0; q < 4; ++q) o[q] = pk2(y[8 * j + 2 * q] * rstd * ng[c0 + 2 * q], y[8 * j + 2 * q + 1] * rstd * ng[c0 + 2 * q + 1]);
            *(v4u*)(MIX + (size_t)row * DM + 1024 + c0) = (v4u){o[0], o[1], o[2], o[3]}; }
    }
}
__device__ __forceinline__ void hyena_prep_phase(Frame& F) {
    const bf16* P1 = (const bf16*)(F.ws + WS_BIG); const float* sw = F.in[I_HYSW]; const float* sb = F.in[I_HYSB]; const int lane = F.lane;
    LAS float* tile = (LAS float*)(F.lds + F.wave * 16896);
    for (int item = F.gw; item < 3 * 16 * NB * 32; item += F.ngw) {
        const int tb = item & 31, b = (item >> 5) & 7, cbk = (item >> 8) & 15, part = item >> 12;
        const int col = part * 1024 + cbk * 64 + lane, t0 = tb * 64;
        const float w0 = sw[col], w1 = sw[3072 + col], w2 = sw[6144 + col], bb = sb[col];
        const bf16* base = P1 + (size_t)(b * SEQ) * ODD_LD + col;
        float prev = t0 > 0 ? bf2f(base[(size_t)(t0 - 1) * ODD_LD]) : 0.f, cur = bf2f(base[(size_t)t0 * ODD_LD]);
        for (int tl = 0; tl < 64; ++tl) { const int t = t0 + tl; const float nxt = t + 1 < SEQ ? bf2f(base[(size_t)(t + 1) * ODD_LD]) : 0.f;
            tile[tl * 65 + lane] = w0 * prev + w1 * cur + w2 * nxt + bb; prev = cur; cur = nxt; }
        asm volatile("s_waitcnt lgkmcnt(0)" ::: "memory");
        bf16* dst = (bf16*)(F.ws + (part == 0 ? WS_X1C : part == 1 ? WS_X2C : WS_VC)) + ((size_t)(cbk * 64) * NB + b) * SEQ + t0 + lane;
        for (int c = 0; c < 64; ++c) dst[(size_t)c * NB * SEQ] = (bf16)f2bf(tile[lane * 65 + c]);
        asm volatile("s_waitcnt lgkmcnt(0)" ::: "memory");
    }
}
__device__ __forceinline__ void hyena_conv_phase(Frame& F, int order) {
    LAS float* kf = (LAS float*)F.lds; LAS float* ub = kf + 4096;
    const float* FILT = (const float*)(F.ws + WS_FILT); const bf16* U = (const bf16*)(F.ws + (order == 0 ? WS_VC : WS_ZC)); const bf16* GT = (const bf16*)(F.ws + (order == 0 ? WS_X1C : WS_X2C));
    bf16* ZC = (bf16*)(F.ws + WS_ZC); bf16* MIX = (bf16*)(F.ws + WS_MIX);
    for (int c = blockIdx.x; c < 1024; c += F.G) {
        __syncthreads();
        for (int i = F.tid; i < 4096; i += 512) kf[i] = i < 4095 ? FILT[(size_t)(order * 1024 + c) * 4096 + i] : 0.f;
        for (int i = F.tid; i < NB * SEQ; i += 512) ub[i] = bf2f(U[(size_t)c * NB * SEQ + i]);
        __syncthreads();
        float acc[4][8];
#pragma unroll
        for (int i = 0; i < 4; ++i)
#pragma unroll
            for (int b = 0; b < 8; ++b) acc[i][b] = 0.f;
        const LAS float* kp = kf + F.tid + 2047;
#pragma unroll 2
        for (int s = 0; s < SEQ; ++s) {
            float u8[8];
#pragma unroll
            for (int b = 0; b < 8; ++b) u8[b] = ub[b * SEQ + s];
#pragma unroll
            for (int i = 0; i < 4; ++i) { const float kv = kp[512 * i - s];
#pragma unroll
                for (int b = 0; b < 8; ++b) acc[i][b] += kv * u8[b]; } }
        const float fb = F.in[I_HYFBIAS][order * 1024 + c];
#pragma unroll
        for (int i = 0; i < 4; ++i) { const int t = F.tid + 512 * i;
#pragma unroll
            for (int b = 0; b < 8; ++b) { const float gt = bf2f(GT[((size_t)c * NB + b) * SEQ + t]); const float v = gt * (acc[i][b] + ub[b * SEQ + t] * fb);
                if (order == 0) ZC[((size_t)c * NB + b) * SEQ + t] = (bf16)f2bf(v); else MIX[((size_t)b * SEQ + t) * DM + c] = (bf16)f2bf(v); } }
    }
    __syncthreads();
}
#define XB_TMO      128
#define XB_XCNT(j)  (256  + 64 * (j))
#define XB_XSUB(j)  (1280 + 64 * (j))
#define XB_XGEN(j)  (2304 + 64 * (j))
#define XB_TOP      3328
#define XB_TOPGEN   3392
#define XCD_BAR_WORDS 3456
#define XB_SPIN_CAP (1u << 18)

__device__ __forceinline__ unsigned xb_ld(unsigned* p)              { return __hip_atomic_load(p, __ATOMIC_RELAXED, __HIP_MEMORY_SCOPE_AGENT); }
__device__ __forceinline__ unsigned xb_add(unsigned* p, unsigned v) { return __hip_atomic_fetch_add(p, v, __ATOMIC_RELAXED, __HIP_MEMORY_SCOPE_AGENT); }
__device__ __forceinline__ unsigned xb_xcc_id() { return (unsigned)__builtin_amdgcn_s_getreg((3 << 11) | 20) & 0xFu; }
#define XB_SPIN(cond, bar) do { unsigned _sp = 0; while (cond) { __builtin_amdgcn_s_sleep(1); \
    if ((++_sp & 255u) == 0u) { if (xb_ld(&(bar)[XB_TMO])) break; if (_sp > XB_SPIN_CAP) { atomicAdd(&(bar)[XB_TMO], 1u); break; } } } } while (0)

struct XcdBarrier {
    unsigned* bar; unsigned x;
    volatile LAS unsigned* st;
};

__device__ __forceinline__ XcdBarrier xcd_barrier_post(unsigned* bar, volatile LAS unsigned* st) {
    XcdBarrier b; b.bar = bar; b.x = xb_xcc_id(); b.st = st;
    if (threadIdx.x == 0) (void)xb_add(&bar[XB_XCNT(b.x)], 1u);
    return b;
}
__device__ __forceinline__ void xcd_barrier_complete(unsigned* bar, unsigned x, unsigned& nloc, unsigned& nx) {
    const unsigned G = gridDim.x * gridDim.y * gridDim.z;
    unsigned sum, cnt, mine, sp = 0u;
    for (;;) {
        sum = 0u; cnt = 0u; mine = 0u;
#pragma unroll
        for (unsigned j = 0; j < 16; ++j) { const unsigned c = xb_ld(&bar[XB_XCNT(j)]); sum += c; cnt += (c > 0u) ? 1u : 0u; mine = (j == x) ? c : mine; }
        if (sum == G) break;
        __builtin_amdgcn_s_sleep(1);
        if ((++sp & 255u) == 0u) { if (xb_ld(&bar[XB_TMO])) break; if (sp > XB_SPIN_CAP) { atomicAdd(&bar[XB_TMO], 1u); break; } }
    }
    nloc = mine > 0u ? mine : 1u; nx = cnt > 0u ? cnt : 1u;
}

__device__ __forceinline__ void xcd_barrier(const XcdBarrier& b) {
    asm volatile("s_waitcnt vmcnt(0)" ::: "memory");
    __syncthreads();
    if (threadIdx.x == 0) {
        unsigned* bar = b.bar;
        __builtin_amdgcn_s_waitcnt(0);
        unsigned nloc = b.st[0], nx = b.st[1];
        if (nloc == 0u) { xcd_barrier_complete(bar, b.x, nloc, nx); b.st[0] = nloc; b.st[1] = nx; }
        const unsigned old = xb_add(&bar[XB_XSUB(b.x)], 1u);
        const unsigned gen = old / nloc;
        if (old + 1u == (gen + 1u) * nloc) {
            __builtin_amdgcn_fence(__ATOMIC_RELEASE, "agent");
            asm volatile("s_waitcnt vmcnt(0)" ::: "memory");
            const unsigned og = xb_add(&bar[XB_TOP], 1u);
            const unsigned tg = og / nx;
            if (og + 1u == (tg + 1u) * nx) xb_add(&bar[XB_TOPGEN], 1u);
            else XB_SPIN(xb_ld(&bar[XB_TOPGEN]) == tg, bar);
            __builtin_amdgcn_fence(__ATOMIC_ACQUIRE, "agent");
            xb_add(&bar[XB_XGEN(b.x)], 1u);
            asm volatile("s_waitcnt vmcnt(0)" ::: "memory");
        } else {
            XB_SPIN(xb_ld(&bar[XB_XGEN(b.x)]) == gen, bar);
            __builtin_amdgcn_fence(__ATOMIC_ACQUIRE, "agent");
            asm volatile("s_waitcnt vmcnt(0)" ::: "memory");
        }
    }
    __syncthreads();
}

#ifndef MK_ONE_LAUNCH
#define MK_ONE_LAUNCH 0
#endif
#ifndef RUN_MASK
#define RUN_MASK 0xFFFFFFFFu
#endif
constexpr int NPH = 27;
__global__ void __launch_bounds__(NWAVES * 64, 2) mega_fwd(Args args) {
    extern __shared__ __attribute__((aligned(16))) unsigned char lds_raw[];
    Frame F;
    F.lds = (LAS unsigned char*)lds_raw; F.in = args.in; F.out = args.out; F.ws = args.ws;
    F.tid = threadIdx.x; F.lane = F.tid & 63; F.wave = __builtin_amdgcn_readfirstlane(F.tid >> 6); F.G = gridDim.x;
    F.gw = blockIdx.x * NWAVES + F.wave; F.ngw = F.G * NWAVES;
    volatile LAS unsigned* MISC = (volatile LAS unsigned*)(F.lds + MISC_OFF);
    for (int u = F.tid; u < (LDS_BYTES - LDSCTL_OFF) / 4; u += NWAVES * 64) ((LAS unsigned*)(F.lds + LDSCTL_OFF))[u] = 0u;
    __syncthreads();
    unsigned* ctl = (unsigned*)(args.ws + WS_CTL);
    XcdBarrier bar; bar.bar = ctl + CW_BAR; bar.x = 0; bar.st = nullptr;
    const int lo = args.ph_lo, hi = args.ph_hi;
    if (hi - lo > 1) bar = xcd_barrier_post(ctl + CW_BAR, MISC + 8);
#define IN(k) (lo <= (k) && (k) < hi && ((RUN_MASK >> (k)) & 1u))
#define SEAM(k) do { if ((k) + 1 < hi) xcd_barrier(bar); } while (0)
    unsigned char* ws = args.ws;
    bf16* H = (bf16*)(ws + WS_H); bf16* BIG = (bf16*)(ws + WS_BIG); bf16* MIX = (bf16*)(ws + WS_MIX); float* XS = (float*)(ws + WS_XS);
    const float* MV0 = (const float*)(ws + WS_MODV); const float* MV1 = MV0 + (size_t)9 * NMODC;
    LAS unsigned char* ring = F.lds;

#define GEMM_GATEUP(lab, Mrows) do { pg8::Gemm g{H, (const bf16*)(ws + WS_WGU + (size_t)(lab) * SZ_WGU), (Mrows), 2 * DFF, DM}; pg8::StaticOrder S; S.init((Mrows), 2 * DFF, F.G, (int)blockIdx.x); \
        pg8::EpiSwiglu E{BIG, DFF}; pg8::gemm_phase<pg8::EpiSwiglu, pg8::StaticOrder, true, true>(ring, g, S, E); } while (0)
#define GEMM_DOWN(lab, Mrows, bL, bC, mv, gi, sc) do { pg8::Gemm g{BIG, (const bf16*)(ws + WS_WD + (size_t)(lab) * SZ_WD), (Mrows), DM, DFF}; pg8::StaticOrder S; S.init((Mrows), DM, F.G, (int)blockIdx.x); \
        pg8::EpiResid E{(bL), (bC), XS, (mv), (gi), (sc)}; pg8::gemm_phase<pg8::EpiResid, pg8::StaticOrder, true, true>(ring, g, S, E); } while (0)

    if (lo <= 0 && 0 < hi) { if ((RUN_MASK >> 0) & 1u) p0_prologue(F); SEAM(0); }
    if (lo <= 1 && 1 < hi) { if ((RUN_MASK >> 1) & 1u) p1_modred(F); SEAM(1); }
    if (lo <= 2 && 2 < hi) { if (IN(2)) prenorm_phase(F, F.in[I_X], F.in[I_CTX], MT, 0, 0); SEAM(2); }
    if (lo <= 3 && 3 < hi) { if (IN(3)) GEMM_GATEUP(0, MT); SEAM(3); }
    if (lo <= 4 && 4 < hi) { if (IN(4)) GEMM_DOWN(0, MT, F.in[I_X], F.in[I_CTX], MV0, 2, 0.5f); SEAM(4); }
    if (lo <= 5 && 5 < hi) { if (IN(5)) prenorm_phase(F, XS, XS + (size_t)ML * DM, MT, 0, 1); SEAM(5); }
    if (lo <= 6 && 6 < hi) { if (IN(6)) { pg8::Gemm g{H, (const bf16*)(ws + WS_WEVIN), MT, EVEN_IN, DM}; pg8::StaticOrder S; S.init(MT, EVEN_IN, F.G, (int)blockIdx.x);
            pg8::EpiPlain E{BIG, EVEN_IN, nullptr}; pg8::gemm_phase<pg8::EpiPlain, pg8::StaticOrder, true, true>(ring, g, S, E); } SEAM(6); }
    if (lo <= 7 && 7 < hi) { if (IN(7)) { s5_scan_phase(F); na_naive_phase(F); } SEAM(7); }
    if (lo <= 8 && 8 < hi) { if (IN(8)) s5_post_phase(F); SEAM(8); }
    if (lo <= 9 && 9 < hi) { if (IN(9)) { pg8::Gemm g{(const bf16*)(ws + WS_G), (const bf16*)(ws + WS_WGLU), MT, 1024, 1024}; pg8::StaticOrder S; S.init(MT, 1024, F.G, (int)blockIdx.x);
            pg8::EpiGlu E{(const bf16*)(ws + WS_G), F.in[I_GLUB], MIX}; pg8::gemm_phase<pg8::EpiGlu, pg8::StaticOrder, true, true>(ring, g, S, E); } SEAM(9); }
    if (lo <= 10 && 10 < hi) { if (IN(10)) { pg8::Gemm g{MIX, (const bf16*)(ws + WS_WEVOUT), MT, DM, DM}; pg8::StaticOrder S; S.init(MT, DM, F.G, (int)blockIdx.x);
            pg8::EpiResid E{XS, XS + (size_t)ML * DM, XS, MV0, 5, 1.0f}; pg8::gemm_phase<pg8::EpiResid, pg8::StaticOrder, true, true>(ring, g, S, E); } SEAM(10); }
    if (lo <= 11 && 11 < hi) { if (IN(11)) prenorm_phase(F, XS, XS + (size_t)ML * DM, MT, 0, 2); SEAM(11); }
    if (lo <= 12 && 12 < hi) { if (IN(12)) GEMM_GATEUP(1, MT); SEAM(12); }
    if (lo <= 13 && 13 < hi) { if (IN(13)) GEMM_DOWN(1, MT, XS, XS + (size_t)ML * DM, MV0, 8, 0.5f); SEAM(13); }
    if (lo <= 14 && 14 < hi) { if (IN(14)) prenorm_phase(F, XS, XS + (size_t)ML * DM, MT, 1, 0); SEAM(14); }
    if (lo <= 15 && 15 < hi) { if (IN(15)) GEMM_GATEUP(2, MT); SEAM(15); }
    if (lo <= 16 && 16 < hi) { if (IN(16)) GEMM_DOWN(2, MT, XS, XS + (size_t)ML * DM, MV1, 2, 0.5f); SEAM(16); }
    if (lo <= 17 && 17 < hi) { if (IN(17)) prenorm_phase(F, XS, XS + (size_t)ML * DM, MT, 1, 1); SEAM(17); }
    if (lo <= 18 && 18 < hi) { if (IN(18)) { pg8::Gemm g{H, (const bf16*)(ws + WS_WODIN), MT, ODD_INP, DM}; pg8::StaticOrder S; S.init(MT, ODD_INP, F.G, (int)blockIdx.x);
            pg8::EpiPlain E{BIG, ODD_LD, (float*)(ws + WS_DT)}; pg8::gemm_phase<pg8::EpiPlain, pg8::StaticOrder, true, true>(ring, g, S, E); } SEAM(18); }
    if (lo <= 19 && 19 < hi) { if (IN(19)) { hyena_prep_phase(F); ssd_prep_phase(F); } SEAM(19); }
    if (lo <= 20 && 20 < hi) { if (IN(20)) { ssd_scan_phase(F); hyena_conv_phase(F, 0); } SEAM(20); }
    if (lo <= 21 && 21 < hi) { if (IN(21)) { hyena_conv_phase(F, 1); ssd_out_phase(F); } SEAM(21); }
    if (lo <= 22 && 22 < hi) { if (IN(22)) { pg8::Gemm g{MIX, (const bf16*)(ws + WS_WODOUT), ML, DM, DM}; pg8::StaticOrder S; S.init(ML, DM, F.G, (int)blockIdx.x);
            pg8::EpiResid E{XS, XS + (size_t)ML * DM, XS, MV1, 5, 1.0f}; pg8::gemm_phase<pg8::EpiResid, pg8::StaticOrder, true, true>(ring, g, S, E); } SEAM(22); }
    if (lo <= 23 && 23 < hi) { if (IN(23)) prenorm_phase(F, XS, XS + (size_t)ML * DM, ML, 1, 2); SEAM(23); }
    if (lo <= 24 && 24 < hi) { if (IN(24)) GEMM_GATEUP(3, ML); SEAM(24); }
    if (lo <= 25 && 25 < hi) { if (IN(25)) GEMM_DOWN(3, ML, XS, XS + (size_t)ML * DM, MV1, 8, 0.5f); SEAM(25); }
    if (lo <= 26 && 26 < hi) { if (IN(26)) final_norm_phase(F); }
#undef IN
#undef SEAM
}

extern "C" void kernel_launch(void* const* d_in, const int* in_sizes, int n_in, void* d_out, int out_size, void* d_ws, size_t ws_size, hipStream_t stream) {
    static int grid = 0;
    if (grid == 0) {
        if (n_in != N_IN || out_size != ML * DM || ws_size < WS_END) { fprintf(stderr, "kernel_launch: unexpected shapes: n_in %d out %d ws %zu (need %zu)\n", n_in, out_size, ws_size, (size_t)WS_END); grid = -1; return; }
        int dev = 0, cus = 0, per_cu = 0;
        if (hipGetDevice(&dev) != hipSuccess || hipDeviceGetAttribute(&cus, hipDeviceAttributeMultiprocessorCount, dev) != hipSuccess) { grid = -1; return; }
        if (hipFuncSetAttribute((const void*)mega_fwd, hipFuncAttributeMaxDynamicSharedMemorySize, LDS_BYTES) != hipSuccess) { fprintf(stderr, "kernel_launch: hipFuncSetAttribute failed\n"); grid = -1; return; }
        if (hipOccupancyMaxActiveBlocksPerMultiprocessor(&per_cu, (const void*)mega_fwd, NWAVES * 64, LDS_BYTES) != hipSuccess || per_cu < 1) fprintf(stderr, "kernel_launch: occupancy query reports %d\n", per_cu);
        (void)hipGetLastError();
        grid = cus;
    }
    if (grid < 0) return;
    (void)in_sizes;
    if (hipMemsetAsync((char*)d_ws + WS_CTL, 0, CTL_ZERO_BYTES, stream) != hipSuccess) return;
    Args a{};
    for (int i = 0; i < N_IN; ++i) a.in[i] = (const float*)d_in[i];
    a.out = (float*)d_out; a.ws = (unsigned char*)d_ws;
#if MK_ONE_LAUNCH
    a.ph_lo = 0; a.ph_hi = NPH;
    hipLaunchKernelGGL(mega_fwd, dim3(grid), dim3(NWAVES * 64), LDS_BYTES, stream, a);
#else
    for (int p = 0; p < NPH; ++p) { if (!((RUN_MASK >> p) & 1u)) continue; a.ph_lo = p; a.ph_hi = p + 1; hipLaunchKernelGGL(mega_fwd, dim3(grid), dim3(NWAVES * 64), LDS_BYTES, stream, a); }
#endif
}
```

```cpp
#include <hip/hip_runtime.h>
#include <cstdio>
#include <cstdint>
#define REP_CODE -1
namespace pg8 {
#define PG8_LAS __attribute__((address_space(3)))
typedef unsigned short bf16_t;
typedef short bf16x8 __attribute__((ext_vector_type(8)));
typedef float f32x4 __attribute__((ext_vector_type(4)));
typedef unsigned u32x4 __attribute__((ext_vector_type(4)));
constexpr int BM = 256, BK = 64, HALF = 128, HTB = HALF * BK * 2  , STAGE_BYTES = 8 * HTB, NXCD = 8, WGM = 8;

__host__ __device__ __forceinline__ int lds_byte(int r, int c) { const int st = (r >> 4) * 2 + (c >> 5), rr = r & 15, cc = c & 31, ob = rr * 64 + cc * 2; return st * 1024 + (ob ^ (((ob >> 9) & 1) << 5)); }
__host__ __device__ __forceinline__ void stage_rc(int b, int& R, int& C) { const int st = b / 1024, sb = b % 1024, swz = sb ^ (((sb >> 9) & 1) << 5); R = (st >> 1) * 16 + swz / 64; C = (st & 1) * 32 + (swz % 64) / 2; }
__host__ __device__ __forceinline__ int perm32(int rho) { const int n = rho >> 4, i = rho & 15; return 8 * (i >> 2) + 4 * n + (i & 3); }

struct Unit { int pm, pn, kq; };
struct Gemm { const bf16_t* A; const bf16_t* Bt; int M, N, K; int ld = 0; int kcb = 0; };


struct StaticOrder {
    int nM, nN, nwg, G, c;
    __host__ __device__ void init(int M, int N, int G_, int c_) { nM = M / BM; nN = N / BM; nwg = nM * nN; G = G_; c = c_; }
    __host__ __device__ bool next(int i, Unit& u) const {
        const long L = (long)i * G + c; if (L >= nwg) return false;
        int wgid = (int)L; { const int q = nwg / NXCD, r = nwg % NXCD, xcd = wgid % NXCD, off = wgid / NXCD; wgid = (xcd < r ? xcd * (q + 1) : r * (q + 1) + (xcd - r) * q) + off; }
        const int nig = WGM * nN, gid = wgid / nig, fm = gid * WGM, gsz = (nM - fm) < WGM ? (nM - fm) : WGM;
        u.pm = fm + ((wgid % nig) % gsz); u.pn = (wgid % nig) / gsz; u.kq = 0; return true;
    }
    __device__ __forceinline__ void a_ready(const Unit&) const {}
    __device__ __forceinline__ void done(const Unit&) const {}
};
__device__ __forceinline__ unsigned cvt_pk_bf16(float lo, float hi) { unsigned r; asm volatile("v_cvt_pk_bf16_f32 %0, %1, %2" : "=v"(r) : "v"(lo), "v"(hi)); return r; }

__device__ __forceinline__ float fast_sigmoid(float x) { return __builtin_amdgcn_rcpf(1.0f + __builtin_amdgcn_exp2f(-1.4426950408889634f * x)); }
#ifndef EMU_D
#define EMU_D 0
#endif
#define EMU_D_FLAG EMU_D
__device__ __forceinline__ float q_e4m3_epi(float x) { const float ax = __builtin_fabsf(x); if (ax < 0.015625f) return __builtin_rintf(x * 512.0f) * (1.0f / 512.0f);
    unsigned u = __float_as_uint(x); u += 0x7FFFFu + ((u >> 20) & 1u); u &= 0xFFF00000u; const float r = __uint_as_float(u); return __builtin_fabsf(r) > 448.0f ? __builtin_copysignf(448.0f, x) : r; }
struct EpiSwiglu {
    static constexpr bool PERM = true, AFTER_DRAIN = false;
    bf16_t* O; int ldc;
    __device__ __forceinline__ void operator()(const f32x4 (&acc)[2][2][4][2], const Unit& u, int wr, int wc, int fr, int fq) const {
        const int row0 = u.pm * BM + wr * 64 + fr, col0 = u.pn * HALF + wc * 32 + 8 * fq;
#pragma unroll
        for (int ai = 0; ai < 2; ++ai)
#pragma unroll
            for (int m = 0; m < 4; ++m) { bf16_t* rowp = O + (size_t)(row0 + ai * HALF + m * 16) * ldc + col0;
                float h[8];
#pragma unroll
                for (int n = 0; n < 2; ++n)
#pragma unroll
                    for (int j = 0; j < 4; ++j) { const float g = acc[ai][0][m][n][j], up = acc[ai][1][m][n][j]; h[4 * n + j] = g * fast_sigmoid(g) * up; if (EMU_D_FLAG) h[4 * n + j] = q_e4m3_epi(h[4 * n + j] * 8.0f) * 0.125f; }
                u32x4 w; w.x = cvt_pk_bf16(h[0], h[1]); w.y = cvt_pk_bf16(h[2], h[3]); w.z = cvt_pk_bf16(h[4], h[5]); w.w = cvt_pk_bf16(h[6], h[7]);
                *(u32x4*)rowp = w; }
    }
};
#ifndef F8_DOWN
#define F8_DOWN 1
#endif
__device__ __forceinline__ unsigned pack4_fp8(float a, float b, float c, float d) {
    a = __builtin_fminf(__builtin_fmaxf(a, -448.f), 448.f); b = __builtin_fminf(__builtin_fmaxf(b, -448.f), 448.f); c = __builtin_fminf(__builtin_fmaxf(c, -448.f), 448.f); d = __builtin_fminf(__builtin_fmaxf(d, -448.f), 448.f);
    unsigned r = __builtin_amdgcn_cvt_pk_fp8_f32(a, b, 0u, false); return __builtin_amdgcn_cvt_pk_fp8_f32(c, d, r, true); }
struct EpiSwigluI8 {
    static constexpr bool PERM = true, AFTER_DRAIN = false;
    bf16_t* O; int ldc; const float* rs; const float* cs;
    __device__ __forceinline__ void hrow(const f32x4 (&acc)[2][2][4][2], int ai, int m, float r, const f32x4& cg0, const f32x4& cg1, const f32x4& cu0, const f32x4& cu1, float (&h)[8]) const {
#pragma unroll
        for (int n = 0; n < 2; ++n)
#pragma unroll
            for (int j = 0; j < 4; ++j) { const float g = (float)__float_as_int(acc[ai][0][m][n][j]) * (r * (n ? cg1[j] : cg0[j])), up = (float)__float_as_int(acc[ai][1][m][n][j]) * (r * (n ? cu1[j] : cu0[j]));
                h[4 * n + j] = g * fast_sigmoid(g) * up; if (EMU_D_FLAG) h[4 * n + j] = q_e4m3_epi(h[4 * n + j] * 8.0f) * 0.125f; }
    }
    __device__ __forceinline__ void operator()(const f32x4 (&acc)[2][2][4][2], const Unit& u, int wr, int wc, int fr, int fq) const {
        const int row0 = u.pm * BM + wr * 64 + fr, col0 = u.pn * HALF + wc * 32 + 8 * fq, brow0 = u.pn * BM + wc * 32 + 8 * fq;
        const f32x4 cg0 = *(const f32x4*)(cs + brow0), cg1 = *(const f32x4*)(cs + brow0 + 4), cu0 = *(const f32x4*)(cs + brow0 + HALF), cu1 = *(const f32x4*)(cs + brow0 + HALF + 4);
        if (F8_DOWN) {
            const bool odd = (fq & 1) != 0;
#pragma unroll
            for (int ai = 0; ai < 2; ++ai)
#pragma unroll
                for (int m = 0; m < 4; m += 2) { const int rowa = row0 + ai * HALF + m * 16, rowb = rowa + 16; float ha[8], hb[8];
                    hrow(acc, ai, m, rs[rowa], cg0, cg1, cu0, cu1, ha); hrow(acc, ai, m + 1, rs[rowb], cg0, cg1, cu0, cu1, hb);
                    const unsigned a0 = pack4_fp8(8.f * ha[0], 8.f * ha[1], 8.f * ha[2], 8.f * ha[3]), a1 = pack4_fp8(8.f * ha[4], 8.f * ha[5], 8.f * ha[6], 8.f * ha[7]);
                    const unsigned b0 = pack4_fp8(8.f * hb[0], 8.f * hb[1], 8.f * hb[2], 8.f * hb[3]), b1 = pack4_fp8(8.f * hb[4], 8.f * hb[5], 8.f * hb[6], 8.f * hb[7]);
                    const unsigned r0 = (unsigned)__shfl_xor((int)(odd ? a0 : b0), 16), r1 = (unsigned)__shfl_xor((int)(odd ? a1 : b1), 16);
                    unsigned char* rowp = (unsigned char*)O + (size_t)(odd ? rowb : rowa) * ldc + (odd ? col0 - 8 : col0);
                    *(u32x4*)rowp = odd ? (u32x4){r0, r1, b0, b1} : (u32x4){a0, a1, r0, r1}; }
        } else {
#pragma unroll
            for (int ai = 0; ai < 2; ++ai)
#pragma unroll
                for (int m = 0; m < 4; ++m) { const int row = row0 + ai * HALF + m * 16; float h[8]; hrow(acc, ai, m, rs[row], cg0, cg1, cu0, cu1, h);
                    bf16_t* rowp = O + (size_t)row * ldc + col0;
                    u32x4 w; w.x = cvt_pk_bf16(h[0], h[1]); w.y = cvt_pk_bf16(h[2], h[3]); w.z = cvt_pk_bf16(h[4], h[5]); w.w = cvt_pk_bf16(h[6], h[7]);
                    *(u32x4*)rowp = w; }
        }
    }
};
struct EpiResid {
    static constexpr bool PERM = false, AFTER_DRAIN = false;
    const float* baseL; const float* baseC; float* out; const float* modv; int gidx; float scale;
    __device__ __forceinline__ void operator()(const f32x4 (&acc)[2][2][4][2], const Unit& u, int wr, int wc, int fr, int fq) const {
        const int pm = u.pm, r = pm < 64 ? (pm >> 3) : 8;
        const float* gv = modv + (size_t)r * 18432 + gidx * 2048;
        const float* base = pm < 64 ? baseL + (size_t)pm * 256 * 2048 : baseC + (size_t)(pm - 64) * 256 * 2048;
        float* o = out + (size_t)pm * 256 * 2048;
        const int rowl = wr * 64 + fr, col0 = u.pn * BM + wc * 32 + 4 * fq;
        f32x4 gvv[2][2];
#pragma unroll
        for (int bj = 0; bj < 2; ++bj)
#pragma unroll
            for (int n = 0; n < 2; ++n) gvv[bj][n] = *(const f32x4*)(gv + col0 + bj * HALF + n * 16) * scale;
#pragma unroll
        for (int ai = 0; ai < 2; ++ai)
#pragma unroll
            for (int m = 0; m < 4; ++m) { const size_t off = (size_t)(rowl + ai * HALF + m * 16) * 2048 + col0;
#pragma unroll
                for (int bj = 0; bj < 2; ++bj)
#pragma unroll
                    for (int n = 0; n < 2; ++n) { const f32x4 bs = *(const f32x4*)(base + off + bj * HALF + n * 16); *(f32x4*)(o + off + bj * HALF + n * 16) = bs + gvv[bj][n] * acc[ai][bj][m][n]; }
                asm volatile("" ::: "memory"); }
    }
};
struct EpiResid16 {
    static constexpr bool PERM = true, AFTER_DRAIN = false;
    const float* baseL32; const bf16_t* baseL16; const float* baseC; bf16_t* out16; float* outC; const float* modv; int gidx; float scale;
    __device__ __forceinline__ void operator()(const f32x4 (&acc)[2][2][4][2], const Unit& u, int wr, int wc, int fr, int fq) const {
        const int pm = u.pm, r = pm < 64 ? (pm >> 3) : 8;
        const float* gv = modv + (size_t)r * 18432 + gidx * 2048;
        const int rowl = wr * 64 + fr, col0 = u.pn * BM + wc * 32 + 8 * fq;
        f32x4 gvv[2][2];
#pragma unroll
        for (int bj = 0; bj < 2; ++bj)
#pragma unroll
            for (int n = 0; n < 2; ++n) gvv[bj][n] = *(const f32x4*)(gv + col0 + bj * HALF + 4 * n) * scale;
        if (pm >= 64) {
            const float* base = baseC + (size_t)(pm - 64) * 256 * 2048; float* o = outC + (size_t)pm * 256 * 2048;
#pragma unroll
            for (int ai = 0; ai < 2; ++ai)
#pragma unroll
                for (int m = 0; m < 4; ++m) { const size_t off = (size_t)(rowl + ai * HALF + m * 16) * 2048 + col0;
#pragma unroll
                    for (int bj = 0; bj < 2; ++bj)
#pragma unroll
                        for (int n = 0; n < 2; ++n) { const f32x4 bs = *(const f32x4*)(base + off + bj * HALF + 4 * n); *(f32x4*)(o + off + bj * HALF + 4 * n) = bs + gvv[bj][n] * acc[ai][bj][m][n]; }
                    asm volatile("" ::: "memory"); }
            return;
        }
        bf16_t* o = out16 + (size_t)pm * 256 * 2048;
        if (baseL16 != nullptr) {
            const bf16_t* base = baseL16 + (size_t)pm * 256 * 2048;
            u32x4 q[2]; const unsigned lo = (unsigned)(rowl * 2048 + col0) * 2u;
            const char* bb = (const char*)base; char* ob = (char*)o;
            q[0] = *(const u32x4*)(bb + lo);
#pragma unroll
            for (int st = 0; st < 16; ++st) { const int gi = st >> 1, bj = st & 1, ai = gi >> 2, m = gi & 3; const unsigned off = lo + (unsigned)(((ai * HALF + m * 16) * 2048 + bj * HALF) * 2);
                if (st + 1 < 16) { const int gn = (st + 1) >> 1, bn = (st + 1) & 1; q[(st + 1) & 1] = *(const u32x4*)(bb + (lo + (unsigned)((((gn >> 2) * HALF + (gn & 3) * 16) * 2048 + bn * HALF) * 2))); }
                const u32x4 qq = q[st & 1];
                const f32x4 b0 = (f32x4){__uint_as_float(qq.x << 16), __uint_as_float(qq.x & 0xffff0000u), __uint_as_float(qq.y << 16), __uint_as_float(qq.y & 0xffff0000u)};
                const f32x4 b1 = (f32x4){__uint_as_float(qq.z << 16), __uint_as_float(qq.z & 0xffff0000u), __uint_as_float(qq.w << 16), __uint_as_float(qq.w & 0xffff0000u)};
                const f32x4 v0 = b0 + gvv[bj][0] * acc[ai][bj][m][0], v1 = b1 + gvv[bj][1] * acc[ai][bj][m][1];
                u32x4 w; w.x = cvt_pk_bf16(v0[0], v0[1]); w.y = cvt_pk_bf16(v0[2], v0[3]); w.z = cvt_pk_bf16(v1[0], v1[1]); w.w = cvt_pk_bf16(v1[2], v1[3]);
                *(u32x4*)(ob + off) = w;
                asm volatile("" ::: "memory"); }
        } else {
            const float* base = baseL32 + (size_t)pm * 256 * 2048;
#pragma unroll
            for (int ai = 0; ai < 2; ++ai)
#pragma unroll
                for (int m = 0; m < 4; ++m) { const size_t off = (size_t)(rowl + ai * HALF + m * 16) * 2048 + col0;
#pragma unroll
                    for (int bj = 0; bj < 2; ++bj) { const f32x4 b0 = *(const f32x4*)(base + off + bj * HALF), b1 = *(const f32x4*)(base + off + bj * HALF + 4);
                        const f32x4 v0 = b0 + gvv[bj][0] * acc[ai][bj][m][0], v1 = b1 + gvv[bj][1] * acc[ai][bj][m][1];
                        u32x4 w; w.x = cvt_pk_bf16(v0[0], v0[1]); w.y = cvt_pk_bf16(v0[2], v0[3]); w.z = cvt_pk_bf16(v1[0], v1[1]); w.w = cvt_pk_bf16(v1[2], v1[3]);
                        *(u32x4*)(o + off + bj * HALF) = w; }
                    asm volatile("" ::: "memory"); }
        }
    }
};
struct EpiPlain {
    static constexpr bool PERM = true, AFTER_DRAIN = false;
    bf16_t* O; int ldc; float* DT;
    __device__ __forceinline__ void operator()(const f32x4 (&acc)[2][2][4][2], const Unit& u, int wr, int wc, int fr, int fq) const {
        const int row0 = u.pm * BM + wr * 64 + fr;
        if (u.pn * BM >= ldc) {
            if (DT != nullptr && wc == 0) {
#pragma unroll
                for (int ai = 0; ai < 2; ++ai)
#pragma unroll
                    for (int m = 0; m < 4; ++m) { float* rowp = DT + (size_t)(row0 + ai * HALF + m * 16) * 32 + 8 * fq;
                        *(f32x4*)(rowp) = acc[ai][0][m][0]; *(f32x4*)(rowp + 4) = acc[ai][0][m][1]; }
            }
            return;
        }
        const int col0 = u.pn * BM + wc * 32 + 8 * fq;
#pragma unroll
        for (int ai = 0; ai < 2; ++ai)
#pragma unroll
            for (int m = 0; m < 4; ++m) { bf16_t* rowp = O + (size_t)(row0 + ai * HALF + m * 16) * ldc + col0;
#pragma unroll
                for (int bj = 0; bj < 2; ++bj) { const f32x4 v0 = acc[ai][bj][m][0], v1 = acc[ai][bj][m][1];
                    u32x4 w; w.x = cvt_pk_bf16(v0[0], v0[1]); w.y = cvt_pk_bf16(v0[2], v0[3]); w.z = cvt_pk_bf16(v1[0], v1[1]); w.w = cvt_pk_bf16(v1[2], v1[3]);
                    *(u32x4*)(rowp + bj * HALF) = w; } }
    }
};
struct EpiPlainI8 {
    static constexpr bool PERM = true, AFTER_DRAIN = false;
    bf16_t* O; int ldc; float* DT; const float* rs; const float* cs;
    __device__ __forceinline__ void operator()(const f32x4 (&acc)[2][2][4][2], const Unit& u, int wr, int wc, int fr, int fq) const {
        const int row0 = u.pm * BM + wr * 64 + fr, col0 = u.pn * BM + wc * 32 + 8 * fq;
        if (u.pn * BM >= ldc) {
            if (DT != nullptr && wc == 0) { const f32x4 c0 = *(const f32x4*)(cs + col0), c1 = *(const f32x4*)(cs + col0 + 4);
#pragma unroll
                for (int ai = 0; ai < 2; ++ai)
#pragma unroll
                    for (int m = 0; m < 4; ++m) { const int row = row0 + ai * HALF + m * 16; const float r = rs[row]; float* rowp = DT + (size_t)row * 32 + 8 * fq; f32x4 o0, o1;
#pragma unroll
                        for (int j = 0; j < 4; ++j) { o0[j] = (float)__float_as_int(acc[ai][0][m][0][j]) * (r * c0[j]); o1[j] = (float)__float_as_int(acc[ai][0][m][1][j]) * (r * c1[j]); }
                        *(f32x4*)(rowp) = o0; *(f32x4*)(rowp + 4) = o1; }
            }
            return;
        }
        f32x4 cv[2][2];
#pragma unroll
        for (int bj = 0; bj < 2; ++bj) { cv[bj][0] = *(const f32x4*)(cs + col0 + bj * HALF); cv[bj][1] = *(const f32x4*)(cs + col0 + bj * HALF + 4); }
#pragma unroll
        for (int ai = 0; ai < 2; ++ai)
#pragma unroll
            for (int m = 0; m < 4; ++m) { const int row = row0 + ai * HALF + m * 16; const float r = rs[row]; bf16_t* rowp = O + (size_t)row * ldc + col0;
#pragma unroll
                for (int bj = 0; bj < 2; ++bj) { float v[8];
#pragma unroll
                    for (int j = 0; j < 4; ++j) { v[j] = (float)__float_as_int(acc[ai][bj][m][0][j]) * (r * cv[bj][0][j]); v[4 + j] = (float)__float_as_int(acc[ai][bj][m][1][j]) * (r * cv[bj][1][j]); }
                    u32x4 w; w.x = cvt_pk_bf16(v[0], v[1]); w.y = cvt_pk_bf16(v[2], v[3]); w.z = cvt_pk_bf16(v[4], v[5]); w.w = cvt_pk_bf16(v[6], v[7]);
                    *(u32x4*)(rowp + bj * HALF) = w; } }
    }
};
struct EpiVT8 {
    static constexpr bool PERM = true, AFTER_DRAIN = false;
    bf16_t* VT; const float* rs; const float* cs;
    __device__ __forceinline__ void operator()(const f32x4 (&acc)[2][2][4][2], const Unit& u, int wr, int wc, int fr, int fq) const {
        const int row0 = u.pm * BM + wr * 64 + fr, col0 = u.pn * BM + wc * 32 + 8 * fq;
        const int b = u.pn < 64 ? (u.pn >> 3) : (u.pn - 64), tokb = (u.pn < 64 ? (u.pn & 7) * 256 : 2048) + wc * 32 + 8 * fq;
        f32x4 cv[2][2];
#pragma unroll
        for (int bj = 0; bj < 2; ++bj) { cv[bj][0] = *(const f32x4*)(rs + col0 + bj * HALF); cv[bj][1] = *(const f32x4*)(rs + col0 + bj * HALF + 4); }
#pragma unroll
        for (int ai = 0; ai < 2; ++ai)
#pragma unroll
            for (int m = 0; m < 4; ++m) { const int row = row0 + ai * HALF + m * 16; const float r = cs[row]; bf16_t* rowp = VT + (size_t)((b * 8 + (row >> 7)) * 128 + (row & 127)) * 2304 + tokb;
#pragma unroll
                for (int bj = 0; bj < 2; ++bj) { float v[8];
#pragma unroll
                    for (int j = 0; j < 4; ++j) { v[j] = (float)__float_as_int(acc[ai][bj][m][0][j]) * (r * cv[bj][0][j]); v[4 + j] = (float)__float_as_int(acc[ai][bj][m][1][j]) * (r * cv[bj][1][j]); }
                    u32x4 w; w.x = cvt_pk_bf16(v[0], v[1]); w.y = cvt_pk_bf16(v[2], v[3]); w.z = cvt_pk_bf16(v[4], v[5]); w.w = cvt_pk_bf16(v[6], v[7]);
                    *(u32x4*)(rowp + bj * HALF) = w; } }
    }
};
struct EpiResidPart {
    static constexpr bool PERM = false, AFTER_DRAIN = false;
    float* part; const float* modv; int gidx; float scale;
    __device__ __forceinline__ void operator()(const f32x4 (&acc)[2][2][4][2], const Unit& u, int wr, int wc, int fr, int fq) const {
        const float* gv = modv + (size_t)8 * 18432 + gidx * 2048;
        float* o = part + ((size_t)u.kq * 2048 + (size_t)(u.pm - 64) * 256) * 2048;
        const int rowl = wr * 64 + fr, col0 = u.pn * BM + wc * 32 + 4 * fq;
        f32x4 gvv[2][2];
#pragma unroll
        for (int bj = 0; bj < 2; ++bj)
#pragma unroll
            for (int n = 0; n < 2; ++n) gvv[bj][n] = *(const f32x4*)(gv + col0 + bj * HALF + n * 16) * scale;
#pragma unroll
        for (int ai = 0; ai < 2; ++ai)
#pragma unroll
            for (int m = 0; m < 4; ++m) { const size_t off = (size_t)(rowl + ai * HALF + m * 16) * 2048 + col0;
#pragma unroll
                for (int bj = 0; bj < 2; ++bj)
#pragma unroll
                    for (int n = 0; n < 2; ++n) *(f32x4*)(o + off + bj * HALF + n * 16) = gvv[bj][n] * acc[ai][bj][m][n];
                asm volatile("" ::: "memory"); }
    }
};
struct SplitCtxOrder {
    int G, c, ns;
    __device__ bool next(int i, Unit& u) const { const long L = (long)i * G + c; if (L >= 64 * ns) return false; u.kq = (int)(L % ns); const int q = (int)(L / ns); u.pn = q & 7; u.pm = 64 + (q >> 3); return true; }
    __device__ __forceinline__ void a_ready(const Unit&) const {}
    __device__ __forceinline__ void done(const Unit&) const {}
};
struct OddInOrder {
    StaticOrder S; int G, c;
    __device__ void init(int G_, int c_) { S.init(16384, 6400, G_, c_); G = G_; c = c_; }
    __device__ bool next(int i, Unit& u) const { const long L = (long)i * G + c; if (L < 1600) return S.next(i, u); const int l2 = (int)(L - 1600); if (l2 >= 72) return false; u.pm = 64 + (l2 & 7); u.pn = 16 + (l2 >> 3); u.kq = 0; return true; }
    __device__ __forceinline__ void a_ready(const Unit&) const {}
    __device__ __forceinline__ void done(const Unit&) const {}
};
struct EpiGlu {
    static constexpr bool PERM = true, AFTER_DRAIN = false;
    const bf16_t* G; const float* bias; bf16_t* O;
    __device__ __forceinline__ void operator()(const f32x4 (&acc)[2][2][4][2], const Unit& u, int wr, int wc, int fr, int fq) const {
        const int row0 = u.pm * BM + wr * 64 + fr, col0 = u.pn * BM + wc * 32 + 8 * fq;
#pragma unroll
        for (int ai = 0; ai < 2; ++ai)
#pragma unroll
            for (int m = 0; m < 4; ++m) { const size_t row = (size_t)(row0 + ai * HALF + m * 16);
#pragma unroll
                for (int bj = 0; bj < 2; ++bj) { const int c = col0 + bj * HALF;
                    const u32x4 gw = *(const u32x4*)(G + row * 1024 + c);
                    const f32x4 b0 = *(const f32x4*)(bias + c), b1 = *(const f32x4*)(bias + c + 4);
                    const f32x4 v0 = acc[ai][bj][m][0] + b0, v1 = acc[ai][bj][m][1] + b1;
                    float o[8];
#pragma unroll
                    for (int j = 0; j < 4; ++j) { const unsigned gq = gw[j]; const float ga = __uint_as_float(gq << 16), gb = __uint_as_float(gq & 0xffff0000u);
                        const float sa = (j < 2) ? v0[2 * j] : v1[2 * j - 4], sb = (j < 2) ? v0[2 * j + 1] : v1[2 * j - 3];
                        o[2 * j] = ga * fast_sigmoid(sa); o[2 * j + 1] = gb * fast_sigmoid(sb); }
                    u32x4 w; w.x = cvt_pk_bf16(o[0], o[1]); w.y = cvt_pk_bf16(o[2], o[3]); w.z = cvt_pk_bf16(o[4], o[5]); w.w = cvt_pk_bf16(o[6], o[7]);
                    *(u32x4*)(O + row * 2048 + c) = w; } }
    }
};
typedef int i32x4 __attribute__((ext_vector_type(4)));
template <bool I8> __device__ __forceinline__ f32x4 mma_step(bf16x8 b, bf16x8 a, f32x4 c) {
#if defined(I8_VIA_BF16)
    if constexpr (I8) { const i32x4 bi = __builtin_bit_cast(i32x4, b), ai = __builtin_bit_cast(i32x4, a); const i32x4 ci = __builtin_bit_cast(i32x4, c); f32x4 r = (f32x4){(float)ci[0], (float)ci[1], (float)ci[2], (float)ci[3]};
#pragma unroll
        for (int h = 0; h < 2; ++h) { bf16x8 bb, aa;
#pragma unroll
            for (int j = 0; j < 8; ++j) { const int wb = bi[2 * h + (j >> 2)], wa = ai[2 * h + (j >> 2)]; const float fb = (float)((wb << (24 - 8 * (j & 3))) >> 24), fa = (float)((wa << (24 - 8 * (j & 3))) >> 24);
                bb[j] = (short)(__float_as_uint(fb) >> 16); aa[j] = (short)(__float_as_uint(fa) >> 16); }
            r = __builtin_amdgcn_mfma_f32_16x16x32_bf16(bb, aa, r, 0, 0, 0); }
        return __builtin_bit_cast(f32x4, (i32x4){(int)r[0], (int)r[1], (int)r[2], (int)r[3]}); }
#endif
    if constexpr (I8) return __builtin_bit_cast(f32x4, __builtin_amdgcn_mfma_i32_16x16x64_i8(__builtin_bit_cast(i32x4, b), __builtin_bit_cast(i32x4, a), __builtin_bit_cast(i32x4, c), 0, 0, 0));
    else return __builtin_amdgcn_mfma_f32_16x16x32_bf16(b, a, c, 0, 0, 0);
}
typedef int i32x8 __attribute__((ext_vector_type(8)));
__device__ __forceinline__ void mma_f8(bf16x8 b0, bf16x8 b1, bf16x8 a0, bf16x8 a1, f32x4& c, int one) {
    const i32x4 bl = __builtin_bit_cast(i32x4, b0), bh = __builtin_bit_cast(i32x4, b1), al = __builtin_bit_cast(i32x4, a0), ah = __builtin_bit_cast(i32x4, a1);
    const i32x8 bb = {bl[0], bl[1], bl[2], bl[3], bh[0], bh[1], bh[2], bh[3]}, aa = {al[0], al[1], al[2], al[3], ah[0], ah[1], ah[2], ah[3]};
    asm volatile("v_mfma_scale_f32_16x16x128_f8f6f4 %0, %1, %2, %0, %3, %3 op_sel_hi:[0,0,0]" : "+v"(c) : "v"(bb), "v"(aa), "v"(one));
}
template <class Epi, class Sched, bool ALIGN_EPI = false, bool SP2 = false, bool I8 = false, bool F8 = false>
__device__ __forceinline__ void gemm_phase(PG8_LAS unsigned char* lds, const Gemm g, const Sched& S, const Epi& E) {
    const int tid = threadIdx.x, wid = __builtin_amdgcn_readfirstlane(tid >> 6), lane = tid & 63, wr = wid >> 2, wc = wid & 3, fr = lane & 15, fq = lane >> 4;
    const int K = g.ld ? g.ld : g.K, nt = g.K / BK;
    unsigned voffA[2], voffB[2];
#pragma unroll
    for (int i = 0; i < 2; ++i) { int R, C; stage_rc(tid * 16 + i * 8192, R, C); const int Rb = Epi::PERM ? ((R & ~31) + perm32(R & 31)) : R;
        voffA[i] = (unsigned)(R * K + C) * 2u; voffB[i] = (unsigned)(Rb * K + C) * 2u; }
    const size_t kstep = (size_t)(BK * 2);
    const size_t hstep = (size_t)HALF * K * 2;
    const size_t tstep = 2 * hstep;
    const unsigned ldsw = (unsigned)wid * 1024u;
    const int aoff = lds_byte(wr * 64 + fr, fq * 8), boff = lds_byte(wc * 32 + fr, fq * 8);
#define PG8_SA(b, h) (((b) * 2 + (h)) * HTB)
#define PG8_SB(b, h) ((4 + (b) * 2 + (h)) * HTB)
#define PG8_STAGE(bufoff, gbase, voff) do { _Pragma("unroll") for (int _i = 0; _i < 2; ++_i) \
        __builtin_amdgcn_global_load_lds((const unsigned*)((const char*)(gbase) + (voff)[_i]), (PG8_LAS unsigned*)(lds + (bufoff) + ldsw + _i * 8192), 16, 0, 0); } while (0)
#define PG8_LDA(dst, b, h) do { _Pragma("unroll") for (int m = 0; m < 4; ++m) _Pragma("unroll") for (int k = 0; k < 2; ++k) dst[m][k] = *(const PG8_LAS bf16x8*)(lds + PG8_SA(b, h) + aoff + m * 2048 + k * 1024); } while (0)
#define PG8_LDB(dst, b, h) do { _Pragma("unroll") for (int n = 0; n < 2; ++n) _Pragma("unroll") for (int k = 0; k < 2; ++k) dst[n][k] = *(const PG8_LAS bf16x8*)(lds + PG8_SB(b, h) + boff + n * 2048 + k * 1024); } while (0)
#define PG8_MMA(ai, bj, At, Bt) do { __builtin_amdgcn_s_setprio(1); if constexpr (F8) { _Pragma("unroll") for (int m = 0; m < 4; ++m) _Pragma("unroll") for (int n = 0; n < 2; ++n) \
        mma_f8(Bt[n][0], Bt[n][1], At[m][0], At[m][1], acc[ai][bj][m][n], f8one); } else { _Pragma("unroll") for (int m = 0; m < 4; ++m) _Pragma("unroll") for (int n = 0; n < 2; ++n) _Pragma("unroll") for (int k = 0; k < 2; ++k) \
        acc[ai][bj][m][n] = mma_step<I8>(Bt[n][k], At[m][k], acc[ai][bj][m][n]); } __builtin_amdgcn_s_setprio(0); } while (0)
#define PG8_WAIT_V(n) asm volatile("s_waitcnt vmcnt(" #n ")" ::: "memory")
#define PG8_WAIT_L(n) asm volatile("s_waitcnt lgkmcnt(" #n ")" ::: "memory")
#define PG8_BAR __builtin_amdgcn_s_barrier()
#define PG8_SCHED __builtin_amdgcn_sched_barrier(0)
    Unit cur, nxt; int ui = 0;
    if (!S.next(0, cur)) return;
    f32x4 acc[2][2][4][2]; int f8one = 0x7f7f7f7f; asm volatile("" : "+v"(f8one));
#pragma unroll
    for (int a = 0; a < 2; ++a)
#pragma unroll
        for (int b = 0; b < 2; ++b)
#pragma unroll
            for (int m = 0; m < 4; ++m)
#pragma unroll
                for (int n = 0; n < 2; ++n) acc[a][b][m][n] = (f32x4){0.f, 0.f, 0.f, 0.f};
    bf16x8 At[4][2], B0[2][2], B1[2][2];
    const char* cA = (const char*)g.A + (size_t)cur.pm * tstep + (size_t)cur.kq * g.kcb; const char* cB = (const char*)g.Bt + (size_t)cur.pn * tstep + (size_t)cur.kq * g.kcb;
    S.a_ready(cur);
    if constexpr (SP2) {
        PG8_STAGE(PG8_SB(0, 0), cB, voffB); PG8_STAGE(PG8_SB(0, 1), cB + hstep, voffB); PG8_STAGE(PG8_SA(0, 0), cA, voffA); PG8_STAGE(PG8_SA(0, 1), cA + hstep, voffA);
        if (wr == 1) PG8_BAR;
        PG8_WAIT_V(2); PG8_BAR;
        PG8_STAGE(PG8_SB(1, 0), cB + kstep, voffB); PG8_STAGE(PG8_SA(1, 0), cA + kstep, voffA); PG8_STAGE(PG8_SB(1, 1), cB + hstep + kstep, voffB);
        PG8_WAIT_V(6); PG8_BAR;
    } else {
        PG8_STAGE(PG8_SB(0, 0), cB, voffB); PG8_STAGE(PG8_SA(0, 0), cA, voffA); PG8_STAGE(PG8_SB(0, 1), cB + hstep, voffB); PG8_STAGE(PG8_SA(0, 1), cA + hstep, voffA);
        if (wr == 1) PG8_BAR;
        PG8_WAIT_V(4); PG8_BAR;
        PG8_STAGE(PG8_SB(1, 0), cB + kstep, voffB); PG8_STAGE(PG8_SA(1, 0), cA + kstep, voffA); PG8_STAGE(PG8_SB(1, 1), cB + hstep + kstep, voffB);
        PG8_WAIT_V(6); PG8_BAR;
    }
    for (;;) {
        const bool has_next = S.next(ui + 1, nxt);
        const char* nA = has_next ? (const char*)g.A + (size_t)nxt.pm * tstep + (size_t)nxt.kq * g.kcb : cA; const char* nB = has_next ? (const char*)g.Bt + (size_t)nxt.pn * tstep + (size_t)nxt.kq * g.kcb : cB;
        for (int t = 0; t < nt; t += 2) {
            const bool last = (t == nt - 2);
            const char* a1 = cA + (size_t)(t + 1) * kstep;
            const char* a2 = last ? nA : cA + (size_t)(t + 2) * kstep; const char* b2 = last ? nB : cB + (size_t)(t + 2) * kstep;
            const char* a3 = a2 + kstep; const char* b3 = b2 + kstep;
            if (last && has_next) S.a_ready(nxt);
            if constexpr (SP2) {
            PG8_LDB(B0, 0, 0); PG8_LDB(B1, 0, 1); PG8_SCHED; PG8_LDA(At, 0, 0); PG8_STAGE(PG8_SA(1, 1), a1 + hstep, voffA);
            PG8_WAIT_V(8); PG8_WAIT_L(0); PG8_BAR; PG8_MMA(0, 0, At, B0); PG8_MMA(0, 1, At, B1); PG8_BAR; PG8_SCHED;
            PG8_LDA(At, 0, 1); PG8_STAGE(PG8_SB(0, 0), b2, voffB); PG8_STAGE(PG8_SB(0, 1), b2 + hstep, voffB); PG8_STAGE(PG8_SA(0, 0), a2, voffA);
            PG8_WAIT_V(8); PG8_WAIT_L(0); PG8_BAR; PG8_MMA(1, 0, At, B0); PG8_MMA(1, 1, At, B1); PG8_BAR; PG8_SCHED;
            PG8_LDB(B0, 1, 0); PG8_LDB(B1, 1, 1); PG8_SCHED; PG8_LDA(At, 1, 0); PG8_STAGE(PG8_SA(0, 1), a2 + hstep, voffA);
            PG8_WAIT_V(8); PG8_WAIT_L(0); PG8_BAR; PG8_MMA(0, 0, At, B0); PG8_MMA(0, 1, At, B1); PG8_BAR; PG8_SCHED;
            PG8_LDA(At, 1, 1); PG8_STAGE(PG8_SB(1, 0), b3, voffB); PG8_STAGE(PG8_SB(1, 1), b3 + hstep, voffB); PG8_STAGE(PG8_SA(1, 0), a3, voffA);
            PG8_WAIT_V(8); PG8_WAIT_L(0); PG8_BAR; PG8_MMA(1, 0, At, B0); PG8_MMA(1, 1, At, B1); PG8_BAR; PG8_SCHED;
            } else {
            PG8_LDB(B0, 0, 0); PG8_SCHED; PG8_LDA(At, 0, 0); PG8_STAGE(PG8_SA(1, 1), a1 + hstep, voffA);
            PG8_WAIT_L(8); PG8_BAR; PG8_WAIT_L(0); PG8_MMA(0, 0, At, B0); PG8_BAR; PG8_SCHED;
            PG8_LDB(B1, 0, 1); PG8_STAGE(PG8_SB(0, 0), b2, voffB);
            PG8_BAR; PG8_WAIT_L(0); PG8_MMA(0, 1, At, B1); PG8_BAR;
            PG8_LDA(At, 0, 1); PG8_STAGE(PG8_SA(0, 0), a2, voffA);
            PG8_BAR; PG8_WAIT_L(0); PG8_MMA(1, 0, At, B0); PG8_BAR; PG8_SCHED;
            PG8_STAGE(PG8_SB(0, 1), b2 + hstep, voffB);
            PG8_WAIT_V(6); PG8_BAR; PG8_MMA(1, 1, At, B1); PG8_BAR;
            PG8_LDB(B0, 1, 0); PG8_SCHED; PG8_LDA(At, 1, 0); PG8_STAGE(PG8_SA(0, 1), a2 + hstep, voffA);
            PG8_WAIT_L(8); PG8_BAR; PG8_WAIT_L(0); PG8_MMA(0, 0, At, B0); PG8_BAR; PG8_SCHED;
            PG8_LDB(B1, 1, 1); PG8_STAGE(PG8_SB(1, 0), b3, voffB);
            PG8_BAR; PG8_WAIT_L(0); PG8_MMA(0, 1, At, B1); PG8_BAR;
            PG8_LDA(At, 1, 1); PG8_STAGE(PG8_SA(1, 0), a3, voffA);
            PG8_BAR; PG8_WAIT_L(0); PG8_MMA(1, 0, At, B0); PG8_BAR; PG8_SCHED;
            PG8_STAGE(PG8_SB(1, 1), b3 + hstep, voffB);
            PG8_WAIT_V(6); PG8_BAR; PG8_MMA(1, 1, At, B1); PG8_BAR;
            }
        }
        if constexpr (F8) asm volatile("s_nop 15\n\ts_nop 15" ::: "memory");
        if constexpr (ALIGN_EPI) { if (wr == 0) PG8_BAR; }
        if constexpr (!Epi::AFTER_DRAIN) { E(acc, cur, wr, wc, fr, fq); if (REP_CODE == 3001 && I8) E(acc, cur, wr, wc, fr, fq); S.done(cur); }
        if (!has_next) break;
#pragma unroll
        for (int a = 0; a < 2; ++a)
#pragma unroll
            for (int b = 0; b < 2; ++b)
#pragma unroll
                for (int m = 0; m < 4; ++m)
#pragma unroll
                    for (int n = 0; n < 2; ++n) acc[a][b][m][n] = (f32x4){0.f, 0.f, 0.f, 0.f};
        cur = nxt; cA = nA; cB = nB; ++ui;
        if constexpr (ALIGN_EPI) { if (wr == 1) PG8_BAR; }
    }
    PG8_WAIT_V(0);
    if constexpr (!ALIGN_EPI) { if (wr == 0) PG8_BAR; }
    PG8_BAR;
    if constexpr (Epi::AFTER_DRAIN) { E.fused(acc, cur, wr, wc, fr, fq, lds, wid, lane); S.done(cur); }
#undef PG8_SA
#undef PG8_SB
#undef PG8_STAGE
#undef PG8_LDA
#undef PG8_LDB
#undef PG8_MMA
#undef PG8_WAIT_V
#undef PG8_WAIT_L
#undef PG8_BAR
#undef PG8_SCHED
}
}

#define LAS __attribute__((address_space(3)))
typedef unsigned short bf16;
typedef float f32x4 __attribute__((ext_vector_type(4)));
typedef unsigned v4u __attribute__((ext_vector_type(4)));
typedef unsigned v2u __attribute__((ext_vector_type(2)));
constexpr int NWAVES = 8;
constexpr int DM = 2048, NB = 8, SEQ = 2048, CTXL = 256, DFF = 5632;
constexpr int ML = NB * SEQ, MC = NB * CTXL, MT = ML + MC;
constexpr int NMODC = 9 * DM;
constexpr int EVEN_IN = 4096, ODD_IN = 6176, ODD_INP = 6400, ODD_LD = 6144;
constexpr int XBC_LD = 2048 + 64, EVEN_LD = EVEN_IN;
constexpr float EPS = 1e-6f;
enum { I_X = 0, I_C, I_CTX, I_CCTX, I_MODW, I_MODB, I_NORMG, I_WG, I_WU, I_WD, I_FINALG, I_EVWIN, I_EVWOUT, I_S5ARE, I_S5AIM, I_S5LOGDT, I_S5BRE, I_S5BIM, I_S5CRE, I_S5CIM,
       I_S5D, I_GLUW, I_GLUB, I_RPB, I_ODWIN, I_ODWOUT, I_HYSW, I_HYSB, I_HYWIN, I_HYBIN, I_HYWMID, I_HYBMID, I_HYWOUT, I_HYFREQ, I_HYFBIAS, I_SSDCW, I_SSDCB, I_SSDDTB, I_SSDALOG,
       I_SSDD, I_SSDNG, N_IN };
constexpr size_t MiB = 1u << 20;
constexpr size_t WS_CTL = 0, CTL_ZERO_BYTES = 1 * MiB;
constexpr size_t SZ_WGU = (size_t)2 * DFF * DM * 2, SZ_WGU8 = (size_t)2 * DFF * DM, SZ_WD = (size_t)DM * DFF * 2;
constexpr size_t WS_WGU = 1 * MiB;
constexpr size_t WS_WD = WS_WGU + 4 * SZ_WGU8;
constexpr size_t WS_WEVIN = WS_WD + 4 * SZ_WD;
constexpr size_t WS_WEVOUT = WS_WEVIN + (size_t)EVEN_IN * DM * 2;
constexpr size_t WS_WGLU = WS_WEVOUT + (size_t)DM * DM * 2;
constexpr size_t WS_WODIN = WS_WGLU + (size_t)1024 * 1024 * 2;
constexpr size_t WS_WODOUT = WS_WODIN + (size_t)ODD_INP * DM * 2;
constexpr size_t WS_MODP = WS_WODOUT + (size_t)DM * DM * 2;
constexpr size_t WS_MODV = WS_MODP + (size_t)2 * 32 * 9 * NMODC * 4;
constexpr size_t WS_CS = WS_MODV + (size_t)2 * 9 * NMODC * 4;
constexpr size_t WS_RS = WS_CS + (size_t)4 * 2 * DFF * 4;
constexpr size_t WS_CS2 = WS_RS + (size_t)MT * 4;
constexpr size_t WS_XS = WS_CS2 + (size_t)(EVEN_IN + ODD_INP) * 4;
constexpr size_t WS_H = WS_XS + (size_t)MT * DM * 4;
constexpr size_t WS_BIG = WS_H + (size_t)MT * DM * 2;
constexpr size_t SZ_BIG = (size_t)MT * ODD_LD * 2;
constexpr size_t WS_MIX = WS_BIG + SZ_BIG;
constexpr size_t WS_FILT = WS_MIX + (size_t)MT * DM * 2;
constexpr size_t WS_SCR = WS_FILT + (size_t)2 * 1024 * 4096 * 4;
constexpr size_t WS_G = WS_SCR, WS_VT = WS_G + (size_t)MT * 1024 * 2;
constexpr size_t WS_S5KF = WS_VT + (size_t)64 * 128 * (SEQ + CTXL) * 2;
constexpr size_t WS_S5W = WS_S5KF + (size_t)64 * 2 * 64 * 256 * 4;
constexpr size_t WS_S5V = WS_S5W + (size_t)64 * 256 * 1024 * 2;
constexpr size_t WS_S5SLOC = WS_S5V + (size_t)64 * 1024 * 256 * 2;
constexpr size_t WS_S5SIN = WS_S5SLOC + (size_t)64 * 288 * 256 * 4;
constexpr size_t WS_SCR0_END = WS_S5SIN + (size_t)64 * 288 * 256 * 2;
constexpr size_t SZ_CM = (size_t)1024 * ML * 2;
constexpr size_t WS_X1C = WS_SCR, WS_X2C = WS_X1C + SZ_CM, WS_VC = WS_X2C + SZ_CM, WS_ZC = WS_VC + SZ_CM, WS_XBC = WS_ZC + SZ_CM, WS_DT = WS_XBC + (size_t)MT * XBC_LD * 2, WS_SCR1_END = WS_DT + (size_t)MT * 32 * 4;
constexpr size_t WS_YS = WS_H;
constexpr size_t WS_PART = (WS_SCR0_END > WS_SCR1_END ? WS_SCR0_END : WS_SCR1_END);
constexpr size_t WS_H3 = WS_PART + (size_t)4 * MC * DM * 4;
constexpr size_t WS_XS16 = WS_H3 + (size_t)SEQ * 64 * 4;
constexpr size_t WS_END = WS_XS16 + (size_t)ML * DM * 2;
static_assert(WS_END <= (size_t)1152 * MiB, "workspace map exceeds the guaranteed d_ws size");
static_assert((size_t)2 * ML * 1024 * 2 <= (size_t)MT * DM * 2, "YS fits in H");
constexpr int CW_TMO = 0, CW_BAR = 4096, CW_XRANK = 8192, CW_CMAX = 16384, CW_CMAX_EV = CW_CMAX + 4 * 2 * DFF, CW_CMAX_OD = CW_CMAX_EV + EVEN_IN, CW_CMAX_END = CW_CMAX_OD + ODD_INP;
static_assert(CW_CMAX_END * 4 <= (int)CTL_ZERO_BYTES, "control words");
constexpr int RING_BYTES = 131072, SCR_BYTES = 139264, LDSCTL_OFF = SCR_BYTES, MISC_OFF = LDSCTL_OFF + 320, LDS_BYTES = 147456;

__device__ __forceinline__ float bf2f(unsigned v) { return __uint_as_float(v << 16); }
__device__ __forceinline__ unsigned f2bf(float f) { unsigned u = __float_as_uint(f); return (u + 0x7fffu + ((u >> 16) & 1u)) >> 16; }
__device__ __forceinline__ unsigned pk2(float lo, float hi) { return f2bf(lo) | (f2bf(hi) << 16); }
__device__ __forceinline__ float wave_sum(float v) {
#pragma unroll
    for (int o = 1; o < 64; o <<= 1) v += __shfl_xor(v, o);
    return v;
}
__device__ __forceinline__ float wave_max(float v) {
#pragma unroll
    for (int o = 1; o < 64; o <<= 1) v = fmaxf(v, __shfl_xor(v, o));
    return v;
}
__device__ __forceinline__ float silu_f(float x) { return x / (1.0f + __expf(-x)); }
__device__ __forceinline__ float rdlane(float v, int l) { return __int_as_float(__builtin_amdgcn_readlane(__float_as_int(v), l)); }

#ifndef I8_INPROJ
#define I8_INPROJ 1
#endif
#ifndef F8_DOWN
#define F8_DOWN 1
#endif
#define NSPLIT (F8_DOWN ? 2 : 4)
#ifndef EXP_A
#define EXP_A 0
#endif
#define I8_EV ((I8_INPROJ) & 1)
#define I8_OD (((I8_INPROJ) >> 1) & 1)
#ifndef SPLIT_CTX
#define SPLIT_CTX 1
#endif
#ifndef GU_ONEPASS
#define GU_ONEPASS 1
#endif
#ifndef EV_ONEPASS
#define EV_ONEPASS 0
#endif
#ifndef DEFER_Q
#define DEFER_Q 1
#endif
#ifndef EMU_GU
#define EMU_GU 0
#endif
#ifndef EMU_D
#define EMU_D 0
#endif
__device__ __forceinline__ float q_e4m3(float x) {
    const float ax = fabsf(x);
    if (ax < 0.015625f) return rintf(x * 512.0f) * (1.0f / 512.0f);
    unsigned u = __float_as_uint(x); u += 0x7FFFFu + ((u >> 20) & 1u); u &= 0xFFF00000u; const float r = __uint_as_float(u);
    return fabsf(r) > 448.0f ? copysignf(448.0f, x) : r;
}
struct Args { const float* in[N_IN]; float* out; unsigned char* ws; int ph_lo, ph_hi; };
struct Frame {
    LAS unsigned char* lds; const float* const* in; float* out; unsigned char* ws;
    int tid, lane, wave, gw, ngw, G, xcd, xrank;
};

__device__ __forceinline__ void transpose_item(const float* W, int K, int N, bf16* WT, int k0, int n0, int drow0, LAS float* scr, int lane, float wscale = 0.f) {
#pragma unroll
    for (int i = 0; i < 32; ++i) { const int kk = 2 * i + (lane >> 5); float wv = __builtin_nontemporal_load(W + (size_t)(k0 + kk) * N + n0 + (lane & 31)); if (wscale > 0.f) wv = q_e4m3(wv * wscale) / wscale; else if (wscale < 0.f) { const float st = 5.5f * 0.02209708691f / 127.0f; wv = fminf(fmaxf(rintf(wv / st), -127.f), 127.f) * st; } scr[kk * 33 + (lane & 31)] = wv; }
    asm volatile("s_waitcnt lgkmcnt(0)" ::: "memory");
    const int c = lane & 7;
#pragma unroll
    for (int j = 0; j < 4; ++j) { const int n = (lane >> 3) + 8 * j; const LAS float* s = scr + (8 * c) * 33 + n;
        v4u o; o.x = pk2(s[0 * 33], s[1 * 33]); o.y = pk2(s[2 * 33], s[3 * 33]); o.z = pk2(s[4 * 33], s[5 * 33]); o.w = pk2(s[6 * 33], s[7 * 33]);
        *(v4u*)(WT + (size_t)(drow0 + n) * K + k0 + 8 * c) = o; }
    asm volatile("s_waitcnt lgkmcnt(0)" ::: "memory");
}
#ifndef REP_CODE
#define REP_CODE -1
#endif
#define P0REP(code) for (int _pr = 0; _pr < ((code) == REP_CODE ? 2 : 1); ++_pr)
__device__ __forceinline__ void transpose_f8_item(const float* W, int K, int N, unsigned char* WT, int k0, int n0, LAS float* scr, int lane, float wscale) {
#pragma unroll
    for (int i = 0; i < 32; ++i) { const int kk = 2 * i + (lane >> 5); scr[kk * 33 + (lane & 31)] = __builtin_nontemporal_load(W + (size_t)(k0 + kk) * N + n0 + (lane & 31)) * wscale; }
    asm volatile("s_waitcnt lgkmcnt(0)" ::: "memory");
    const int c = lane & 7;
#pragma unroll
    for (int j = 0; j < 4; ++j) { const int n = (lane >> 3) + 8 * j; const LAS float* sp = scr + (8 * c) * 33 + n;
        *(v2u*)(WT + (size_t)(n0 + n) * K + k0 + 8 * c) = (v2u){pg8::pack4_fp8(sp[0], sp[33], sp[66], sp[99]), pg8::pack4_fp8(sp[132], sp[165], sp[198], sp[231])}; }
    asm volatile("s_waitcnt lgkmcnt(0)" ::: "memory");
}
__device__ __forceinline__ void p0_prologue(Frame& F, int part) {
    LAS float* scr = (LAS float*)(F.lds + F.wave * 16384);
    const float* const* in = F.in; unsigned char* ws = F.ws; const int lane = F.lane;
    if (part == 0) {
    constexpr int I_FFN1 = (DM / 64) * (DFF / 32);
    constexpr int I_FFN = 4 * I_FFN1;
    constexpr int I_EVIN = (DM / 64) * (EVEN_IN / 32), I_EVOUT = (DM / 64) * (DM / 32), I_GLU = (1024 / 64) * (1024 / 32), I_ODIN = (DM / 64) * (ODD_IN / 32), I_ODOUT = I_EVOUT;
    constexpr int NITEMS = I_FFN + I_EVOUT + I_GLU + I_ODOUT + I_EVIN + I_ODIN;
    P0REP(1001) for (int it = F.gw; it < NITEMS; it += F.ngw) {
        int r = it;
        if (r < I_FFN) { const int lab = r / I_FFN1, rr = r % I_FFN1; const int nblk = DM / 32, kb = rr / nblk, nb = rr % nblk;
            if (F8_DOWN) transpose_f8_item(in[I_WD] + (size_t)lab * DFF * DM, DFF, DM, ws + WS_WD + (size_t)lab * SZ_WD, kb * 64, nb * 32, scr, lane, 1024.f);
            else transpose_item(in[I_WD] + (size_t)lab * DFF * DM, DFF, DM, (bf16*)(ws + WS_WD + (size_t)lab * SZ_WD), kb * 64, nb * 32, nb * 32, scr, lane, EMU_D ? 1024.f : 0.f);
            continue; }
        r -= I_FFN;
        if (r < I_EVOUT) { const int nblk = DM / 32; transpose_item(in[I_EVWOUT], DM, DM, (bf16*)(ws + WS_WEVOUT), (r / nblk) * 64, (r % nblk) * 32, (r % nblk) * 32, scr, lane); continue; }
        r -= I_EVOUT;
        if (r < I_GLU) { const int nblk = 1024 / 32; transpose_item(in[I_GLUW], 1024, 1024, (bf16*)(ws + WS_WGLU), (r / nblk) * 64, (r % nblk) * 32, (r % nblk) * 32, scr, lane); continue; }
        r -= I_GLU;
        if (r < I_ODOUT) { const int nblk = DM / 32; transpose_item(in[I_ODWOUT], DM, DM, (bf16*)(ws + WS_WODOUT), (r / nblk) * 64, (r % nblk) * 32, (r % nblk) * 32, scr, lane); continue; }
        r -= I_ODOUT;
        if (r < I_EVIN) { if (I8_EV && !EXP_A) continue; const int nblk = EVEN_IN / 32; transpose_item(in[I_EVWIN], DM, EVEN_IN, (bf16*)(ws + WS_WEVIN), (r / nblk) * 64, (r % nblk) * 32, (r % nblk) * 32, scr, lane); continue; }
        r -= I_EVIN;
        if (!I8_OD) { const int nblk = ODD_IN / 32; transpose_item(in[I_ODWIN], DM, ODD_IN, (bf16*)(ws + WS_WODIN), (r / nblk) * 64, (r % nblk) * 32, (r % nblk) * 32, scr, lane); }
    }
    { v4u* z = (v4u*)(ws + WS_WODIN + (size_t)ODD_IN * DM * (I8_OD ? 1 : 2)); const int nz = (ODD_INP - ODD_IN) * DM * (I8_OD ? 1 : 2) / 16;
      for (int i = F.gw * 64 + lane; i < nz; i += F.ngw * 64) z[i] = (v4u){0u, 0u, 0u, 0u}; }
    { LAS float* sv = scr;
      P0REP(1003) for (int it = F.gw; it < 2 * 72 * 32; it += F.ngw) {
          const int kc = it & 31, cb = (it >> 5) % 72, l = it / (72 * 32);
          for (int idx = lane; idx < 9 * 64; idx += 64) { const int r = idx >> 6, kk = idx & 63; const float v = r < 8 ? in[I_C][r * DM + kc * 64 + kk] : in[I_CCTX][kc * 64 + kk]; sv[idx] = silu_f(v); }
          asm volatile("s_waitcnt lgkmcnt(0)" ::: "memory");
          f32x4 acc[9];
#pragma unroll
          for (int r = 0; r < 9; ++r) acc[r] = (f32x4){0.f, 0.f, 0.f, 0.f};
          const float* wp = in[I_MODW] + ((size_t)l * DM + kc * 64) * NMODC + cb * 256 + lane * 4;
#pragma unroll 16
          for (int kk = 0; kk < 64; ++kk) { const f32x4 w = __builtin_nontemporal_load((const f32x4*)(wp + (size_t)kk * NMODC));
#pragma unroll
              for (int r = 0; r < 9; ++r) acc[r] += w * sv[r * 64 + kk]; }
          float* op = (float*)(ws + WS_MODP) + ((size_t)(l * 32 + kc) * 9) * NMODC + cb * 256 + lane * 4;
#pragma unroll
          for (int r = 0; r < 9; ++r) *(f32x4*)(op + (size_t)r * NMODC) = acc[r];
          asm volatile("s_waitcnt lgkmcnt(0)" ::: "memory");
      } }
    { unsigned* CM = (unsigned*)(ws + WS_CTL);
      constexpr int NI_GU = 8 * 32 * 22, NI_EV = 32 * 16, NI_OD = 32 * 25;
      P0REP(1002) for (int it = (GU_ONEPASS ? NI_GU + (EV_ONEPASS ? NI_EV : 0) : 0) + F.gw; it < NI_GU + (I8_INPROJ ? NI_EV + NI_OD : 0); it += F.ngw) {
          const float* W; int N, nb, kc, mode; unsigned* cm;
          if (it < NI_GU) { nb = it % 22; kc = (it / 22) & 31; const int mm = it / (22 * 32); mode = 1 + (mm & 1); W = (mode == 1 ? in[I_WG] : in[I_WU]) + (size_t)(mm >> 1) * DM * DFF; N = DFF; cm = CM + CW_CMAX + (mm >> 1) * 2 * DFF; }
          else if (it < NI_GU + NI_EV) { if (!I8_EV) continue; const int r = it - NI_GU; nb = r & 15; kc = r >> 4; mode = 0; W = in[I_EVWIN]; N = EVEN_IN; cm = CM + CW_CMAX_EV; }
          else { if (!I8_OD) continue; const int r = it - NI_GU - NI_EV; nb = r % 25; kc = r / 25; mode = 0; W = in[I_ODWIN]; N = ODD_IN; cm = CM + CW_CMAX_OD; }
          const int n0 = nb * 256 + lane * 4;
          if (n0 < N) { const float* wp = W + (size_t)(kc * 64) * N + n0; f32x4 mx = (f32x4){0.f, 0.f, 0.f, 0.f};
#pragma unroll 16
              for (int kk = 0; kk < 64; ++kk) { const f32x4 w = *(const f32x4*)(wp + (size_t)kk * N); mx.x = fmaxf(mx.x, fabsf(w.x)); mx.y = fmaxf(mx.y, fabsf(w.y)); mx.z = fmaxf(mx.z, fabsf(w.z)); mx.w = fmaxf(mx.w, fabsf(w.w)); }
              unsigned* cp = cm + (mode == 0 ? n0 : (n0 >> 7) * 256 + (n0 & 127) + (mode - 1) * 128);
              atomicMax(cp, __float_as_uint(mx.x)); atomicMax(cp + 1, __float_as_uint(mx.y)); atomicMax(cp + 2, __float_as_uint(mx.z)); atomicMax(cp + 3, __float_as_uint(mx.w)); } } }
    }
    if (part == 1) {
    { const float PI2 = 6.283185307179586f; float* H3 = (float*)(ws + WS_H3); LAS float* hl = scr; LAS float* zl = hl + 64;
      P0REP(1004) for (int pos = F.gw; pos < SEQ; pos += F.ngw) {
          const float w = PI2 * (float)pos / 2048.0f, tt = (float)pos / 2047.0f;
          if (lane < 32) { const int i = lane & 15; const float f = 1e-4f + (float)i * ((15.0f - 1e-4f) / 15.0f); const float a = f * w; zl[lane] = lane < 16 ? cosf(a) : -sinf(a); }
          asm volatile("s_waitcnt lgkmcnt(0)" ::: "memory");
          float pre = in[I_HYBIN][lane] + tt * in[I_HYWIN][lane];
#pragma unroll 4
          for (int e = 0; e < 32; e += 4) { const f32x4 z4 = *(const LAS f32x4*)(zl + e);
              pre += z4.x * in[I_HYWIN][(1 + e) * 64 + lane] + z4.y * in[I_HYWIN][(2 + e) * 64 + lane] + z4.z * in[I_HYWIN][(3 + e) * 64 + lane] + z4.w * in[I_HYWIN][(4 + e) * 64 + lane]; }
          const float fr = in[I_HYFREQ][lane]; float hv = sinf(fr * pre);
#pragma unroll
          for (int l2 = 0; l2 < 2; ++l2) { hl[lane] = hv; asm volatile("s_waitcnt lgkmcnt(0)" ::: "memory");
              float p0 = in[I_HYBMID][l2 * 64 + lane]; const float* wm = in[I_HYWMID] + l2 * 4096 + lane;
#pragma unroll 8
              for (int i = 0; i < 64; i += 4) { const f32x4 a0 = *(const LAS f32x4*)(hl + i); p0 += a0.x * wm[i * 64] + a0.y * wm[(i + 1) * 64] + a0.z * wm[(i + 2) * 64] + a0.w * wm[(i + 3) * 64]; }
              asm volatile("s_waitcnt lgkmcnt(0)" ::: "memory");
              hv = sinf(fr * p0); }
          H3[(size_t)pos * 64 + lane] = hv;
      } }
    }
}
__device__ __forceinline__ void p1_filter_proj(Frame& F) {
    const float* const* in = F.in; unsigned char* ws = F.ws; const int lane = F.lane;
    const float* H3 = (const float*)(ws + WS_H3); float* FILT = (float*)(ws + WS_FILT); LAS float* hl = (LAS float*)(F.lds + F.wave * 16384);
    const float min_decay = -3.0701134573253943f, max_decay = -15.350567286626972f;
    for (int item = F.gw; item < 128 * 64; item += F.ngw) {
        const int pb = item >> 6, cbk = item & 63, col = cbk * 64 + lane;
#pragma unroll
        for (int p = 0; p < 16; ++p) hl[p * 64 + lane] = H3[(size_t)(16 * pb + p) * 64 + lane];
        asm volatile("s_waitcnt lgkmcnt(0)" ::: "memory");
        float acc[16];
#pragma unroll
        for (int p = 0; p < 16; ++p) acc[p] = 0.f;
        const float* wo = in[I_HYWOUT] + col;
#pragma unroll 4
        for (int i = 0; i < 64; i += 4) { const float w0 = wo[i * 4096], w1 = wo[(i + 1) * 4096], w2 = wo[(i + 2) * 4096], w3 = wo[(i + 3) * 4096];
#pragma unroll
            for (int p = 0; p < 16; ++p) { const f32x4 h4 = *(const LAS f32x4*)(hl + p * 64 + i); acc[p] += h4.x * w0 + h4.y * w1 + h4.z * w2 + h4.w * w3; } }
        const int o = col >> 11, d = (col >> 10) & 1, c = col & 1023;
        const float delta = fabsf(min_decay + (float)c * ((max_decay - min_decay) / 1023.0f));
        float* fp = FILT + (size_t)(o * 1024 + c) * 4096;
#pragma unroll
        for (int p = 0; p < 16; ++p) { const int pos = 16 * pb + p; const float val = acc[p] * expf(-((float)pos / 2047.0f) * delta);
            if (d == 0) fp[2047 + pos] = val; else if (pos >= 1) fp[2047 - pos] = val; }
        asm volatile("s_waitcnt lgkmcnt(0)" ::: "memory");
    }
}
__device__ __forceinline__ void p1_modred(Frame& F) {
    const float* MP = (const float*)(F.ws + WS_MODP); float* MV = (float*)(F.ws + WS_MODV);
    for (int i = blockIdx.x * 512 + F.tid; i < 2 * 9 * NMODC; i += F.G * 512) {
        const int col = i % NMODC, r = (i / NMODC) % 9, l = i / (9 * NMODC); float s = F.in[I_MODB][l * NMODC + col];
#pragma unroll
        for (int kc = 0; kc < 32; ++kc) s += MP[((size_t)(l * 32 + kc) * 9 + r) * NMODC + col];
        MV[i] = s; }
}
__device__ __forceinline__ void quant_item(const float* W, int N, int k0, int n0, int drow0, const unsigned* cmax, float* cs, unsigned char* WT, LAS float* scr, int lane) {
    const float cm = fmaxf(__uint_as_float(cmax[drow0 + (lane & 31)]), 1e-30f), isc = 127.0f / cm;
    if (k0 == 0 && lane < 32) cs[drow0 + lane] = cm * (1.0f / 127.0f);
#pragma unroll
    for (int i = 0; i < 32; ++i) { const int kk = 2 * i + (lane >> 5); scr[kk * 33 + (lane & 31)] = rintf(__builtin_nontemporal_load(W + (size_t)(k0 + kk) * N + n0 + (lane & 31)) * isc); }
    asm volatile("s_waitcnt lgkmcnt(0)" ::: "memory");
    const int c = lane & 7;
#pragma unroll
    for (int j = 0; j < 4; ++j) { const int n = (lane >> 3) + 8 * j; const LAS float* sp = scr + (8 * c) * 33 + n; unsigned lo = 0u, hi = 0u;
#pragma unroll
        for (int q = 0; q < 4; ++q) { lo |= ((unsigned)((int)sp[q * 33]) & 255u) << (8 * q); hi |= ((unsigned)((int)sp[(4 + q) * 33]) & 255u) << (8 * q); }
        *(v2u*)(WT + (size_t)(drow0 + n) * DM + k0 + 8 * c) = (v2u){lo, hi}; }
    asm volatile("s_waitcnt lgkmcnt(0)" ::: "memory");
}
__device__ __forceinline__ void p1_quant_weights(Frame& F) {
    LAS float* scr = (LAS float*)(F.lds + F.wave * 16384); const float* const* in = F.in; unsigned char* ws = F.ws; const int lane = F.lane;
    const unsigned* CM = (const unsigned*)(ws + WS_CTL);
    constexpr int I1 = (DM / 64) * (DFF / 32), NI_GU = 8 * I1, NI_EV = (DM / 64) * (EVEN_IN / 32), NI_OD = (DM / 64) * (ODD_IN / 32);
    constexpr int NI_ALL = NI_GU + (I8_INPROJ ? NI_EV + NI_OD : 0);
    for (int it0 = F.gw; it0 < NI_ALL - (GU_ONEPASS ? NI_GU + (I8_INPROJ && EV_ONEPASS ? NI_EV : 0) : 0); it0 += F.ngw) { const int it = NI_ALL - 1 - it0;
        if (it < NI_GU) { const int mm = it / I1, rr = it % I1, mat = mm & 1, lab = mm >> 1, nblk = DFF / 32, kb = rr / nblk, n0 = (rr % nblk) * 32;
            quant_item((mat == 0 ? in[I_WG] : in[I_WU]) + (size_t)lab * DM * DFF, DFF, kb * 64, n0, (n0 >> 7) * 256 + (n0 & 127) + mat * 128, CM + CW_CMAX + lab * 2 * DFF, (float*)(ws + WS_CS) + lab * 2 * DFF, ws + WS_WGU + (size_t)lab * SZ_WGU8, scr, lane); }
        else if (it < NI_GU + NI_EV) { if (!I8_EV) continue; const int r = it - NI_GU, nblk = EVEN_IN / 32; quant_item(in[I_EVWIN], EVEN_IN, (r / nblk) * 64, (r % nblk) * 32, (r % nblk) * 32, CM + CW_CMAX_EV, (float*)(ws + WS_CS2), ws + WS_WEVIN, scr, lane); }
        else { if (!I8_OD) continue; const int r = it - NI_GU - NI_EV, nblk = ODD_IN / 32; quant_item(in[I_ODWIN], ODD_IN, (r / nblk) * 64, (r % nblk) * 32, (r % nblk) * 32, CM + CW_CMAX_OD, (float*)(ws + WS_CS2) + EVEN_IN, ws + WS_WODIN, scr, lane); }
    }
}
constexpr int QP_RS = 4112;
__device__ __forceinline__ const float* qp_src(const float* const* in, int unit, int kb, int lane, int& N) {
    if (unit >= 8 * 176) { N = EVEN_IN; return in[I_EVWIN] + (size_t)kb * EVEN_IN + (unit - 8 * 176) * 32 + (lane & 31); }
    const int mm = unit / 176, nb = unit % 176; N = DFF; return ((mm & 1) == 0 ? in[I_WG] : in[I_WU]) + (size_t)(mm >> 1) * DM * DFF + (size_t)kb * DFF + nb * 32 + (lane & 31);
}
__device__ __forceinline__ void p1_quant_gateup(Frame& F, int ubeg, int uend, int rank, int nranks) {
    const float* const* in = F.in; unsigned char* ws = F.ws; const int lane = F.lane, tid = F.tid, w = F.wave;
    LAS unsigned char* L = F.lds; LAS float* wm = (LAS float*)(F.lds + 32 * QP_RS);
    const int NU = uend;
    const int kb = w * 256 + (lane >> 5);
    float pre[32];
    if (ubeg + rank < NU) { int N; const float* W = qp_src(in, ubeg + rank, kb, lane, N);
#pragma unroll
        for (int i = 0; i < 32; ++i) pre[i] = __builtin_nontemporal_load(W + (size_t)(2 * i) * N); }
    for (int unit = ubeg + rank; unit < NU; unit += nranks) {
        const bool ev = unit >= 8 * 176; const int mm = unit / 176, nb = ev ? unit - 8 * 176 : unit % 176, mat = mm & 1, lab = mm >> 1, n0 = nb * 32;
        int N; const float* W = qp_src(in, unit, kb, lane, N);
        __syncthreads();
        float mx = 0.f; LAS unsigned char* lw = L + (lane & 31) * QP_RS + 2 * kb;
#pragma unroll
        for (int i = 0; i < 32; ++i) { const unsigned hb = f2bf(pre[i]); mx = fmaxf(mx, fabsf(bf2f(hb))); *(LAS unsigned short*)(lw + 4 * i) = (unsigned short)hb; }
#pragma unroll 32
        for (int i = 32; i < 128; ++i) { const float v = __builtin_nontemporal_load(W + (size_t)(2 * i) * N); const unsigned hb = f2bf(v); mx = fmaxf(mx, fabsf(bf2f(hb))); *(LAS unsigned short*)(lw + 4 * i) = (unsigned short)hb; }
        mx = fmaxf(mx, __shfl_xor(mx, 32));
        if (lane < 32) wm[w * 32 + lane] = mx;
        __syncthreads();
        if (unit + nranks < NU) { int Nn; const float* Wn = qp_src(in, unit + nranks, kb, lane, Nn);
#pragma unroll
            for (int i = 0; i < 32; ++i) pre[i] = __builtin_nontemporal_load(Wn + (size_t)(2 * i) * Nn); }
        unsigned char* WT = ev ? ws + WS_WEVIN : ws + WS_WGU + (size_t)lab * SZ_WGU8; float* cs = ev ? (float*)(ws + WS_CS2) : (float*)(ws + WS_CS) + lab * 2 * DFF;
        for (int idx = tid; idx < 32 * 256; idx += 512) { const int n = idx >> 8, kg = idx & 255;
            float cm = wm[n];
#pragma unroll
            for (int ww = 1; ww < 8; ++ww) cm = fmaxf(cm, wm[ww * 32 + n]);
            cm = fmaxf(cm, 1e-30f); const float isc = 127.0f / cm;
            const v4u q = *(const LAS v4u*)(L + n * QP_RS + 16 * kg);
            const unsigned qq[4] = {q.x, q.y, q.z, q.w}; unsigned o[2] = {0u, 0u};
#pragma unroll
            for (int e = 0; e < 4; ++e) {
                const unsigned a = __float_as_uint(fmaf(bf2f(qq[e] & 0xffffu), isc, 12582912.0f)) & 255u, b = __float_as_uint(fmaf(bf2f(qq[e] >> 16), isc, 12582912.0f)) & 255u;
                o[e >> 1] |= (a | (b << 8)) << (16 * (e & 1)); }
            const int nn = n0 + n, drow = ev ? nn : (nn >> 7) * 256 + (nn & 127) + mat * 128;
            *(v2u*)(WT + (size_t)drow * DM + 8 * kg) = (v2u){o[0], o[1]};
            if (kg == 0) cs[drow] = cm * (1.0f / 127.0f); }
    }
    __syncthreads();
}
__device__ __forceinline__ void tail_quant(Frame& F, int lo, int hi, int dbeg, int dend) {
    if (lo >= hi) { lo = 0; hi = F.G; }
    const int c = blockIdx.x; if (c >= lo && c < hi) p1_quant_gateup(F, 352 + dbeg, 352 + dend, c - lo, hi - lo);
}
#define PN_C(j) (8 * (F.lane + 64 * ((j) >> 1)) + 4 * ((j) & 1))
__device__ __forceinline__ void pn_load16(const bf16* p, int lane, v4u (&q)[4]) {
#pragma unroll
    for (int jj = 0; jj < 4; ++jj) q[jj] = *(const v4u*)(p + 8 * (lane + 64 * jj));
}
__device__ __forceinline__ void pn_unpack16(const v4u (&q)[4], f32x4 (&v)[8]) {
#pragma unroll
    for (int jj = 0; jj < 4; ++jj) { v[2 * jj] = (f32x4){bf2f(q[jj].x & 0xffffu), bf2f(q[jj].x >> 16), bf2f(q[jj].y & 0xffffu), bf2f(q[jj].y >> 16)}; v[2 * jj + 1] = (f32x4){bf2f(q[jj].z & 0xffffu), bf2f(q[jj].z >> 16), bf2f(q[jj].w & 0xffffu), bf2f(q[jj].w >> 16)}; }
}
__device__ __forceinline__ void prenorm_phase(Frame& F, const float* xl, const float* xc, int rows, int layer, int sub, int fold_part = 0, const bf16* xl16 = nullptr) {
    const float* g = F.in[I_NORMG] + (layer * 3 + sub) * DM; const float* MV = (const float*)(F.ws + WS_MODV) + (size_t)layer * 9 * NMODC; bf16* H = (bf16*)(F.ws + WS_H);
    const int rows16 = xl16 != nullptr ? min(rows, ML) : 0; v4u qn[4];
    if (F.gw < rows16) pn_load16(xl16 + (size_t)F.gw * DM, F.lane, qn);
    for (int row = F.gw; row < rows; row += F.ngw) {
        const float* xr = row < ML ? xl + (size_t)row * DM : xc + (size_t)(row - ML) * DM; const int r = row < ML ? row / SEQ : 8;
        const float* sh = MV + (size_t)r * NMODC + (3 * sub) * DM; const float* sc = sh + DM;
        f32x4 v[8]; float s = 0.f;
        if (row < rows16) { pn_unpack16(qn, v); if (row + F.ngw < rows16) pn_load16(xl16 + (size_t)(row + F.ngw) * DM, F.lane, qn); }
        else {
#pragma unroll
            for (int j = 0; j < 8; ++j) v[j] = *(const f32x4*)(xr + PN_C(j)); }
#pragma unroll
        for (int j = 0; j < 8; ++j) s += (v[j].x * v[j].x + v[j].y * v[j].y) + (v[j].z * v[j].z + v[j].w * v[j].w);
        if (fold_part && row >= ML) { const float* pp = (const float*)(F.ws + WS_PART) + (size_t)(row - ML) * DM; s = 0.f; float* xo = (float*)(F.ws + WS_XS) + (size_t)row * DM;
#pragma unroll
            for (int j = 0; j < 8; ++j) { const int c = PN_C(j); { f32x4 ps = *(const f32x4*)(pp + c) + *(const f32x4*)(pp + (size_t)MC * DM + c); if (fold_part == 4) ps += *(const f32x4*)(pp + (size_t)2 * MC * DM + c) + *(const f32x4*)(pp + (size_t)3 * MC * DM + c); v[j] += ps; }
                s += (v[j].x * v[j].x + v[j].y * v[j].y) + (v[j].z * v[j].z + v[j].w * v[j].w); *(f32x4*)(xo + c) = v[j]; } }
        const float rstd = 1.0f / sqrtf(wave_sum(s) * (1.0f / DM) + EPS);
#pragma unroll
        for (int j = 0; j < 8; ++j) { const int c = PN_C(j); const f32x4 gg = *(const f32x4*)(g + c), ss = *(const f32x4*)(sc + c), hh = *(const f32x4*)(sh + c);
            v[j] = (v[j] * rstd * gg) * (ss + 1.0f) + hh; }
#pragma unroll
        for (int jj = 0; jj < 4; ++jj) { const f32x4 y0 = v[2 * jj], y1 = v[2 * jj + 1]; *(v4u*)(H + (size_t)row * DM + 8 * (F.lane + 64 * jj)) = (v4u){pk2(y0.x, y0.y), pk2(y0.z, y0.w), pk2(y1.x, y1.y), pk2(y1.z, y1.w)}; }
    }
}
__device__ __forceinline__ void prenorm8_phase(Frame& F, const float* xl, const float* xc, int rows, int layer, int sub, bool copy_ctx = false, int fold_part = 0, const bf16* xl16 = nullptr) {
    const float* g = F.in[I_NORMG] + (layer * 3 + sub) * DM; const float* MV = (const float*)(F.ws + WS_MODV) + (size_t)layer * 9 * NMODC; unsigned char* H8 = (unsigned char*)(F.ws + WS_H); float* RS = (float*)(F.ws + WS_RS);
    const int rows16 = xl16 != nullptr ? min(rows, ML) : 0; v4u qn[4]; f32x4 fnx[8]; const bool pf32 = xl16 == nullptr;
    if (F.gw < rows16) pn_load16(xl16 + (size_t)F.gw * DM, F.lane, qn);
    if (pf32 && F.gw < rows) { const float* x0 = F.gw < ML ? xl + (size_t)F.gw * DM : xc + (size_t)(F.gw - ML) * DM;
#pragma unroll
        for (int j = 0; j < 8; ++j) fnx[j] = *(const f32x4*)(x0 + PN_C(j)); }
    for (int row = F.gw; row < rows; row += F.ngw) {
        const float* xr = row < ML ? xl + (size_t)row * DM : xc + (size_t)(row - ML) * DM; const int r = row < ML ? row / SEQ : 8;
        const float* sh = MV + (size_t)r * NMODC + (3 * sub) * DM; const float* sc = sh + DM;
        f32x4 v[8]; float s = 0.f;
        if (row < rows16) { pn_unpack16(qn, v); if (row + F.ngw < rows16) pn_load16(xl16 + (size_t)(row + F.ngw) * DM, F.lane, qn); }
        else if (pf32) {
#pragma unroll
            for (int j = 0; j < 8; ++j) v[j] = fnx[j];
            const int nr = row + F.ngw; if (nr < rows) { const float* xn = nr < ML ? xl + (size_t)nr * DM : xc + (size_t)(nr - ML) * DM;
#pragma unroll
                for (int j = 0; j < 8; ++j) fnx[j] = *(const f32x4*)(xn + PN_C(j)); } }
        else {
#pragma unroll
            for (int j = 0; j < 8; ++j) v[j] = *(const f32x4*)(xr + PN_C(j)); }
#pragma unroll
        for (int j = 0; j < 8; ++j) s += (v[j].x * v[j].x + v[j].y * v[j].y) + (v[j].z * v[j].z + v[j].w * v[j].w);
        if (fold_part && row >= ML) { const float* pp = (const float*)(F.ws + WS_PART) + (size_t)(row - ML) * DM; s = 0.f;
#pragma unroll
            for (int j = 0; j < 8; ++j) { const int c = PN_C(j); { f32x4 ps = *(const f32x4*)(pp + c) + *(const f32x4*)(pp + (size_t)MC * DM + c); if (fold_part == 4) ps += *(const f32x4*)(pp + (size_t)2 * MC * DM + c) + *(const f32x4*)(pp + (size_t)3 * MC * DM + c); v[j] += ps; }
                s += (v[j].x * v[j].x + v[j].y * v[j].y) + (v[j].z * v[j].z + v[j].w * v[j].w); } }
        if ((copy_ctx || fold_part) && row >= ML) { float* xo = (float*)(F.ws + WS_XS) + (size_t)row * DM;
#pragma unroll
            for (int j = 0; j < 8; ++j) *(f32x4*)(xo + PN_C(j)) = v[j]; }
        const float rstd = 1.0f / sqrtf(wave_sum(s) * (1.0f / DM) + EPS); float mx = 1e-20f;
#pragma unroll
        for (int j = 0; j < 8; ++j) { const int c = PN_C(j); const f32x4 gg = *(const f32x4*)(g + c), ss = *(const f32x4*)(sc + c), hh = *(const f32x4*)(sh + c);
            v[j] = (v[j] * rstd * gg) * (ss + 1.0f) + hh; mx = fmaxf(mx, fmaxf(fmaxf(fabsf(v[j].x), fabsf(v[j].y)), fmaxf(fabsf(v[j].z), fabsf(v[j].w)))); }
        mx = wave_max(mx); const float isc = 127.0f / mx;
        if (F.lane == 0) RS[row] = mx * (1.0f / 127.0f);
#pragma unroll
        for (int jj = 0; jj < 4; ++jj) { unsigned w2[2];
#pragma unroll
            for (int e = 0; e < 2; ++e) { const f32x4 y = v[2 * jj + e]; const int q0 = (int)rintf(y.x * isc), q1 = (int)rintf(y.y * isc), q2 = (int)rintf(y.z * isc), q3 = (int)rintf(y.w * isc);
                w2[e] = (unsigned)(q0 & 255) | ((unsigned)(q1 & 255) << 8) | ((unsigned)(q2 & 255) << 16) | ((unsigned)(q3 & 255) << 24); }
            *(v2u*)(H8 + (size_t)row * DM + 8 * (F.lane + 64 * jj)) = (v2u){w2[0], w2[1]}; }
    }
}
__device__ __forceinline__ void final_norm_phase(Frame& F) {
    const bf16* X = (const bf16*)(F.ws + WS_XS); const float* g = F.in[I_FINALG]; v4u qn[4];
    if (F.gw < ML) pn_load16(X + (size_t)F.gw * DM, F.lane, qn);
    for (int row = F.gw; row < ML; row += F.ngw) {
        f32x4 v[8]; float s = 0.f; pn_unpack16(qn, v); if (row + F.ngw < ML) pn_load16(X + (size_t)(row + F.ngw) * DM, F.lane, qn);
#pragma unroll
        for (int j = 0; j < 8; ++j) s += (v[j].x * v[j].x + v[j].y * v[j].y) + (v[j].z * v[j].z + v[j].w * v[j].w);
        const float rstd = 1.0f / sqrtf(wave_sum(s) * (1.0f / DM) + EPS);
#pragma unroll
        for (int j = 0; j < 8; ++j) { const int c = PN_C(j); *(f32x4*)(F.out + (size_t)row * DM + c) = v[j] * rstd * *(const f32x4*)(g + c); }
    }
}
__device__ __forceinline__ int s5_row(int i, int dir, int b) { if (i < CTXL) { const int j = dir ? CTXL - 1 - i : i; return ML + b * CTXL + j; } const int t = i - CTXL; return b * SEQ + (dir ? SEQ - 1 - t : t); }
typedef short bf16x8v __attribute__((ext_vector_type(8)));
constexpr int NTOK = SEQ + CTXL;
__device__ __forceinline__ void vt_transpose_phase(Frame& F) {
    const bf16* P = (const bf16*)(F.ws + WS_BIG); bf16* VT = (bf16*)(F.ws + WS_VT); const int lane = F.lane;
    LAS unsigned* tile = (LAS unsigned*)(F.lds + F.wave * 16384);
    for (int item = F.gw; item < 64 * 2 * 36; item += F.ngw) {
        const int tb = item % 36, db = (item / 36) & 1, bh = item / 72, b = bh >> 3, h = bh & 7;
        const int row0 = tb < 32 ? b * SEQ + tb * 64 : ML + b * CTXL + (tb - 32) * 64;
        const bf16* src = P + (size_t)row0 * EVEN_LD + 3072 + h * 128 + db * 64 + 8 * (lane & 7);
#pragma unroll
        for (int i = 0; i < 8; ++i) { const int tl = (lane >> 3) + 8 * i; const v4u v = *(const v4u*)(src + (size_t)tl * EVEN_LD);
            LAS unsigned* tp = tile + tl * 33 + 4 * (lane & 7); tp[0] = v.x; tp[1] = v.y; tp[2] = v.z; tp[3] = v.w; }
        asm volatile("s_waitcnt lgkmcnt(0)" ::: "memory");
        bf16* dst = VT + ((size_t)bh * 128 + db * 64) * NTOK + tb * 64 + lane;
#pragma unroll 8
        for (int dp = 0; dp < 32; ++dp) { const unsigned w = tile[lane * 33 + dp]; dst[(size_t)(2 * dp) * NTOK] = (bf16)(w & 0xffffu); dst[(size_t)(2 * dp + 1) * NTOK] = (bf16)(w >> 16); }
        asm volatile("s_waitcnt lgkmcnt(0)" ::: "memory");
    }
}
constexpr int NA_KS = 272, NA_VS = 528, NA_VOFF = 256 * NA_KS;
template <bool LOCAL, bool CL>
__device__ __forceinline__ void na_item(const bf16* P, const bf16* VT, bf16* MIX, const float* rpb, int b, int h, int qrow0, int r, int c, int lane, const LAS unsigned char* cl) {
    constexpr int NT = LOCAL ? 32 : 16, NLT = LOCAL ? 16 : 0;
    const int i = lane & 15, g = lane >> 4;
    const int rs = min(max(r - 4, 0), 24), w0 = (c == 0) ? 0 : (c == 1) ? 8 : (c == 2) ? 24 : 32;
    bf16x8v qf[4];
    { const bf16* qp = P + (size_t)(qrow0 + i) * EVEN_LD + 1024 + h * 128 + 8 * g;
#pragma unroll
      for (int ks = 0; ks < 4; ++ks) qf[ks] = *(const bf16x8v*)(qp + 32 * ks); }
    f32x4 S[NT];
    const int ik = 8 * (i >> 2) + (i & 3);
    unsigned klo = (unsigned)(ik * NA_KS + 16 * g), vlo = (unsigned)(NA_VOFF + i * NA_VS + 16 * g); asm volatile("" : "+v"(klo), "+v"(vlo));
    const LAS unsigned char* klb = cl + klo; const LAS unsigned char* vlb = cl + vlo;
#pragma unroll
    for (int T0 = 0; T0 < NT; T0 += 2) {
        bf16x8v kf[2][4];
#pragma unroll
        for (int e = 0; e < 2; ++e) { const int T = T0 + e;
            if (CL && T >= NLT) { const LAS unsigned char* kl = klb + (32 * ((T - NLT) >> 1) + 4 * e) * NA_KS;
#pragma unroll
                for (int ks = 0; ks < 4; ++ks) kf[e][ks] = *(const LAS bf16x8v*)(kl + 64 * ks); }
            else { size_t krow;
                if (T < NLT) krow = (size_t)b * SEQ + (rs + (T >> 1)) * 64 + w0 + ik + 4 * e; else krow = (size_t)ML + b * CTXL + 32 * ((T - NLT) >> 1) + ik + 4 * e;
                const bf16* kp = P + krow * EVEN_LD + 2048 + h * 128 + 8 * g;
#pragma unroll
                for (int ks = 0; ks < 4; ++ks) kf[e][ks] = *(const bf16x8v*)(kp + 32 * ks); } }
#pragma unroll
        for (int e = 0; e < 2; ++e) { f32x4 acc = (f32x4){0.f, 0.f, 0.f, 0.f};
#pragma unroll
            for (int ks = 0; ks < 4; ++ks) acc = __builtin_amdgcn_mfma_f32_16x16x32_bf16(kf[e][ks], qf[ks], acc, 0, 0, 0);
            S[T0 + e] = acc; }
    }
    const float scale = 0.08838834764831845f; float mx = -3.0e38f;
    const int qc = 16 * c + i, cs = min(max(qc - 8, 0), 48);
#pragma unroll
    for (int T = 0; T < NT; ++T) {
        if (T < NLT) { const float* rp = rpb + (h * 15 + (rs + (T >> 1) - r + 7)) * 31;
#pragma unroll
            for (int q = 0; q < 4; ++q) { const int col = w0 + 8 * g + 4 * (T & 1) + q; const bool ok = (col >= cs) && (col < cs + 16); const int dc = min(max(col - qc + 15, 0), 30);
                S[T][q] = ok ? S[T][q] * scale + rp[dc] : -3.0e38f; } }
        else S[T] = S[T] * scale;
        mx = fmaxf(mx, fmaxf(fmaxf(S[T][0], S[T][1]), fmaxf(S[T][2], S[T][3]))); }
    mx = fmaxf(mx, __shfl_xor(mx, 16)); mx = fmaxf(mx, __shfl_xor(mx, 32));
    float sum = 0.f; bf16x8v pf[NT / 2];
#pragma unroll
    for (int s = 0; s < NT / 2; ++s) { float p[8];
#pragma unroll
        for (int q = 0; q < 4; ++q) { p[q] = __expf(S[2 * s][q] - mx); p[4 + q] = __expf(S[2 * s + 1][q] - mx); }
#pragma unroll
        for (int q = 0; q < 8; ++q) sum += p[q];
        v4u w; w.x = pk2(p[0], p[1]); w.y = pk2(p[2], p[3]); w.z = pk2(p[4], p[5]); w.w = pk2(p[6], p[7]);
        pf[s] = __builtin_bit_cast(bf16x8v, w); }
    sum += __shfl_xor(sum, 16); sum += __shfl_xor(sum, 32);
    const float inv = 1.0f / sum;
    const unsigned voff = (unsigned)((((b * 8 + h) * 128 + i) * NTOK + 8 * g) * 2);
#pragma unroll
    for (int dt = 0; dt < 8; ++dt) {
        f32x4 o = (f32x4){0.f, 0.f, 0.f, 0.f};
#pragma unroll
        for (int s0 = 0; s0 < NT / 2; s0 += 8) {
            bf16x8v vf[8];
#pragma unroll
            for (int s1 = 0; s1 < 8; ++s1) { const int s = s0 + s1;
                if (CL && s >= NLT / 2) vf[s1] = *(const LAS bf16x8v*)(vlb + (16 * dt) * NA_VS + 64 * (s - NLT / 2));
                else { const int tok = (s < NLT / 2) ? (rs + s) * 64 + w0 : SEQ + 32 * (s - NLT / 2); vf[s1] = *(const bf16x8v*)((const char*)VT + (voff + (unsigned)(((16 * dt) * NTOK + tok) * 2))); } }
#pragma unroll
            for (int s1 = 0; s1 < 8; ++s1) o = __builtin_amdgcn_mfma_f32_16x16x32_bf16(vf[s1], pf[s0 + s1], o, 0, 0, 0);
        }
        v2u w; w.x = pk2(o[0] * inv, o[1] * inv); w.y = pk2(o[2] * inv, o[3] * inv);
        *(v2u*)(MIX + (size_t)(qrow0 + i) * DM + 1024 + h * 128 + 16 * dt + 4 * g) = w;
    }
}
__device__ __forceinline__ void na_mfma_phase(Frame& F) {
    const bf16* P = (const bf16*)(F.ws + WS_BIG); const bf16* VT = (const bf16*)(F.ws + WS_VT); bf16* MIX = (bf16*)(F.ws + WS_MIX); const float* rpb = F.in[I_RPB];
    for (int unit = blockIdx.x; unit < 64 * 4; unit += F.G) {
        const int bh = unit >> 2, q = unit & 3, b = bh >> 3, h = bh & 7;
        __syncthreads();
        for (int t = F.tid; t < 4096; t += 512) { const int key = t >> 4, ch = t & 15;
            *(LAS v4u*)(F.lds + key * NA_KS + ch * 16) = *(const v4u*)(P + (size_t)(ML + b * CTXL + key) * EVEN_LD + 2048 + h * 128 + ch * 8); }
        for (int t = F.tid; t < 4096; t += 512) { const int d = t >> 5, ch = t & 31;
            *(LAS v4u*)(F.lds + NA_VOFF + d * NA_VS + ch * 16) = *(const v4u*)(VT + ((size_t)bh * 128 + d) * NTOK + SEQ + ch * 8); }
        __syncthreads();
        for (int n = F.wave; n < 36; n += NWAVES) {
            if (n < 32) { const int c = n & 3, r = 8 * q + (n >> 2); na_item<true, true>(P, VT, MIX, rpb, b, h, b * SEQ + r * 64 + 16 * c, r, c, F.lane, F.lds); }
            else na_item<false, true>(P, VT, MIX, rpb, b, h, ML + b * CTXL + 16 * (4 * q + n - 32), 0, 0, F.lane, F.lds); }
    }
    __syncthreads();
}
constexpr int S5COLS = NB * 36;
__device__ __forceinline__ int s5_colrow(int col) { const int b = col / 36, ch = col % 36; return ch < 4 ? ML + b * CTXL + 64 * ch : b * SEQ + 64 * (ch - 4); }
__device__ __forceinline__ void s5_disc(const float* const* in, int dir, int g, int p, float& are_dt, float& aim_dt, float& cr, float& ci) {
    const int gp = (dir * 64 + g) * 64 + p; const float are = in[I_S5ARE][gp], aim = in[I_S5AIM][gp], dt = expf(in[I_S5LOGDT][dir * 64 + g]);
    const float er = expf(are * dt); float sn, cs; sincosf(aim * dt, &sn, &cs);
    const float nr = er * cs - 1.0f, ni = er * sn, den = are * are + aim * aim;
    cr = (nr * are + ni * aim) / den; ci = (ni * are - nr * aim) / den; are_dt = are * dt; aim_dt = aim * dt;
}
__device__ __forceinline__ void s5_prep_items(Frame& F) {
    const float* const* in = F.in; const int lane = F.lane;
    LAS float* Bl = (LAS float*)(F.lds + F.wave * 16384); LAS float* Zl = Bl + 2048;
    float* KF = (float*)(F.ws + WS_S5KF); bf16* W = (bf16*)(F.ws + WS_S5W); bf16* V = (bf16*)(F.ws + WS_S5V);
    for (int item = F.gw; item < 64 * 2 * 32; item += F.ngw) {
        const int nb = item & 31, dir = (item >> 5) & 1, g = item >> 6, p = lane, gp = (dir * 64 + g) * 64 + p;
        float ared, aimd, cr, ci; s5_disc(in, dir, g, p, ared, aimd, cr, ci);
        float Br[16], Bi[16], Cr[16], Ci[16];
#pragma unroll
        for (int h = 0; h < 16; ++h) { const float br = in[I_S5BRE][(size_t)gp * 16 + h], bi = in[I_S5BIM][(size_t)gp * 16 + h]; Br[h] = cr * br - ci * bi; Bi[h] = cr * bi + ci * br;
            Cr[h] = in[I_S5CRE][((size_t)(dir * 64 + g) * 16 + h) * 64 + p]; Ci[h] = in[I_S5CIM][((size_t)(dir * 64 + g) * 16 + h) * 64 + p];
            Bl[(p * 16 + h) * 2] = Br[h]; Bl[(p * 16 + h) * 2 + 1] = Bi[h]; }
        float pr[3], pi[3];
#pragma unroll
        for (int k = 0; k < 3; ++k) { const float e = (float)(2 * nb + k); const float er = expf(ared * e); float sn, cs; sincosf(aimd * e, &sn, &cs); pr[k] = er * cs; pi[k] = er * sn; }
#pragma unroll
        for (int k = 0; k < 2; ++k) {
            const int e = 2 * nb + k;
#pragma unroll
            for (int h = 0; h < 16; ++h) { Zl[(p * 16 + h) * 2] = Cr[h] * pr[k] - Ci[h] * pi[k]; Zl[(p * 16 + h) * 2 + 1] = Cr[h] * pi[k] + Ci[h] * pr[k]; }
            asm volatile("s_waitcnt lgkmcnt(0)" ::: "memory");
            { const int h = lane >> 2, hp0 = 4 * (lane & 3); float a4[4] = {0.f, 0.f, 0.f, 0.f};
              for (int pp = 0; pp < 64; ++pp) { const float zr = Zl[(pp * 16 + h) * 2], zi = Zl[(pp * 16 + h) * 2 + 1];
#pragma unroll
                  for (int q = 0; q < 4; ++q) a4[q] += zr * Bl[(pp * 16 + hp0 + q) * 2] - zi * Bl[(pp * 16 + hp0 + q) * 2 + 1]; }
              *(f32x4*)(KF + ((size_t)((g * 2 + dir) * 64 + e)) * 256 + h * 16 + hp0) = (f32x4){a4[0], a4[1], a4[2], a4[3]}; }
            asm volatile("s_waitcnt lgkmcnt(0)" ::: "memory");
            { const int s = dir ? e : 63 - e; unsigned wr[8], wi[8];
#pragma unroll
              for (int q = 0; q < 8; ++q) { const float r0 = pr[k] * Br[2 * q] - pi[k] * Bi[2 * q], r1 = pr[k] * Br[2 * q + 1] - pi[k] * Bi[2 * q + 1];
                  const float i0 = pr[k] * Bi[2 * q] + pi[k] * Br[2 * q], i1 = pr[k] * Bi[2 * q + 1] + pi[k] * Br[2 * q + 1]; wr[q] = pk2(r0, r1); wi[q] = pk2(i0, i1); }
              bf16* wp = W + ((size_t)g * 256 + dir * 128 + 2 * p) * 1024 + s * 16;
              *(v4u*)wp = (v4u){wr[0], wr[1], wr[2], wr[3]}; *(v4u*)(wp + 8) = (v4u){wr[4], wr[5], wr[6], wr[7]};
              *(v4u*)(wp + 1024) = (v4u){wi[0], wi[1], wi[2], wi[3]}; *(v4u*)(wp + 1024 + 8) = (v4u){wi[4], wi[5], wi[6], wi[7]}; }
            { const int l = dir ? 63 - e : e;
#pragma unroll
              for (int h = 0; h < 16; ++h) { const float zr = Cr[h] * pr[k + 1] - Ci[h] * pi[k + 1], zi = Cr[h] * pi[k + 1] + Ci[h] * pr[k + 1];
                  *(unsigned*)(V + ((size_t)g * 1024 + l * 16 + h) * 256 + dir * 128 + 2 * p) = pk2(zr, -zi); } }
        }
    }
}
__device__ __forceinline__ void s5_statein_phase(Frame& F) {
    const bf16* P = (const bf16*)(F.ws + WS_BIG); const bf16* W = (const bf16*)(F.ws + WS_S5W); float* SL = (float*)(F.ws + WS_S5SLOC);
    const int i = F.lane & 15, gq = F.lane >> 4;
    for (int item = F.gw; item < 64 * 9 * 8; item += F.ngw) {
        const int me = item & 7, B = item >> 3, y = B >> 3, rr = ((y >> 2) << 3) + (B & 7), cb = rr % 9, g = (rr / 9) * 4 + (y & 3);
        const bf16* bp[2]; const bf16* ap[2];
#pragma unroll
        for (int ct = 0; ct < 2; ++ct) bp[ct] = P + (size_t)(s5_colrow(cb * 32 + 16 * ct + i) + (gq >> 1)) * EVEN_LD + g * 16 + 8 * (gq & 1);
#pragma unroll
        for (int mt = 0; mt < 2; ++mt) ap[mt] = W + ((size_t)g * 256 + 32 * me + 16 * mt + i) * 1024 + 8 * gq;
        f32x4 acc[2][2];
#pragma unroll
        for (int mt = 0; mt < 2; ++mt)
#pragma unroll
            for (int ct = 0; ct < 2; ++ct) acc[mt][ct] = (f32x4){0.f, 0.f, 0.f, 0.f};
#pragma unroll 8
        for (int ks = 0; ks < 32; ++ks) {
            bf16x8v bfr[2], afr[2];
#pragma unroll
            for (int ct = 0; ct < 2; ++ct) bfr[ct] = *(const bf16x8v*)(bp[ct] + (size_t)(2 * ks) * EVEN_LD);
#pragma unroll
            for (int mt = 0; mt < 2; ++mt) afr[mt] = *(const bf16x8v*)(ap[mt] + 32 * ks);
#pragma unroll
            for (int mt = 0; mt < 2; ++mt)
#pragma unroll
                for (int ct = 0; ct < 2; ++ct) acc[mt][ct] = __builtin_amdgcn_mfma_f32_16x16x32_bf16(afr[mt], bfr[ct], acc[mt][ct], 0, 0, 0);
        }
#pragma unroll
        for (int mt = 0; mt < 2; ++mt)
#pragma unroll
            for (int ct = 0; ct < 2; ++ct) *(f32x4*)(SL + ((size_t)g * S5COLS + cb * 32 + 16 * ct + i) * 256 + 32 * me + 16 * mt + 4 * gq) = acc[mt][ct];
    }
}
__device__ __forceinline__ void s5_chain_phase(Frame& F) {
    const float* SL = (const float*)(F.ws + WS_S5SLOC); bf16* SIN = (bf16*)(F.ws + WS_S5SIN);
    for (int idx = blockIdx.x * 512 + F.tid; idx < NB * 64 * 2 * 64; idx += F.G * 512) {
        const int p = idx & 63, dir = (idx >> 6) & 1, g = (idx >> 7) & 63, b = idx >> 13;
        float ared, aimd, cr, ci; s5_disc(F.in, dir, g, p, ared, aimd, cr, ci);
        const float er = expf(ared * 64.0f); float sn, cs; sincosf(aimd * 64.0f, &sn, &cs); const float qr = er * cs, qi = er * sn;
        const size_t base = ((size_t)g * S5COLS + b * 36) * 256 + dir * 128 + 2 * p;
        float sr = 0.f, si = 0.f;
#pragma unroll 6
        for (int j = 0; j < 36; ++j) {
            const int k = dir ? (j < 4 ? 3 - j : 39 - j) : j;
            const float2 v = *(const float2*)(SL + base + (size_t)k * 256); const float xr = v.x, xi = v.y;
            *(unsigned*)(SIN + base + (size_t)k * 256) = pk2(sr, si);
            const float nr = qr * sr - qi * si + xr, ni = qr * si + qi * sr + xi; sr = nr; si = ni; }
    }
}
constexpr int KT_ROWB = 48;
__device__ __forceinline__ float gelu_tanh2(float x) { const float u = 0.7978845608028654f * (x + 0.044715f * x * x * x); const float e = __expf(2.0f * u); return x * (1.0f - 1.0f / (e + 1.0f)); }
constexpr int S5_UOFF = 127 * 16 * KT_ROWB, S5_US = 2064;
__device__ __forceinline__ void s5_out_phase(Frame& F) {
    const bf16* P = (const bf16*)(F.ws + WS_BIG); const float* KF = (const float*)(F.ws + WS_S5KF); const bf16* V = (const bf16*)(F.ws + WS_S5V); const bf16* SIN = (const bf16*)(F.ws + WS_S5SIN);
    bf16* G = (bf16*)(F.ws + WS_G); const float* dd = F.in[I_S5D];
    const int i = F.lane & 15, gq = F.lane >> 4, w = F.wave;
    for (int unit = blockIdx.x; unit < 64 * 18; unit += F.G) {
        const int g = unit / 18, cb = unit % 18;
        v4u ur[4];
#pragma unroll
        for (int j = 0; j < 4; ++j) { const int id = F.tid + 512 * j, cl = id >> 7, sh = id & 127; ur[j] = *(const v4u*)(P + (size_t)(s5_colrow(cb * 16 + cl) + (sh >> 1)) * EVEN_LD + g * 16 + 8 * (sh & 1)); }
        __syncthreads();
        for (int idx = F.tid; idx < 127 * 32; idx += 512) { const int nn = idx >> 5, h = (idx >> 1) & 15, half = idx & 1; float v[8];
            if (nn == 63) { const float* k0 = KF + ((size_t)(g * 2 + 0) * 64) * 256 + h * 16 + 8 * half; const float* k1 = KF + ((size_t)(g * 2 + 1) * 64) * 256 + h * 16 + 8 * half;
#pragma unroll
                for (int j = 0; j < 8; ++j) v[j] = k0[j] + k1[j] + ((8 * half + j) == h ? dd[g * 16 + h] : 0.f); }
            else { const float* k0 = nn > 63 ? KF + ((size_t)(g * 2 + 0) * 64 + (nn - 63)) * 256 + h * 16 + 8 * half : KF + ((size_t)(g * 2 + 1) * 64 + (63 - nn)) * 256 + h * 16 + 8 * half;
#pragma unroll
                for (int j = 0; j < 8; ++j) v[j] = k0[j]; }
            *(LAS v4u*)(F.lds + (nn * 16 + h) * KT_ROWB + half * 16) = (v4u){pk2(v[0], v[1]), pk2(v[2], v[3]), pk2(v[4], v[5]), pk2(v[6], v[7])}; }
#pragma unroll
        for (int j = 0; j < 4; ++j) { const int id = F.tid + 512 * j, cl = id >> 7, sh = id & 127; *(LAS v4u*)(F.lds + S5_UOFF + cl * S5_US + sh * 16) = ur[j]; }
        __syncthreads();
        const int col = cb * 16 + i, rowbase = s5_colrow(col);
        f32x4 acc[8];
#pragma unroll
        for (int lt = 0; lt < 8; ++lt) acc[lt] = (f32x4){0.f, 0.f, 0.f, 0.f};
        unsigned kto = (unsigned)(((8 * w - (gq >> 1) + 63) * 16 + i) * KT_ROWB + (gq & 1) * 16), uo = (unsigned)(S5_UOFF + i * S5_US + gq * 16); asm volatile("" : "+v"(kto), "+v"(uo));
        const LAS unsigned char* kt = F.lds + kto;
        const LAS unsigned char* ub = F.lds + uo;
        bf16x8v fr[8];
#pragma unroll
        for (int d = 0; d < 8; ++d) fr[d] = *(const LAS bf16x8v*)(kt + d * (16 * KT_ROWB));
#pragma unroll
        for (int ks = 0; ks < 32; ++ks) {
            if (ks > 0) { fr[(8 - 2 * (ks & 3)) & 7] = *(const LAS bf16x8v*)(kt + (-2 * ks) * (16 * KT_ROWB)); fr[(9 - 2 * (ks & 3)) & 7] = *(const LAS bf16x8v*)(kt + (1 - 2 * ks) * (16 * KT_ROWB)); }
            const bf16x8v bfr = *(const LAS bf16x8v*)(ub + 64 * ks);
#pragma unroll
            for (int lt = 0; lt < 8; ++lt) acc[lt] = __builtin_amdgcn_mfma_f32_16x16x32_bf16(fr[(lt - 2 * ks) & 7], bfr, acc[lt], 0, 0, 0);
        }
        const bf16* sp = SIN + ((size_t)g * S5COLS + col) * 256 + 8 * gq; const bf16* vp = V + ((size_t)g * 1024 + (8 * w) * 16 + i) * 256 + 8 * gq;
#pragma unroll 2
        for (int k2 = 0; k2 < 8; ++k2) {
            const bf16x8v bf2 = *(const bf16x8v*)(sp + 32 * k2);
#pragma unroll
            for (int lt = 0; lt < 8; ++lt) { const bf16x8v afr = *(const bf16x8v*)(vp + (size_t)lt * 16 * 256 + 32 * k2); acc[lt] = __builtin_amdgcn_mfma_f32_16x16x32_bf16(afr, bf2, acc[lt], 0, 0, 0); }
        }
#pragma unroll
        for (int lt = 0; lt < 8; ++lt) { v2u o; o.x = pk2(gelu_tanh2(acc[lt][0]), gelu_tanh2(acc[lt][1])); o.y = pk2(gelu_tanh2(acc[lt][2]), gelu_tanh2(acc[lt][3]));
            *(v2u*)(G + (size_t)(rowbase + 8 * w + lt) * 1024 + g * 16 + 4 * gq) = o; }
    }
    __syncthreads();
}
__device__ __forceinline__ void ssd_prep_phase(Frame& F) {
    const bf16* P1 = (const bf16*)(F.ws + WS_BIG); bf16* XBC = (bf16*)(F.ws + WS_XBC); const float* cw = F.in[I_SSDCW]; const float* cb = F.in[I_SSDCB];
    const int c0 = (F.tid & 255) * 8; float w0[8], w1[8], w2[8], bb[8];
#pragma unroll
    for (int j = 0; j < 8; ++j) { w0[j] = cw[c0 + j]; w1[j] = cw[2048 + c0 + j]; w2[j] = cw[4096 + c0 + j]; bb[j] = cb[c0 + j]; }
    for (int row0 = blockIdx.x * 8 + (F.tid >> 8); row0 < MT; row0 += F.G * 8) {
        v4u a[4], m[4], n[4]; const v4u z4 = (v4u){0u, 0u, 0u, 0u};
#pragma unroll
        for (int q = 0; q < 4; ++q) { const int row = row0 + 2 * q; int pos, len; if (row < ML) { pos = row & 2047; len = SEQ; } else { pos = (row - ML) & 255; len = CTXL; }
            const bf16* pr = P1 + (size_t)row * ODD_LD + 4096 + c0;
            a[q] = pos > 0 ? *(const v4u*)(pr - ODD_LD) : z4; m[q] = *(const v4u*)pr; n[q] = pos < len - 1 ? *(const v4u*)(pr + ODD_LD) : z4; }
#pragma unroll
        for (int q = 0; q < 4; ++q) { const int row = row0 + 2 * q; unsigned o[4];
#pragma unroll
            for (int j = 0; j < 4; ++j) {
                const float y0 = w0[2 * j] * bf2f(a[q][j] & 0xffffu) + w1[2 * j] * bf2f(m[q][j] & 0xffffu) + w2[2 * j] * bf2f(n[q][j] & 0xffffu) + bb[2 * j];
                const float y1 = w0[2 * j + 1] * bf2f(a[q][j] >> 16) + w1[2 * j + 1] * bf2f(m[q][j] >> 16) + w2[2 * j + 1] * bf2f(n[q][j] >> 16) + bb[2 * j + 1];
                o[j] = pk2(silu_f(y0), silu_f(y1)); }
            *(v4u*)(XBC + (size_t)row * XBC_LD + c0) = (v4u){o[0], o[1], o[2], o[3]}; }
    }
}
__device__ __forceinline__ float softplus_f(float x) { return x > 20.f ? x : log1pf(expf(x)); }
__device__ __forceinline__ void ssd_scan_phase(Frame& F) {
    const bf16* XBC = (const bf16*)(F.ws + WS_XBC); const float* DT = (const float*)(F.ws + WS_DT); bf16* YS = (bf16*)(F.ws + WS_YS);
    for (int item = blockIdx.x; item < NB * 16 * 2; item += F.G) {
        const int dir = item & 1, hd = (item >> 1) & 15, b = item >> 5, g = hd >> 2, p = F.tid >> 3, ns = F.tid & 7;
        const float dtb = F.in[I_SSDDTB][dir * 16 + hd], a = -expf(F.in[I_SSDALOG][dir * 16 + hd]);
        float S[16];
#pragma unroll
        for (int i = 0; i < 16; ++i) S[i] = 0.f;
        int row = s5_row(0, dir, b);
        float dtr = DT[(size_t)row * 32 + dir * 16 + hd]; unsigned xr = XBC[(size_t)row * XBC_LD + hd * 64 + p];
        v4u bq0 = *(const v4u*)(XBC + (size_t)row * XBC_LD + 1024 + g * 128 + ns * 16), bq1 = *(const v4u*)(XBC + (size_t)row * XBC_LD + 1024 + g * 128 + ns * 16 + 8);
        v4u cq0 = *(const v4u*)(XBC + (size_t)row * XBC_LD + 1536 + g * 128 + ns * 16), cq1 = *(const v4u*)(XBC + (size_t)row * XBC_LD + 1536 + g * 128 + ns * 16 + 8);
        for (int i = 0; i < CTXL + SEQ; ++i) {
            const int rown = s5_row(i + 1 < CTXL + SEQ ? i + 1 : i, dir, b);
            const float dtr_n = DT[(size_t)rown * 32 + dir * 16 + hd]; const unsigned xr_n = XBC[(size_t)rown * XBC_LD + hd * 64 + p];
            const v4u bn0 = *(const v4u*)(XBC + (size_t)rown * XBC_LD + 1024 + g * 128 + ns * 16), bn1 = *(const v4u*)(XBC + (size_t)rown * XBC_LD + 1024 + g * 128 + ns * 16 + 8);
            const v4u cn0 = *(const v4u*)(XBC + (size_t)rown * XBC_LD + 1536 + g * 128 + ns * 16), cn1 = *(const v4u*)(XBC + (size_t)rown * XBC_LD + 1536 + g * 128 + ns * 16 + 8);
            const float dt = softplus_f(dtr + dtb), dA = __expf(dt * a), dx = dt * bf2f(xr);
            float y = 0.f;
#pragma unroll
            for (int j = 0; j < 4; ++j) {
                S[2 * j] = S[2 * j] * dA + dx * bf2f(bq0[j] & 0xffffu); S[2 * j + 1] = S[2 * j + 1] * dA + dx * bf2f(bq0[j] >> 16);
                S[8 + 2 * j] = S[8 + 2 * j] * dA + dx * bf2f(bq1[j] & 0xffffu); S[8 + 2 * j + 1] = S[8 + 2 * j + 1] * dA + dx * bf2f(bq1[j] >> 16);
                y += S[2 * j] * bf2f(cq0[j] & 0xffffu) + S[2 * j + 1] * bf2f(cq0[j] >> 16) + S[8 + 2 * j] * bf2f(cq1[j] & 0xffffu) + S[8 + 2 * j + 1] * bf2f(cq1[j] >> 16); }
            y += __shfl_xor(y, 1); y += __shfl_xor(y, 2); y += __shfl_xor(y, 4);
            if (ns == 0 && row < ML) YS[((size_t)dir * ML + row) * 1024 + hd * 64 + p] = (bf16)f2bf(y);
            row = rown; dtr = dtr_n; xr = xr_n; bq0 = bn0; bq1 = bn1; cq0 = cn0; cq1 = cn1;
        }
    }
}

constexpr int SSD_XT = 0, SSD_XWT = 9216, SSD_BT = 18432, SSD_BN = 36864, SSD_CN = 54272, SSD_SBF = 71680, SSD_SM = SSD_SBF + 2 * 17408;
__device__ __forceinline__ void ssd_mfma_phase(Frame& F) {
    const bf16* XBC = (const bf16*)(F.ws + WS_XBC); const float* DT = (const float*)(F.ws + WS_DT); bf16* YS = (bf16*)(F.ws + WS_YS);
    const int lane = F.lane, w = F.wave, i = lane & 15, gq = lane >> 4;
    LAS unsigned char* L = F.lds;
    for (int item = blockIdx.x; item < NB * 16 * 2; item += F.G) {
        const int dir = item & 1, hd = (item >> 1) & 15, b = item >> 5, g = hd >> 2;
        const float dtb = F.in[I_SSDDTB][dir * 16 + hd], a = -expf(F.in[I_SSDALOG][dir * 16 + hd]);
        __syncthreads();
        for (int q = F.tid; q < 17408 / 4; q += 512) ((LAS unsigned*)(L + SSD_SBF))[q] = 0u;
        f32x4 accS[4];
#pragma unroll
        for (int pt = 0; pt < 4; ++pt) accS[pt] = (f32x4){0.f, 0.f, 0.f, 0.f};
        int rowt = s5_row(lane, dir, b);
        const bf16* rp = XBC + (size_t)rowt * XBC_LD;
        v4u xr = *(const v4u*)(rp + hd * 64 + 8 * w);
        v4u br0 = *(const v4u*)(rp + 1024 + g * 128 + 16 * w), br1 = *(const v4u*)(rp + 1024 + g * 128 + 16 * w + 8);
        v4u cr0 = *(const v4u*)(rp + 1536 + g * 128 + 16 * w), cr1 = *(const v4u*)(rp + 1536 + g * 128 + 16 * w + 8);
        float dtr = DT[(size_t)rowt * 32 + dir * 16 + hd];
        for (int k = 0; k < 36; ++k) {
            LAS float* sm = (LAS float*)(L + SSD_SM + (k & 1) * 1024);
            const float dt = softplus_f(dtr + dtb); float c = dt * a;
#pragma unroll
            for (int o = 1; o < 64; o <<= 1) { const float t = __shfl_up(c, o); if (lane >= o) c += t; }
            const float c63 = rdlane(c, 63), we = dt * __expf(c63 - c);
            if (w == 0) { sm[lane] = c; sm[64 + lane] = dt; if (lane == 0) sm[192] = __expf(c63); }
            __syncthreads();
#pragma unroll
            for (int j = 0; j < 4; ++j) { const float x0 = bf2f(xr[j] & 0xffffu), x1 = bf2f(xr[j] >> 16);
                *(LAS bf16*)(L + SSD_XT + (8 * w + 2 * j) * 144 + lane * 2) = (bf16)(xr[j] & 0xffffu); *(LAS bf16*)(L + SSD_XT + (8 * w + 2 * j + 1) * 144 + lane * 2) = (bf16)(xr[j] >> 16);
                *(LAS bf16*)(L + SSD_XWT + (8 * w + 2 * j) * 144 + lane * 2) = (bf16)f2bf(x0 * we); *(LAS bf16*)(L + SSD_XWT + (8 * w + 2 * j + 1) * 144 + lane * 2) = (bf16)f2bf(x1 * we); }
#pragma unroll
            for (int j = 0; j < 4; ++j) {
                *(LAS bf16*)(L + SSD_BT + (16 * w + 2 * j) * 144 + lane * 2) = (bf16)(br0[j] & 0xffffu); *(LAS bf16*)(L + SSD_BT + (16 * w + 2 * j + 1) * 144 + lane * 2) = (bf16)(br0[j] >> 16);
                *(LAS bf16*)(L + SSD_BT + (16 * w + 8 + 2 * j) * 144 + lane * 2) = (bf16)(br1[j] & 0xffffu); *(LAS bf16*)(L + SSD_BT + (16 * w + 8 + 2 * j + 1) * 144 + lane * 2) = (bf16)(br1[j] >> 16); }
            *(LAS v4u*)(L + SSD_BN + lane * 272 + 32 * w) = br0; *(LAS v4u*)(L + SSD_BN + lane * 272 + 32 * w + 16) = br1;
            *(LAS v4u*)(L + SSD_CN + lane * 272 + 32 * w) = cr0; *(LAS v4u*)(L + SSD_CN + lane * 272 + 32 * w + 16) = cr1;
            if (k + 1 < 36) { rowt = s5_row(64 * (k + 1) + lane, dir, b); rp = XBC + (size_t)rowt * XBC_LD;
                xr = *(const v4u*)(rp + hd * 64 + 8 * w);
                br0 = *(const v4u*)(rp + 1024 + g * 128 + 16 * w); br1 = *(const v4u*)(rp + 1024 + g * 128 + 16 * w + 8);
                cr0 = *(const v4u*)(rp + 1536 + g * 128 + 16 * w); cr1 = *(const v4u*)(rp + 1536 + g * 128 + 16 * w + 8);
                dtr = DT[(size_t)rowt * 32 + dir * 16 + hd]; }
            __syncthreads();
            const LAS unsigned char* Scur = L + SSD_SBF + (k & 1) * 17408; LAS unsigned char* Snxt = L + SSD_SBF + ((k + 1) & 1) * 17408;
            for (int rep_ = 0; rep_ < (REP_CODE == 2001 ? 2 : 1); ++rep_)
            if (k >= 4) {
                const int lt = w & 3, pt0 = 2 * (w >> 2), l = 16 * lt + i, rowl = s5_row(64 * k + l, dir, b);
                bf16x8v cf[4];
#pragma unroll
                for (int ks = 0; ks < 4; ++ks) cf[ks] = *(const LAS bf16x8v*)(L + SSD_CN + l * 272 + (32 * ks + 8 * gq) * 2);
                f32x4 acc[2];
#pragma unroll
                for (int pt = 0; pt < 2; ++pt) { acc[pt] = (f32x4){0.f, 0.f, 0.f, 0.f};
#pragma unroll
                    for (int ks = 0; ks < 4; ++ks) { const bf16x8v sf = *(const LAS bf16x8v*)(Scur + (16 * (pt0 + pt) + i) * 272 + (32 * ks + 8 * gq) * 2); acc[pt] = __builtin_amdgcn_mfma_f32_16x16x32_bf16(sf, cf[ks], acc[pt], 0, 0, 0); } }
                const float cl = sm[l], ecl = __expf(cl);
                acc[0] = acc[0] * ecl; acc[1] = acc[1] * ecl;
                const int npair = lt >= 2 ? 2 : 1;
                for (int pr = 0; pr < npair; ++pr) {
                    f32x4 cb[2];
#pragma unroll
                    for (int e = 0; e < 2; ++e) { const int srow = 32 * pr + 8 * (i >> 2) + 4 * e + (i & 3); cb[e] = (f32x4){0.f, 0.f, 0.f, 0.f};
#pragma unroll
                        for (int ks = 0; ks < 4; ++ks) { const bf16x8v bfr = *(const LAS bf16x8v*)(L + SSD_BN + srow * 272 + (32 * ks + 8 * gq) * 2); cb[e] = __builtin_amdgcn_mfma_f32_16x16x32_bf16(bfr, cf[ks], cb[e], 0, 0, 0); } }
                    const int s0 = 32 * pr + 8 * gq; float m[8];
                    const f32x4 c0 = *(const LAS f32x4*)(sm + s0), c1 = *(const LAS f32x4*)(sm + s0 + 4), d0 = *(const LAS f32x4*)(sm + 64 + s0), d1 = *(const LAS f32x4*)(sm + 64 + s0 + 4);
#pragma unroll
                    for (int j = 0; j < 4; ++j) { m[j] = (s0 + j <= l) ? cb[0][j] * d0[j] * __expf(cl - c0[j]) : 0.f; m[4 + j] = (s0 + 4 + j <= l) ? cb[1][j] * d1[j] * __expf(cl - c1[j]) : 0.f; }
                    const v4u mw = (v4u){pk2(m[0], m[1]), pk2(m[2], m[3]), pk2(m[4], m[5]), pk2(m[6], m[7])}; const bf16x8v mf = __builtin_bit_cast(bf16x8v, mw);
#pragma unroll
                    for (int pt = 0; pt < 2; ++pt) { const bf16x8v xf = *(const LAS bf16x8v*)(L + SSD_XT + (16 * (pt0 + pt) + i) * 144 + s0 * 2); acc[pt] = __builtin_amdgcn_mfma_f32_16x16x32_bf16(xf, mf, acc[pt], 0, 0, 0); }
                }
#pragma unroll
                for (int pt = 0; pt < 2; ++pt) { v2u o; o.x = pk2(acc[pt][0], acc[pt][1]); o.y = pk2(acc[pt][2], acc[pt][3]);
                    *(v2u*)(YS + ((size_t)dir * ML + rowl) * 1024 + hd * 64 + 16 * (pt0 + pt) + 4 * gq) = o; }
            }
            { const float dec = sm[192];
              bf16x8v bt[2];
#pragma unroll
              for (int ks = 0; ks < 2; ++ks) bt[ks] = *(const LAS bf16x8v*)(L + SSD_BT + (16 * w + i) * 144 + (32 * ks + 8 * gq) * 2);
#pragma unroll
              for (int pt = 0; pt < 4; ++pt) { accS[pt] = accS[pt] * dec;
#pragma unroll
                  for (int ks = 0; ks < 2; ++ks) { const bf16x8v xw = *(const LAS bf16x8v*)(L + SSD_XWT + (16 * pt + i) * 144 + (32 * ks + 8 * gq) * 2); accS[pt] = __builtin_amdgcn_mfma_f32_16x16x32_bf16(bt[ks], xw, accS[pt], 0, 0, 0); }
                  v2u o; o.x = pk2(accS[pt][0], accS[pt][1]); o.y = pk2(accS[pt][2], accS[pt][3]);
                  *(LAS v2u*)(Snxt + (16 * pt + i) * 272 + (16 * w + 4 * gq) * 2) = o; } }
        }
    }
    __syncthreads();
}

__device__ __forceinline__ void ssd_out_phase(Frame& F) {
    const bf16* XBC = (const bf16*)(F.ws + WS_XBC); const bf16* YS = (const bf16*)(F.ws + WS_YS); const bf16* P1 = (const bf16*)(F.ws + WS_BIG); bf16* MIX = (bf16*)(F.ws + WS_MIX);
    const float* dsk = F.in[I_SSDD]; const float* ng = F.in[I_SSDNG];
    for (int row = F.gw; row < ML; row += F.ngw) {
        float y[16]; float s = 0.f;
#pragma unroll
        for (int j = 0; j < 2; ++j) { const int c0 = 8 * F.lane + 512 * j;
            const v4u a0 = *(const v4u*)(YS + (size_t)row * 1024 + c0), a1 = *(const v4u*)(YS + ((size_t)ML + row) * 1024 + c0), xx = *(const v4u*)(XBC + (size_t)row * XBC_LD + c0), zz = *(const v4u*)(P1 + (size_t)row * ODD_LD + 3072 + c0);
            const float dk = dsk[c0 >> 6];
#pragma unroll
            for (int q = 0; q < 4; ++q) {
                const float v0 = (bf2f(a0[q] & 0xffffu) + bf2f(a1[q] & 0xffffu) + dk * bf2f(xx[q] & 0xffffu)) * silu_f(bf2f(zz[q] & 0xffffu));
                const float v1 = (bf2f(a0[q] >> 16) + bf2f(a1[q] >> 16) + dk * bf2f(xx[q] >> 16)) * silu_f(bf2f(zz[q] >> 16));
                y[8 * j + 2 * q] = v0; y[8 * j + 2 * q + 1] = v1; s += v0 * v0 + v1 * v1; } }
        const float rstd = 1.0f / sqrtf(wave_sum(s) * (1.0f / 1024.0f) + EPS);
#pragma unroll
        for (int j = 0; j < 2; ++j) { const int c0 = 8 * F.lane + 512 * j; unsigned o[4];
#pragma unroll
            for (int q = 0; q < 4; ++q) o[q] = pk2(y[8 * j + 2 * q] * rstd * ng[c0 + 2 * q], y[8 * j + 2 * q + 1] * rstd * ng[c0 + 2 * q + 1]);
            *(v4u*)(MIX + (size_t)row * DM + 1024 + c0) = (v4u){o[0], o[1], o[2], o[3]}; }
    }
}
__device__ __forceinline__ void hyena_prep_load(const bf16* P1, int item, int lane, v4u (&v)[9]) {
    const int tb = item & 31, b = (item >> 5) & 7, cbk = (item >> 8) & 15, part = item >> 12;
    const bf16* base = P1 + (size_t)(b * SEQ) * ODD_LD + part * 1024 + cbk * 64 + 8 * (lane & 7);
#pragma unroll
    for (int i = 0; i < 9; ++i) { const int tl = (lane >> 3) + 8 * i, t = tb * 64 - 1 + tl; v[i] = (v4u){0u, 0u, 0u, 0u}; if (tl < 66 && t >= 0 && t < SEQ) v[i] = *(const v4u*)(base + (size_t)t * ODD_LD); }
}
__device__ __forceinline__ void hyena_prep_phase(Frame& F) {
    const bf16* P1 = (const bf16*)(F.ws + WS_BIG); const float* sw = F.in[I_HYSW]; const float* sb = F.in[I_HYSB]; const int lane = F.lane;
    LAS unsigned* tile = (LAS unsigned*)(F.lds + F.wave * 16384);
    LAS float* wl = (LAS float*)(F.lds + F.wave * 16384 + 9216);
    constexpr int NI = 3 * 16 * NB * 32; v4u vn[9];
    if (F.gw < NI) hyena_prep_load(P1, F.gw, lane, vn);
    for (int item = F.gw; item < NI; item += F.ngw) {
        const int tb = item & 31, b = (item >> 5) & 7, cbk = (item >> 8) & 15, part = item >> 12;
        const int col0 = part * 1024 + cbk * 64, t0 = tb * 64;
        wl[lane] = sw[col0 + lane]; wl[64 + lane] = sw[3072 + col0 + lane]; wl[128 + lane] = sw[6144 + col0 + lane]; wl[192 + lane] = sb[col0 + lane];
#pragma unroll
        for (int i = 0; i < 9; ++i) { const int tl = (lane >> 3) + 8 * i;
            if (tl < 66) { LAS unsigned* tp = tile + tl * 33 + 4 * (lane & 7); tp[0] = vn[i].x; tp[1] = vn[i].y; tp[2] = vn[i].z; tp[3] = vn[i].w; } }
        if (item + F.ngw < NI) hyena_prep_load(P1, item + F.ngw, lane, vn);
        asm volatile("s_waitcnt lgkmcnt(0)" ::: "memory");
        bf16* dst = (bf16*)(F.ws + (part == 0 ? WS_X1C : part == 1 ? WS_X2C : WS_VC)) + ((size_t)(cbk * 64) * NB + b) * SEQ + t0 + lane;
#pragma unroll 4
        for (int cp = 0; cp < 32; ++cp) { const unsigned a = tile[lane * 33 + cp], m = tile[(lane + 1) * 33 + cp], n = tile[(lane + 2) * 33 + cp];
            const float y0 = wl[2 * cp] * bf2f(a & 0xffffu) + wl[64 + 2 * cp] * bf2f(m & 0xffffu) + wl[128 + 2 * cp] * bf2f(n & 0xffffu) + wl[192 + 2 * cp];
            const float y1 = wl[2 * cp + 1] * bf2f(a >> 16) + wl[64 + 2 * cp + 1] * bf2f(m >> 16) + wl[128 + 2 * cp + 1] * bf2f(n >> 16) + wl[192 + 2 * cp + 1];
            dst[(size_t)(2 * cp) * NB * SEQ] = (bf16)f2bf(y0); dst[(size_t)(2 * cp + 1) * NB * SEQ] = (bf16)f2bf(y1); }
        asm volatile("s_waitcnt lgkmcnt(0)" ::: "memory");
    }
}
__device__ __forceinline__ void hyena_conv_phase(Frame& F, int order) {
    LAS float* kf = (LAS float*)F.lds; LAS float* ub = kf + 4096;
    const float* FILT = (const float*)(F.ws + WS_FILT); const bf16* U = (const bf16*)(F.ws + (order == 0 ? WS_VC : WS_ZC)); const bf16* GT = (const bf16*)(F.ws + (order == 0 ? WS_X1C : WS_X2C));
    bf16* ZC = (bf16*)(F.ws + WS_ZC); bf16* MIX = (bf16*)(F.ws + WS_MIX);
    for (int c = blockIdx.x; c < 1024; c += F.G) {
        __syncthreads();
        for (int i = F.tid; i < 4096; i += 512) kf[i] = i < 4095 ? FILT[(size_t)(order * 1024 + c) * 4096 + i] : 0.f;
        for (int i = F.tid; i < NB * SEQ; i += 512) ub[i] = bf2f(U[(size_t)c * NB * SEQ + i]);
        __syncthreads();
        float acc[4][8];
#pragma unroll
        for (int i = 0; i < 4; ++i)
#pragma unroll
            for (int b = 0; b < 8; ++b) acc[i][b] = 0.f;
        const LAS float* kp = kf + F.tid + 2047;
#pragma unroll 2
        for (int s = 0; s < SEQ; ++s) {
            float u8[8];
#pragma unroll
            for (int b = 0; b < 8; ++b) u8[b] = ub[b * SEQ + s];
#pragma unroll
            for (int i = 0; i < 4; ++i) { const float kv = kp[512 * i - s];
#pragma unroll
                for (int b = 0; b < 8; ++b) acc[i][b] += kv * u8[b]; } }
        const float fb = F.in[I_HYFBIAS][order * 1024 + c];
#pragma unroll
        for (int i = 0; i < 4; ++i) { const int t = F.tid + 512 * i;
#pragma unroll
            for (int b = 0; b < 8; ++b) { const float gt = bf2f(GT[((size_t)c * NB + b) * SEQ + t]); const float v = gt * (acc[i][b] + ub[b * SEQ + t] * fb);
                if (order == 0) ZC[((size_t)c * NB + b) * SEQ + t] = (bf16)f2bf(v); else MIX[((size_t)b * SEQ + t) * DM + c] = (bf16)f2bf(v); } }
    }
    __syncthreads();
}

constexpr int HY_CPY = 16384, HY_CPYS = 8224, HY_UB = HY_CPY + 8 * HY_CPYS, HY_UBS = 4112;
__device__ __forceinline__ void hyena_mfma_phase(Frame& F, int order) {
    LAS unsigned char* L = F.lds; LAS float* kf = (LAS float*)L;
    const float* FILT = (const float*)(F.ws + WS_FILT); const bf16* U = (const bf16*)(F.ws + (order == 0 ? WS_VC : WS_ZC)); const bf16* GT = (const bf16*)(F.ws + (order == 0 ? WS_X1C : WS_X2C));
    bf16* OUT = (bf16*)(F.ws + (order == 0 ? WS_ZC : WS_X1C));
    const int lane = F.lane, w = F.wave, i = lane & 15, gq = lane >> 4, tid = F.tid;
    f32x4 kfr[2]; v4u ubr[4];
    int c = blockIdx.x;
    if (c < 1024) {
#pragma unroll
        for (int q = 0; q < 2; ++q) kfr[q] = *(const f32x4*)(FILT + (size_t)(order * 1024 + c) * 4096 + 4 * (tid + 512 * q));
#pragma unroll
        for (int q = 0; q < 4; ++q) { const int qq = tid + 512 * q; ubr[q] = *(const v4u*)(U + ((size_t)c * NB + (qq >> 8)) * SEQ + (qq & 255) * 8); } }
    for (; c < 1024; c += F.G) {
        __syncthreads();
#pragma unroll
        for (int q = 0; q < 2; ++q) { f32x4 v = kfr[q]; if (tid + 512 * q == 1023) v.w = 0.f; *(LAS f32x4*)(kf + 4 * (tid + 512 * q)) = v; }
#pragma unroll
        for (int q = 0; q < 4; ++q) { const int qq = tid + 512 * q; *(LAS v4u*)(L + HY_UB + (qq >> 8) * HY_UBS + (qq & 255) * 16) = ubr[q]; }
        { const int cn = c + F.G; if (cn < 1024) {
#pragma unroll
            for (int q = 0; q < 2; ++q) kfr[q] = *(const f32x4*)(FILT + (size_t)(order * 1024 + cn) * 4096 + 4 * (tid + 512 * q));
#pragma unroll
            for (int q = 0; q < 4; ++q) { const int qq = tid + 512 * q; ubr[q] = *(const v4u*)(U + ((size_t)cn * NB + (qq >> 8)) * SEQ + (qq & 255) * 8); } } }
        __syncthreads();
        for (int rep2_ = 0; rep2_ < (REP_CODE == 2012 ? 2 : 1); ++rep2_)
        for (int q = tid; q < 8 * 512; q += 512) { const int a = q >> 9, y8 = q & 511; unsigned o[4];
#pragma unroll
            for (int j = 0; j < 4; ++j) { const int x0 = 8 * y8 + a + 2 * j, x1 = x0 + 1; const float v0 = x0 <= 4094 ? kf[4094 - x0] : 0.f, v1 = x1 <= 4094 ? kf[4094 - x1] : 0.f; o[j] = pk2(v0, v1); }
            *(LAS v4u*)(L + HY_CPY + a * HY_CPYS + y8 * 16) = (v4u){o[0], o[1], o[2], o[3]}; }
        __syncthreads();
        v2u gg[16];
        if (i < 8) {
#pragma unroll
            for (int j = 0; j < 16; ++j) gg[j] = *(const v2u*)(GT + ((size_t)c * NB + i) * SEQ + 256 * w + 16 * j + 4 * gq); }
        f32x4 acc[16];
        for (int rep_ = 0; rep_ < (REP_CODE == 2011 ? 2 : 1); ++rep_) {
#pragma unroll
        for (int j = 0; j < 16; ++j) { acc[j] = (f32x4){0.f, 0.f, 0.f, 0.f}; asm volatile("" : "+v"(acc[j])); }
        const int a = (7 - i) & 7, ybase = 2040 + 8 * gq - 8 * (i >> 3) - 256 * w;
        const LAS unsigned char* ap = L + HY_CPY + a * HY_CPYS + 2 * ybase;
        const LAS unsigned char* bp = L + HY_UB + (i & 7) * HY_UBS + 16 * gq;
        bf16x8v fr[16];
#pragma unroll
        for (int dd = 0; dd < 16; ++dd) fr[(dd + 1) & 15] = *(const LAS bf16x8v*)(ap + 32 * (dd - 15));
        for (int ks0 = 0; ks0 < 64; ks0 += 8) {
#pragma unroll
            for (int kk = 0; kk < 8; ++kk) { const int ks = ks0 + kk;
                fr[(2 * kk + 15) & 15] = *(const LAS bf16x8v*)(ap + 32 * (2 * ks - 1)); fr[(2 * kk) & 15] = *(const LAS bf16x8v*)(ap + 32 * (2 * ks));
                const bf16x8v bfr = *(const LAS bf16x8v*)(bp + 64 * ks);
#pragma unroll
                for (int j = 0; j < 16; ++j) acc[j] = __builtin_amdgcn_mfma_f32_16x16x32_bf16(fr[(2 * kk - j + 16) & 15], bfr, acc[j], 0, 0, 0); }
        }
        }
        for (int rep3_ = 0; rep3_ < (REP_CODE == 2013 ? 2 : 1); ++rep3_)
        if (i < 8) { const float fb = F.in[I_HYFBIAS][order * 1024 + c];
#pragma unroll
            for (int j = 0; j < 16; ++j) { const int t = 256 * w + 16 * j + 4 * gq; const v2u uu = *(const LAS v2u*)(L + HY_UB + i * HY_UBS + 2 * t);
                const float o0 = bf2f(gg[j].x & 0xffffu) * (acc[j][0] + bf2f(uu.x & 0xffffu) * fb), o1 = bf2f(gg[j].x >> 16) * (acc[j][1] + bf2f(uu.x >> 16) * fb);
                const float o2 = bf2f(gg[j].y & 0xffffu) * (acc[j][2] + bf2f(uu.y & 0xffffu) * fb), o3 = bf2f(gg[j].y >> 16) * (acc[j][3] + bf2f(uu.y >> 16) * fb);
                *(v2u*)(OUT + ((size_t)c * NB + i) * SEQ + t) = (v2u){pk2(o0, o1), pk2(o2, o3)}; } }
    }
    __syncthreads();
}
__device__ __forceinline__ void hyena_untranspose_phase(Frame& F) {
    const bf16* YC = (const bf16*)(F.ws + WS_X1C); bf16* MIX = (bf16*)(F.ws + WS_MIX); const int lane = F.lane;
    LAS float* tile = (LAS float*)(F.lds + F.wave * 16640);
    for (int item = F.gw; item < 16 * NB * 32; item += F.ngw) {
        const int tb = item & 31, b = (item >> 5) & 7, cbk = item >> 8;
        const bf16* src = YC + ((size_t)(cbk * 64) * NB + b) * SEQ + tb * 64 + lane;
        for (int cc = 0; cc < 64; ++cc) tile[cc * 65 + lane] = bf2f(src[(size_t)cc * NB * SEQ]);
        asm volatile("s_waitcnt lgkmcnt(0)" ::: "memory");
        bf16* dst = MIX + (size_t)(b * SEQ + tb * 64) * DM + cbk * 64 + lane;
        for (int tl = 0; tl < 64; ++tl) dst[(size_t)tl * DM] = (bf16)f2bf(tile[lane * 65 + tl]);
        asm volatile("s_waitcnt lgkmcnt(0)" ::: "memory");
    }
}

__device__ __forceinline__ void dt_exact_phase(Frame& F) {
    const float* XSp = (const float*)(F.ws + WS_XS); const float* g = F.in[I_NORMG] + (1 * 3 + 1) * DM; const float* MV = (const float*)(F.ws + WS_MODV) + (size_t)1 * 9 * NMODC; float* DT = (float*)(F.ws + WS_DT);
    const float* W = F.in[I_ODWIN];
    for (int row = F.gw; row < MT; row += F.ngw) {
        const float* xr = XSp + (size_t)row * DM; const int r = row < ML ? row / SEQ : 8;
        const float* sh = MV + (size_t)r * NMODC + 3 * DM; const float* sc = sh + DM;
        f32x4 v[8]; float s = 0.f;
#pragma unroll
        for (int j = 0; j < 8; ++j) { if (row < ML) { const v2u q = *(const v2u*)((const bf16*)(F.ws + WS_XS) + (size_t)row * DM + 4 * (F.lane + 64 * j)); v[j] = (f32x4){bf2f(q.x & 0xffffu), bf2f(q.x >> 16), bf2f(q.y & 0xffffu), bf2f(q.y >> 16)}; } else v[j] = *(const f32x4*)(xr + 4 * (F.lane + 64 * j));
            s += (v[j].x * v[j].x + v[j].y * v[j].y) + (v[j].z * v[j].z + v[j].w * v[j].w); }
        const float rstd = 1.0f / sqrtf(wave_sum(s) * (1.0f / DM) + EPS);
#pragma unroll
        for (int j = 0; j < 8; ++j) { const int c = 4 * (F.lane + 64 * j); const f32x4 gg = *(const f32x4*)(g + c), ss = *(const f32x4*)(sc + c), hh = *(const f32x4*)(sh + c); v[j] = (v[j] * rstd * gg) * (ss + 1.0f) + hh; }
        for (int o = 0; o < 32; ++o) { float a = 0.f;
#pragma unroll
            for (int j = 0; j < 8; ++j) { const int c = 4 * (F.lane + 64 * j); a += v[j].x * W[(size_t)c * ODD_IN + 6144 + o] + v[j].y * W[(size_t)(c + 1) * ODD_IN + 6144 + o] + v[j].z * W[(size_t)(c + 2) * ODD_IN + 6144 + o] + v[j].w * W[(size_t)(c + 3) * ODD_IN + 6144 + o]; }
            a = wave_sum(a); if (F.lane == 0) DT[(size_t)row * 32 + o] = a; }
    }
}
#define XB_TMO      128
#define XB_XCNT(j)  (256  + 64 * (j))
#define XB_XSUB(j)  (1280 + 64 * (j))
#define XB_XGEN(j)  (2304 + 64 * (j))
#define XB_TOP      3328
#define XB_TOPGEN   3392
#define XCD_BAR_WORDS 3456
#define XB_SPIN_CAP (1u << 18)

__device__ __forceinline__ unsigned xb_ld(unsigned* p)              { return __hip_atomic_load(p, __ATOMIC_RELAXED, __HIP_MEMORY_SCOPE_AGENT); }
__device__ __forceinline__ unsigned xb_add(unsigned* p, unsigned v) { return __hip_atomic_fetch_add(p, v, __ATOMIC_RELAXED, __HIP_MEMORY_SCOPE_AGENT); }
__device__ __forceinline__ unsigned xb_xcc_id() { return (unsigned)__builtin_amdgcn_s_getreg((3 << 11) | 20) & 0xFu; }
#define XB_SPIN(cond, bar) do { unsigned _sp = 0; while (cond) { __builtin_amdgcn_s_sleep(1); \
    if ((++_sp & 255u) == 0u) { if (xb_ld(&(bar)[XB_TMO])) break; if (_sp > XB_SPIN_CAP) { atomicAdd(&(bar)[XB_TMO], 1u); break; } } } } while (0)

struct XcdBarrier {
    unsigned* bar; unsigned x;
    volatile LAS unsigned* st;
};

__device__ __forceinline__ XcdBarrier xcd_barrier_post(unsigned* bar, volatile LAS unsigned* st) {
    XcdBarrier b; b.bar = bar; b.x = xb_xcc_id(); b.st = st;
    if (threadIdx.x == 0) (void)xb_add(&bar[XB_XCNT(b.x)], 1u);
    return b;
}
__device__ __forceinline__ void xcd_barrier_complete(unsigned* bar, unsigned x, unsigned& nloc, unsigned& nx) {
    const unsigned G = gridDim.x * gridDim.y * gridDim.z;
    unsigned sum, cnt, mine, sp = 0u;
    for (;;) {
        sum = 0u; cnt = 0u; mine = 0u;
#pragma unroll
        for (unsigned j = 0; j < 16; ++j) { const unsigned c = xb_ld(&bar[XB_XCNT(j)]); sum += c; cnt += (c > 0u) ? 1u : 0u; mine = (j == x) ? c : mine; }
        if (sum == G) break;
        __builtin_amdgcn_s_sleep(1);
        if ((++sp & 255u) == 0u) { if (xb_ld(&bar[XB_TMO])) break; if (sp > XB_SPIN_CAP) { atomicAdd(&bar[XB_TMO], 1u); break; } }
    }
    nloc = mine > 0u ? mine : 1u; nx = cnt > 0u ? cnt : 1u;
}

__device__ __forceinline__ void xcd_barrier(const XcdBarrier& b) {
    asm volatile("s_waitcnt vmcnt(0)" ::: "memory");
    __syncthreads();
    if (threadIdx.x == 0) {
        unsigned* bar = b.bar;
        __builtin_amdgcn_s_waitcnt(0);
        unsigned nloc = b.st[0], nx = b.st[1];
        if (nloc == 0u) { xcd_barrier_complete(bar, b.x, nloc, nx); b.st[0] = nloc; b.st[1] = nx; }
        const unsigned old = xb_add(&bar[XB_XSUB(b.x)], 1u);
        const unsigned gen = old / nloc;
        if (old + 1u == (gen + 1u) * nloc) {
            __builtin_amdgcn_fence(__ATOMIC_RELEASE, "agent");
            asm volatile("s_waitcnt vmcnt(0)" ::: "memory");
            const unsigned og = xb_add(&bar[XB_TOP], 1u);
            const unsigned tg = og / nx;
            if (og + 1u == (tg + 1u) * nx) xb_add(&bar[XB_TOPGEN], 1u);
            else XB_SPIN(xb_ld(&bar[XB_TOPGEN]) == tg, bar);
            __builtin_amdgcn_fence(__ATOMIC_ACQUIRE, "agent");
            xb_add(&bar[XB_XGEN(b.x)], 1u);
            asm volatile("s_waitcnt vmcnt(0)" ::: "memory");
        } else {
            XB_SPIN(xb_ld(&bar[XB_XGEN(b.x)]) == gen, bar);
            __builtin_amdgcn_fence(__ATOMIC_ACQUIRE, "agent");
            asm volatile("s_waitcnt vmcnt(0)" ::: "memory");
        }
    }
    __syncthreads();
}

#ifndef MK_ONE_LAUNCH
#define MK_ONE_LAUNCH 1
#endif
#ifndef RUN_MASK
#define RUN_MASK 0xFFFFFFFFu
#endif
constexpr int NPH = 29;
#if DEFER_Q && (!I8_EV || I8_OD || !GU_ONEPASS)
#error "DEFER_Q needs the int8 even / bf16 odd in-projection phase variants (the tail sites live there)"
#endif
#define REPS(code) (((code) == REP_CODE) ? 2 : 1)
#define REPEAT(code, ...) do { for (int _r = 0; _r < REPS(code); ++_r) { __VA_ARGS__; if (_r + 1 < REPS(code)) __syncthreads(); } } while (0)
__global__ void __launch_bounds__(NWAVES * 64, 2) mega_fwd(Args args) {
    extern __shared__ __attribute__((aligned(16))) unsigned char lds_raw[];
    Frame F;
    F.lds = (LAS unsigned char*)lds_raw; F.in = args.in; F.out = args.out; F.ws = args.ws;
    F.tid = threadIdx.x; F.lane = F.tid & 63; F.wave = __builtin_amdgcn_readfirstlane(F.tid >> 6); F.G = gridDim.x;
    F.gw = blockIdx.x * NWAVES + F.wave; F.ngw = F.G * NWAVES;
    volatile LAS unsigned* MISC = (volatile LAS unsigned*)(F.lds + MISC_OFF);
    for (int u = F.tid; u < (LDS_BYTES - LDSCTL_OFF) / 4; u += NWAVES * 64) ((LAS unsigned*)(F.lds + LDSCTL_OFF))[u] = 0u;
    __syncthreads();
    unsigned* ctl = (unsigned*)(args.ws + WS_CTL);
    if (F.tid == 0) { const unsigned x = xb_xcc_id() & 7u; MISC[16] = x; MISC[17] = __hip_atomic_fetch_add(ctl + CW_XRANK + 64 * x, 1u, __ATOMIC_RELAXED, __HIP_MEMORY_SCOPE_AGENT); }
    __syncthreads();
    F.xcd = __builtin_amdgcn_readfirstlane((int)MISC[16]); F.xrank = __builtin_amdgcn_readfirstlane((int)MISC[17]);
    XcdBarrier bar; bar.bar = ctl + CW_BAR; bar.x = 0; bar.st = nullptr;
    const int lo = args.ph_lo, hi = args.ph_hi;
    if (hi - lo > 1) bar = xcd_barrier_post(ctl + CW_BAR, MISC + 8);
#define IN(k) (lo <= (k) && (k) < hi)
#define SEAM(k) do { if ((k) + 1 < hi) { xcd_barrier(bar); if (REP_CODE == 9999) xcd_barrier(bar); } } while (0)
    unsigned char* ws = args.ws;
    bf16* H = (bf16*)(ws + WS_H); bf16* BIG = (bf16*)(ws + WS_BIG); bf16* MIX = (bf16*)(ws + WS_MIX); float* XS = (float*)(ws + WS_XS);
    const float* MV0 = (const float*)(ws + WS_MODV); const float* MV1 = MV0 + (size_t)9 * NMODC;
    LAS unsigned char* ring = F.lds; bf16* XS16 = (bf16*)(ws + WS_XS);

#define GEMM_GATEUP(lab, Mrows) do { pg8::Gemm g{H, (const bf16*)(ws + WS_WGU + (size_t)(lab) * SZ_WGU8), (Mrows), 2 * DFF, DM / 2}; pg8::StaticOrder S; S.init((Mrows), 2 * DFF, F.G, (int)blockIdx.x); \
        pg8::EpiSwigluI8 E{BIG, DFF, (const float*)(ws + WS_RS), (const float*)(ws + WS_CS) + (size_t)(lab) * 2 * DFF}; pg8::gemm_phase<pg8::EpiSwigluI8, pg8::StaticOrder, true, true, true>(ring, g, S, E); } while (0)
#if F8_DOWN
#define GEMM_DOWN(lab, Mrows, bL, bC, mv, gi, sc) do { pg8::Gemm g{BIG, (const bf16*)(ws + WS_WD + (size_t)(lab) * SZ_WD), ML, DM, DFF / 2}; pg8::StaticOrder S; S.init(ML, DM, F.G, (int)blockIdx.x); \
        pg8::EpiResid16 E{(lab) == 0 ? (bL) : nullptr, (lab) == 0 ? nullptr : XS16, (bC), XS16, XS, (mv), (gi), (sc) * (1.0f / 8192.0f)}; pg8::gemm_phase<pg8::EpiResid16, pg8::StaticOrder, true, true, false, true>(ring, g, S, E); \
        if ((Mrows) > ML) { __syncthreads(); pg8::Gemm g2{BIG, (const bf16*)(ws + WS_WD + (size_t)(lab) * SZ_WD), MT, DM, DFF / 4, DFF / 2, DFF / 2}; pg8::SplitCtxOrder S2{F.G, (int)blockIdx.x, 2}; \
            pg8::EpiResidPart E2{(float*)(ws + WS_PART), (mv), (gi), (sc) * (1.0f / 8192.0f)}; pg8::gemm_phase<pg8::EpiResidPart, pg8::SplitCtxOrder, true, true, false, true>(ring, g2, S2, E2); } } while (0)
#else
#define GEMM_DOWN(lab, Mrows, bL, bC, mv, gi, sc) do { const int m1_ = SPLIT_CTX ? ML : (Mrows); pg8::Gemm g{BIG, (const bf16*)(ws + WS_WD + (size_t)(lab) * SZ_WD), m1_, DM, DFF}; pg8::StaticOrder S; S.init(m1_, DM, F.G, (int)blockIdx.x); \
        pg8::EpiResid E{(bL), (bC), XS, (mv), (gi), (sc)}; pg8::gemm_phase<pg8::EpiResid, pg8::StaticOrder, true, true>(ring, g, S, E); \
        if (SPLIT_CTX && (Mrows) > ML) { __syncthreads(); pg8::Gemm g2{BIG, (const bf16*)(ws + WS_WD + (size_t)(lab) * SZ_WD), MT, DM, DFF / 4, DFF, (DFF / 4) * 2}; pg8::SplitCtxOrder S2{F.G, (int)blockIdx.x, 4}; \
            pg8::EpiResidPart E2{(float*)(ws + WS_PART), (mv), (gi), (sc)}; pg8::gemm_phase<pg8::EpiResidPart, pg8::SplitCtxOrder, true, true>(ring, g2, S2, E2); } } while (0)
#endif

#ifdef ONLY_PH
#define PH(k, ...) if ((k) == ONLY_PH && lo <= (k) && (k) < hi) { __VA_ARGS__; SEAM(k); }
#else
#define PH(k, ...) if (lo <= (k) && (k) < hi) { __VA_ARGS__; SEAM(k); }
#endif
    PH(0, { if ((F.wave & 1) == 0) { p0_prologue(F, 0); p0_prologue(F, 1); s5_prep_items(F); } else { p0_prologue(F, 1); s5_prep_items(F); p0_prologue(F, 0); } })
    PH(1, { p1_modred(F); REPEAT(1006, p1_filter_proj(F)); REPEAT(1005, p1_quant_weights(F)); if (GU_ONEPASS) p1_quant_gateup(F, 0, DEFER_Q ? 352 : 8 * 176, (int)blockIdx.x, F.G); })
    PH(2, REPEAT(2, prenorm8_phase(F, F.in[I_X], F.in[I_CTX], MT, 0, 0, true)))
    PH(3, { REPEAT(3, GEMM_GATEUP(0, MT)); if (DEFER_Q) tail_quant(F, 3168 % F.G, F.G, 0, 160); })
    PH(4, GEMM_DOWN(0, MT, F.in[I_X], F.in[I_CTX], MV0, 2, 0.5f))
#if I8_EV
    PH(5, prenorm8_phase(F, XS, XS + (size_t)ML * DM, MT, 0, 1, false, SPLIT_CTX, XS16))
#else
    PH(5, prenorm_phase(F, XS, XS + (size_t)ML * DM, MT, 0, 1, SPLIT_CTX, XS16))
#endif
#if I8_EV
    PH(6, { { pg8::Gemm g{H, (const bf16*)(ws + WS_WEVIN), MT, 3072, DM / 2}; pg8::StaticOrder S; S.init(MT, 3072, F.G, (int)blockIdx.x);
              pg8::EpiPlainI8 E{BIG, EVEN_LD, nullptr, (const float*)(ws + WS_RS), (const float*)(ws + WS_CS2)}; pg8::gemm_phase<pg8::EpiPlainI8, pg8::StaticOrder, true, true, true>(ring, g, S, E); }
            { pg8::Gemm g{(const bf16*)(ws + WS_WEVIN + (size_t)3072 * DM), H, 1024, MT, DM / 2}; pg8::StaticOrder S; S.init(1024, MT, F.G, F.G - 1 - (int)blockIdx.x);
              pg8::EpiVT8 E{(bf16*)(ws + WS_VT), (const float*)(ws + WS_RS), (const float*)(ws + WS_CS2) + 3072}; pg8::gemm_phase<pg8::EpiVT8, pg8::StaticOrder, true, true, true>(ring, g, S, E); }
            if (DEFER_Q) tail_quant(F, 864 % F.G, F.G - 288 % F.G, 160, 288); })
#else
    PH(6, { pg8::Gemm g{H, (const bf16*)(ws + WS_WEVIN), MT, EVEN_IN, DM}; pg8::StaticOrder S; S.init(MT, EVEN_IN, F.G, (int)blockIdx.x);
            pg8::EpiPlain E{BIG, EVEN_LD, nullptr}; pg8::gemm_phase<pg8::EpiPlain, pg8::StaticOrder, true, true>(ring, g, S, E); })
#endif
    PH(7, { REPEAT(70, s5_statein_phase(F)); if (!I8_EV) vt_transpose_phase(F); })
    PH(8, { s5_chain_phase(F); REPEAT(81, na_mfma_phase(F)); })
    PH(9, REPEAT(9, s5_out_phase(F)))
    PH(10, { pg8::Gemm g{(const bf16*)(ws + WS_G), (const bf16*)(ws + WS_WGLU), MT, 1024, 1024}; pg8::StaticOrder S; S.init(MT, 1024, F.G, (int)blockIdx.x);
            pg8::EpiGlu E{(const bf16*)(ws + WS_G), F.in[I_GLUB], MIX}; pg8::gemm_phase<pg8::EpiGlu, pg8::StaticOrder, true, true>(ring, g, S, E); if (DEFER_Q) tail_quant(F, 288 % F.G, F.G, 288, 512); })
    PH(11, { pg8::Gemm g{MIX, (const bf16*)(ws + WS_WEVOUT), MT, DM, DM}; pg8::StaticOrder S; S.init(MT, DM, F.G, (int)blockIdx.x);
            pg8::EpiResid16 E{nullptr, XS16, XS + (size_t)ML * DM, XS16, XS, MV0, 5, 1.0f}; pg8::gemm_phase<pg8::EpiResid16, pg8::StaticOrder, true, true>(ring, g, S, E); if (DEFER_Q) tail_quant(F, 576 % F.G, F.G, 512, 704); })
    PH(12, prenorm8_phase(F, XS, XS + (size_t)ML * DM, MT, 0, 2, false, 0, XS16))
    PH(13, { GEMM_GATEUP(1, MT); if (DEFER_Q) tail_quant(F, 3168 % F.G, F.G, 704, 864); })
    PH(14, GEMM_DOWN(1, MT, XS, XS + (size_t)ML * DM, MV0, 8, 0.5f))
    PH(15, prenorm8_phase(F, XS, XS + (size_t)ML * DM, MT, 1, 0, false, SPLIT_CTX, XS16))
    PH(16, { GEMM_GATEUP(2, MT); if (DEFER_Q) tail_quant(F, 3168 % F.G, F.G, 864, 1024); })
    PH(17, GEMM_DOWN(2, MT, XS, XS + (size_t)ML * DM, MV1, 2, 0.5f))
#if I8_OD
    PH(18, prenorm8_phase(F, XS, XS + (size_t)ML * DM, MT, 1, 1, false, SPLIT_CTX, XS16))
#else
    PH(18, prenorm_phase(F, XS, XS + (size_t)ML * DM, MT, 1, 1, SPLIT_CTX, XS16))
#endif
#if I8_OD
    PH(19, { pg8::Gemm g{H, (const bf16*)(ws + WS_WODIN), MT, ODD_INP, DM / 2}; pg8::OddInOrder S; S.init(F.G, (int)blockIdx.x);
            pg8::EpiPlainI8 E{BIG, ODD_LD, (float*)(ws + WS_DT), (const float*)(ws + WS_RS), (const float*)(ws + WS_CS2) + EVEN_IN}; pg8::gemm_phase<pg8::EpiPlainI8, pg8::OddInOrder, true, true, true>(ring, g, S, E); })
#else
    PH(19, { pg8::Gemm g{H, (const bf16*)(ws + WS_WODIN), MT, ODD_INP, DM}; pg8::OddInOrder S; S.init(F.G, (int)blockIdx.x);
            pg8::EpiPlain E{BIG, ODD_LD, (float*)(ws + WS_DT)}; pg8::gemm_phase<pg8::EpiPlain, pg8::OddInOrder, true, true>(ring, g, S, E); if (DEFER_Q) tail_quant(F, 1672 % F.G, F.G, 1024, 1056); })
#endif
#ifdef DT_EXACT_PROBE
    PH(20, { dt_exact_phase(F); REPEAT(190, hyena_prep_phase(F)); REPEAT(191, ssd_prep_phase(F)); })
#else
    PH(20, { REPEAT(190, hyena_prep_phase(F)); REPEAT(191, ssd_prep_phase(F)); })
#endif
    PH(21, { REPEAT(200, ssd_mfma_phase(F)); REPEAT(201, hyena_mfma_phase(F, 0)); })
    PH(22, { REPEAT(210, hyena_mfma_phase(F, 1)); REPEAT(211, ssd_out_phase(F)); })
    PH(23, hyena_untranspose_phase(F))
    PH(24, { pg8::Gemm g{MIX, (const bf16*)(ws + WS_WODOUT), ML, DM, DM}; pg8::StaticOrder S; S.init(ML, DM, F.G, (int)blockIdx.x);
            pg8::EpiResid16 E{nullptr, XS16, XS + (size_t)ML * DM, XS16, XS, MV1, 5, 1.0f}; pg8::gemm_phase<pg8::EpiResid16, pg8::StaticOrder, true, true>(ring, g, S, E); })
    PH(25, prenorm8_phase(F, XS, XS + (size_t)ML * DM, ML, 1, 2, false, 0, XS16))
    PH(26, REPEAT(24, GEMM_GATEUP(3, ML)))
    PH(27, GEMM_DOWN(3, ML, XS, XS + (size_t)ML * DM, MV1, 8, 0.5f))
    PH(28, final_norm_phase(F))
#undef PH
#undef IN
#undef SEAM
}

extern "C" void kernel_launch(void* const* d_in, const int* in_sizes, int n_in, void* d_out, int out_size, void* d_ws, size_t ws_size, hipStream_t stream) {
    static int grid = 0;
    if (grid == 0) {
        if (n_in != N_IN || out_size != ML * DM || ws_size < WS_END) { fprintf(stderr, "kernel_launch: unexpected shapes: n_in %d out %d ws %zu (need %zu)\n", n_in, out_size, ws_size, (size_t)WS_END); grid = -1; return; }
        int dev = 0, cus = 0, per_cu = 0;
        if (hipGetDevice(&dev) != hipSuccess || hipDeviceGetAttribute(&cus, hipDeviceAttributeMultiprocessorCount, dev) != hipSuccess) { grid = -1; return; }
        if (hipFuncSetAttribute((const void*)mega_fwd, hipFuncAttributeMaxDynamicSharedMemorySize, LDS_BYTES) != hipSuccess) { fprintf(stderr, "kernel_launch: hipFuncSetAttribute failed\n"); grid = -1; return; }
        if (hipOccupancyMaxActiveBlocksPerMultiprocessor(&per_cu, (const void*)mega_fwd, NWAVES * 64, LDS_BYTES) != hipSuccess || per_cu < 1) fprintf(stderr, "kernel_launch: occupancy query reports %d\n", per_cu);
        (void)hipGetLastError();
        grid = cus;
    }
    if (grid < 0) return;
    (void)in_sizes;
    if (hipMemsetAsync((char*)d_ws + WS_CTL, 0, CTL_ZERO_BYTES, stream) != hipSuccess) return;
    Args a{};
    for (int i = 0; i < N_IN; ++i) a.in[i] = (const float*)d_in[i];
    a.out = (float*)d_out; a.ws = (unsigned char*)d_ws;
#if MK_ONE_LAUNCH
    a.ph_lo = 0; a.ph_hi = NPH;
    hipLaunchKernelGGL(mega_fwd, dim3(grid), dim3(NWAVES * 64), LDS_BYTES, stream, a);
#else
    for (int p = 0; p < NPH; ++p) { a.ph_lo = p; a.ph_hi = p + 1; hipLaunchKernelGGL(mega_fwd, dim3(grid), dim3(NWAVES * 64), LDS_BYTES, stream, a); }
#endif
}
```

```cpp
#include <hip/hip_runtime.h>
#include <cstdio>
#include <cstdint>
#define REP_CODE -1
namespace pg8 {
#define PG8_LAS __attribute__((address_space(3)))
typedef unsigned short bf16_t;
typedef short bf16x8 __attribute__((ext_vector_type(8)));
typedef float f32x4 __attribute__((ext_vector_type(4)));
typedef unsigned u32x4 __attribute__((ext_vector_type(4)));
constexpr int BM = 256, BK = 64, HALF = 128, HTB = HALF * BK * 2  , STAGE_BYTES = 8 * HTB, NXCD = 8, WGM = 8;

__host__ __device__ __forceinline__ int lds_byte(int r, int c) { const int st = (r >> 4) * 2 + (c >> 5), rr = r & 15, cc = c & 31, ob = rr * 64 + cc * 2; return st * 1024 + (ob ^ (((ob >> 9) & 1) << 5)); }
__host__ __device__ __forceinline__ void stage_rc(int b, int& R, int& C) { const int st = b / 1024, sb = b % 1024, swz = sb ^ (((sb >> 9) & 1) << 5); R = (st >> 1) * 16 + swz / 64; C = (st & 1) * 32 + (swz % 64) / 2; }
__host__ __device__ __forceinline__ int perm32(int rho) { const int n = rho >> 4, i = rho & 15; return 8 * (i >> 2) + 4 * n + (i & 3); }

struct Unit { int pm, pn, kq; };
struct Gemm { const bf16_t* A; const bf16_t* Bt; int M, N, K; int ld = 0; int kcb = 0; };


struct StaticOrder {
    int nM, nN, nwg, G, c;
    __host__ __device__ void init(int M, int N, int G_, int c_) { nM = M / BM; nN = N / BM; nwg = nM * nN; G = G_; c = c_; }
    __host__ __device__ bool next(int i, Unit& u) const {
        const long L = (long)i * G + c; if (L >= nwg) return false;
        int wgid = (int)L; { const int q = nwg / NXCD, r = nwg % NXCD, xcd = wgid % NXCD, off = wgid / NXCD; wgid = (xcd < r ? xcd * (q + 1) : r * (q + 1) + (xcd - r) * q) + off; }
        const int nig = WGM * nN, gid = wgid / nig, fm = gid * WGM, gsz = (nM - fm) < WGM ? (nM - fm) : WGM;
        u.pm = fm + ((wgid % nig) % gsz); u.pn = (wgid % nig) / gsz; u.kq = 0; return true;
    }
    __device__ __forceinline__ void a_ready(const Unit&) const {}
    __device__ __forceinline__ void done(const Unit&) const {}
};
__device__ __forceinline__ unsigned cvt_pk_bf16(float lo, float hi) { unsigned r; asm volatile("v_cvt_pk_bf16_f32 %0, %1, %2" : "=v"(r) : "v"(lo), "v"(hi)); return r; }

__device__ __forceinline__ float fast_sigmoid(float x) { return __builtin_amdgcn_rcpf(1.0f + __builtin_amdgcn_exp2f(-1.4426950408889634f * x)); }
#ifndef EMU_D
#define EMU_D 0
#endif
#define EMU_D_FLAG EMU_D
__device__ __forceinline__ float q_e4m3_epi(float x) { const float ax = __builtin_fabsf(x); if (ax < 0.015625f) return __builtin_rintf(x * 512.0f) * (1.0f / 512.0f);
    unsigned u = __float_as_uint(x); u += 0x7FFFFu + ((u >> 20) & 1u); u &= 0xFFF00000u; const float r = __uint_as_float(u); return __builtin_fabsf(r) > 448.0f ? __builtin_copysignf(448.0f, x) : r; }
struct EpiSwiglu {
    static constexpr bool PERM = true, AFTER_DRAIN = false;
    bf16_t* O; int ldc;
    __device__ __forceinline__ void operator()(const f32x4 (&acc)[2][2][4][2], const Unit& u, int wr, int wc, int fr, int fq) const {
        const int row0 = u.pm * BM + wr * 64 + fr, col0 = u.pn * HALF + wc * 32 + 8 * fq;
#pragma unroll
        for (int ai = 0; ai < 2; ++ai)
#pragma unroll
            for (int m = 0; m < 4; ++m) { bf16_t* rowp = O + (size_t)(row0 + ai * HALF + m * 16) * ldc + col0;
                float h[8];
#pragma unroll
                for (int n = 0; n < 2; ++n)
#pragma unroll
                    for (int j = 0; j < 4; ++j) { const float g = acc[ai][0][m][n][j], up = acc[ai][1][m][n][j]; h[4 * n + j] = g * fast_sigmoid(g) * up; if (EMU_D_FLAG) h[4 * n + j] = q_e4m3_epi(h[4 * n + j] * 8.0f) * 0.125f; }
                u32x4 w; w.x = cvt_pk_bf16(h[0], h[1]); w.y = cvt_pk_bf16(h[2], h[3]); w.z = cvt_pk_bf16(h[4], h[5]); w.w = cvt_pk_bf16(h[6], h[7]);
                *(u32x4*)rowp = w; }
    }
};
#ifndef F8_DOWN
#define F8_DOWN 1
#endif
__device__ __forceinline__ unsigned pack4_fp8(float a, float b, float c, float d) {
    a = __builtin_fminf(__builtin_fmaxf(a, -448.f), 448.f); b = __builtin_fminf(__builtin_fmaxf(b, -448.f), 448.f); c = __builtin_fminf(__builtin_fmaxf(c, -448.f), 448.f); d = __builtin_fminf(__builtin_fmaxf(d, -448.f), 448.f);
    unsigned r = __builtin_amdgcn_cvt_pk_fp8_f32(a, b, 0u, false); return __builtin_amdgcn_cvt_pk_fp8_f32(c, d, r, true); }
struct EpiSwigluI8 {
    static constexpr bool PERM = true, AFTER_DRAIN = false;
    bf16_t* O; int ldc; const float* rs; const float* cs;
    __device__ __forceinline__ void hrow(const f32x4 (&acc)[2][2][4][2], int ai, int m, float r, const f32x4& cg0, const f32x4& cg1, const f32x4& cu0, const f32x4& cu1, float (&h)[8]) const {
#pragma unroll
        for (int n = 0; n < 2; ++n)
#pragma unroll
            for (int j = 0; j < 4; ++j) { const float g = (float)__float_as_int(acc[ai][0][m][n][j]) * (r * (n ? cg1[j] : cg0[j])), up = (float)__float_as_int(acc[ai][1][m][n][j]) * (r * (n ? cu1[j] : cu0[j]));
                h[4 * n + j] = g * fast_sigmoid(g) * up; if (EMU_D_FLAG) h[4 * n + j] = q_e4m3_epi(h[4 * n + j] * 8.0f) * 0.125f; }
    }
    __device__ __forceinline__ void operator()(const f32x4 (&acc)[2][2][4][2], const Unit& u, int wr, int wc, int fr, int fq) const {
        const int row0 = u.pm * BM + wr * 64 + fr, col0 = u.pn * HALF + wc * 32 + 8 * fq, brow0 = u.pn * BM + wc * 32 + 8 * fq;
        const f32x4 cg0 = *(const f32x4*)(cs + brow0), cg1 = *(const f32x4*)(cs + brow0 + 4), cu0 = *(const f32x4*)(cs + brow0 + HALF), cu1 = *(const f32x4*)(cs + brow0 + HALF + 4);
        if (F8_DOWN) {
            const bool odd = (fq & 1) != 0;
#pragma unroll
            for (int ai = 0; ai < 2; ++ai)
#pragma unroll
                for (int m = 0; m < 4; m += 2) { const int rowa = row0 + ai * HALF + m * 16, rowb = rowa + 16; float ha[8], hb[8];
                    hrow(acc, ai, m, rs[rowa], cg0, cg1, cu0, cu1, ha); hrow(acc, ai, m + 1, rs[rowb], cg0, cg1, cu0, cu1, hb);
                    const unsigned a0 = pack4_fp8(8.f * ha[0], 8.f * ha[1], 8.f * ha[2], 8.f * ha[3]), a1 = pack4_fp8(8.f * ha[4], 8.f * ha[5], 8.f * ha[6], 8.f * ha[7]);
                    const unsigned b0 = pack4_fp8(8.f * hb[0], 8.f * hb[1], 8.f * hb[2], 8.f * hb[3]), b1 = pack4_fp8(8.f * hb[4], 8.f * hb[5], 8.f * hb[6], 8.f * hb[7]);
                    const unsigned r0 = (unsigned)__shfl_xor((int)(odd ? a0 : b0), 16), r1 = (unsigned)__shfl_xor((int)(odd ? a1 : b1), 16);
                    unsigned char* rowp = (unsigned char*)O + (size_t)(odd ? rowb : rowa) * ldc + (odd ? col0 - 8 : col0);
                    *(u32x4*)rowp = odd ? (u32x4){r0, r1, b0, b1} : (u32x4){a0, a1, r0, r1}; }
        } else {
#pragma unroll
            for (int ai = 0; ai < 2; ++ai)
#pragma unroll
                for (int m = 0; m < 4; ++m) { const int row = row0 + ai * HALF + m * 16; float h[8]; hrow(acc, ai, m, rs[row], cg0, cg1, cu0, cu1, h);
                    bf16_t* rowp = O + (size_t)row * ldc + col0;
                    u32x4 w; w.x = cvt_pk_bf16(h[0], h[1]); w.y = cvt_pk_bf16(h[2], h[3]); w.z = cvt_pk_bf16(h[4], h[5]); w.w = cvt_pk_bf16(h[6], h[7]);
                    *(u32x4*)rowp = w; }
        }
    }
};
struct EpiResid {
    static constexpr bool PERM = false, AFTER_DRAIN = false;
    const float* baseL; const float* baseC; float* out; const float* modv; int gidx; float scale;
    __device__ __forceinline__ void operator()(const f32x4 (&acc)[2][2][4][2], const Unit& u, int wr, int wc, int fr, int fq) const {
        const int pm = u.pm, r = pm < 64 ? (pm >> 3) : 8;
        const float* gv = modv + (size_t)r * 18432 + gidx * 2048;
        const float* base = pm < 64 ? baseL + (size_t)pm * 256 * 2048 : baseC + (size_t)(pm - 64) * 256 * 2048;
        float* o = out + (size_t)pm * 256 * 2048;
        const int rowl = wr * 64 + fr, col0 = u.pn * BM + wc * 32 + 4 * fq;
        f32x4 gvv[2][2];
#pragma unroll
        for (int bj = 0; bj < 2; ++bj)
#pragma unroll
            for (int n = 0; n < 2; ++n) gvv[bj][n] = *(const f32x4*)(gv + col0 + bj * HALF + n * 16) * scale;
#pragma unroll
        for (int ai = 0; ai < 2; ++ai)
#pragma unroll
            for (int m = 0; m < 4; ++m) { const size_t off = (size_t)(rowl + ai * HALF + m * 16) * 2048 + col0;
#pragma unroll
                for (int bj = 0; bj < 2; ++bj)
#pragma unroll
                    for (int n = 0; n < 2; ++n) { const f32x4 bs = *(const f32x4*)(base + off + bj * HALF + n * 16); *(f32x4*)(o + off + bj * HALF + n * 16) = bs + gvv[bj][n] * acc[ai][bj][m][n]; }
                asm volatile("" ::: "memory"); }
    }
};
struct EpiResid16 {
    static constexpr bool PERM = true, AFTER_DRAIN = false;
    const float* baseL32; const bf16_t* baseL16; const float* baseC; bf16_t* out16; float* outC; const float* modv; int gidx; float scale;
    __device__ __forceinline__ void operator()(const f32x4 (&acc)[2][2][4][2], const Unit& u, int wr, int wc, int fr, int fq) const {
        const int pm = u.pm, r = pm < 64 ? (pm >> 3) : 8;
        const float* gv = modv + (size_t)r * 18432 + gidx * 2048;
        const int rowl = wr * 64 + fr, col0 = u.pn * BM + wc * 32 + 8 * fq;
        f32x4 gvv[2][2];
#pragma unroll
        for (int bj = 0; bj < 2; ++bj)
#pragma unroll
            for (int n = 0; n < 2; ++n) gvv[bj][n] = *(const f32x4*)(gv + col0 + bj * HALF + 4 * n) * scale;
        if (pm >= 64) {
            const float* base = baseC + (size_t)(pm - 64) * 256 * 2048; float* o = outC + (size_t)pm * 256 * 2048;
#pragma unroll
            for (int ai = 0; ai < 2; ++ai)
#pragma unroll
                for (int m = 0; m < 4; ++m) { const size_t off = (size_t)(rowl + ai * HALF + m * 16) * 2048 + col0;
#pragma unroll
                    for (int bj = 0; bj < 2; ++bj)
#pragma unroll
                        for (int n = 0; n < 2; ++n) { const f32x4 bs = *(const f32x4*)(base + off + bj * HALF + 4 * n); *(f32x4*)(o + off + bj * HALF + 4 * n) = bs + gvv[bj][n] * acc[ai][bj][m][n]; }
                    asm volatile("" ::: "memory"); }
            return;
        }
        bf16_t* o = out16 + (size_t)pm * 256 * 2048;
        if (baseL16 != nullptr) {
            const bf16_t* base = baseL16 + (size_t)pm * 256 * 2048;
            u32x4 q[2]; const unsigned lo = (unsigned)(rowl * 2048 + col0) * 2u;
            const char* bb = (const char*)base; char* ob = (char*)o;
            q[0] = *(const u32x4*)(bb + lo);
#pragma unroll
            for (int st = 0; st < 16; ++st) { const int gi = st >> 1, bj = st & 1, ai = gi >> 2, m = gi & 3; const unsigned off = lo + (unsigned)(((ai * HALF + m * 16) * 2048 + bj * HALF) * 2);
                if (st + 1 < 16) { const int gn = (st + 1) >> 1, bn = (st + 1) & 1; q[(st + 1) & 1] = *(const u32x4*)(bb + (lo + (unsigned)((((gn >> 2) * HALF + (gn & 3) * 16) * 2048 + bn * HALF) * 2))); }
                const u32x4 qq = q[st & 1];
                const f32x4 b0 = (f32x4){__uint_as_float(qq.x << 16), __uint_as_float(qq.x & 0xffff0000u), __uint_as_float(qq.y << 16), __uint_as_float(qq.y & 0xffff0000u)};
                const f32x4 b1 = (f32x4){__uint_as_float(qq.z << 16), __uint_as_float(qq.z & 0xffff0000u), __uint_as_float(qq.w << 16), __uint_as_float(qq.w & 0xffff0000u)};
                const f32x4 v0 = b0 + gvv[bj][0] * acc[ai][bj][m][0], v1 = b1 + gvv[bj][1] * acc[ai][bj][m][1];
                u32x4 w; w.x = cvt_pk_bf16(v0[0], v0[1]); w.y = cvt_pk_bf16(v0[2], v0[3]); w.z = cvt_pk_bf16(v1[0], v1[1]); w.w = cvt_pk_bf16(v1[2], v1[3]);
                *(u32x4*)(ob + off) = w;
                asm volatile("" ::: "memory"); }
        } else {
            const float* base = baseL32 + (size_t)pm * 256 * 2048;
#pragma unroll
            for (int ai = 0; ai < 2; ++ai)
#pragma unroll
                for (int m = 0; m < 4; ++m) { const size_t off = (size_t)(rowl + ai * HALF + m * 16) * 2048 + col0;
#pragma unroll
                    for (int bj = 0; bj < 2; ++bj) { const f32x4 b0 = *(const f32x4*)(base + off + bj * HALF), b1 = *(const f32x4*)(base + off + bj * HALF + 4);
                        const f32x4 v0 = b0 + gvv[bj][0] * acc[ai][bj][m][0], v1 = b1 + gvv[bj][1] * acc[ai][bj][m][1];
                        u32x4 w; w.x = cvt_pk_bf16(v0[0], v0[1]); w.y = cvt_pk_bf16(v0[2], v0[3]); w.z = cvt_pk_bf16(v1[0], v1[1]); w.w = cvt_pk_bf16(v1[2], v1[3]);
                        *(u32x4*)(o + off + bj * HALF) = w; }
                    asm volatile("" ::: "memory"); }
        }
    }
};
struct EpiPlain {
    static constexpr bool PERM = true, AFTER_DRAIN = false;
    bf16_t* O; int ldc; float* DT;
    __device__ __forceinline__ void operator()(const f32x4 (&acc)[2][2][4][2], const Unit& u, int wr, int wc, int fr, int fq) const {
        const int row0 = u.pm * BM + wr * 64 + fr;
        if (u.pn * BM >= ldc) {
            if (DT != nullptr && wc == 0) {
#pragma unroll
                for (int ai = 0; ai < 2; ++ai)
#pragma unroll
                    for (int m = 0; m < 4; ++m) { float* rowp = DT + (size_t)(row0 + ai * HALF + m * 16) * 32 + 8 * fq;
                        *(f32x4*)(rowp) = acc[ai][0][m][0]; *(f32x4*)(rowp + 4) = acc[ai][0][m][1]; }
            }
            return;
        }
        const int col0 = u.pn * BM + wc * 32 + 8 * fq;
#pragma unroll
        for (int ai = 0; ai < 2; ++ai)
#pragma unroll
            for (int m = 0; m < 4; ++m) { bf16_t* rowp = O + (size_t)(row0 + ai * HALF + m * 16) * ldc + col0;
#pragma unroll
                for (int bj = 0; bj < 2; ++bj) { const f32x4 v0 = acc[ai][bj][m][0], v1 = acc[ai][bj][m][1];
                    u32x4 w; w.x = cvt_pk_bf16(v0[0], v0[1]); w.y = cvt_pk_bf16(v0[2], v0[3]); w.z = cvt_pk_bf16(v1[0], v1[1]); w.w = cvt_pk_bf16(v1[2], v1[3]);
                    *(u32x4*)(rowp + bj * HALF) = w; } }
    }
};
struct EpiPlainI8 {
    static constexpr bool PERM = true, AFTER_DRAIN = false;
    bf16_t* O; int ldc; float* DT; const float* rs; const float* cs;
    __device__ __forceinline__ void operator()(const f32x4 (&acc)[2][2][4][2], const Unit& u, int wr, int wc, int fr, int fq) const {
        const int row0 = u.pm * BM + wr * 64 + fr, col0 = u.pn * BM + wc * 32 + 8 * fq;
        if (u.pn * BM >= ldc) {
            if (DT != nullptr && wc == 0) { const f32x4 c0 = *(const f32x4*)(cs + col0), c1 = *(const f32x4*)(cs + col0 + 4);
#pragma unroll
                for (int ai = 0; ai < 2; ++ai)
#pragma unroll
                    for (int m = 0; m < 4; ++m) { const int row = row0 + ai * HALF + m * 16; const float r = rs[row]; float* rowp = DT + (size_t)row * 32 + 8 * fq; f32x4 o0, o1;
#pragma unroll
                        for (int j = 0; j < 4; ++j) { o0[j] = (float)__float_as_int(acc[ai][0][m][0][j]) * (r * c0[j]); o1[j] = (float)__float_as_int(acc[ai][0][m][1][j]) * (r * c1[j]); }
                        *(f32x4*)(rowp) = o0; *(f32x4*)(rowp + 4) = o1; }
            }
            return;
        }
        f32x4 cv[2][2];
#pragma unroll
        for (int bj = 0; bj < 2; ++bj) { cv[bj][0] = *(const f32x4*)(cs + col0 + bj * HALF); cv[bj][1] = *(const f32x4*)(cs + col0 + bj * HALF + 4); }
#pragma unroll
        for (int ai = 0; ai < 2; ++ai)
#pragma unroll
            for (int m = 0; m < 4; ++m) { const int row = row0 + ai * HALF + m * 16; const float r = rs[row]; bf16_t* rowp = O + (size_t)row * ldc + col0;
#pragma unroll
                for (int bj = 0; bj < 2; ++bj) { float v[8];
#pragma unroll
                    for (int j = 0; j < 4; ++j) { v[j] = (float)__float_as_int(acc[ai][bj][m][0][j]) * (r * cv[bj][0][j]); v[4 + j] = (float)__float_as_int(acc[ai][bj][m][1][j]) * (r * cv[bj][1][j]); }
                    u32x4 w; w.x = cvt_pk_bf16(v[0], v[1]); w.y = cvt_pk_bf16(v[2], v[3]); w.z = cvt_pk_bf16(v[4], v[5]); w.w = cvt_pk_bf16(v[6], v[7]);
                    *(u32x4*)(rowp + bj * HALF) = w; } }
    }
};
struct EpiVT8 {
    static constexpr bool PERM = true, AFTER_DRAIN = false;
    bf16_t* VT; const float* rs; const float* cs;
    __device__ __forceinline__ void operator()(const f32x4 (&acc)[2][2][4][2], const Unit& u, int wr, int wc, int fr, int fq) const {
        const int row0 = u.pm * BM + wr * 64 + fr, col0 = u.pn * BM + wc * 32 + 8 * fq;
        const int b = u.pn < 64 ? (u.pn >> 3) : (u.pn - 64), tokb = (u.pn < 64 ? (u.pn & 7) * 256 : 2048) + wc * 32 + 8 * fq;
        f32x4 cv[2][2];
#pragma unroll
        for (int bj = 0; bj < 2; ++bj) { cv[bj][0] = *(const f32x4*)(rs + col0 + bj * HALF); cv[bj][1] = *(const f32x4*)(rs + col0 + bj * HALF + 4); }
#pragma unroll
        for (int ai = 0; ai < 2; ++ai)
#pragma unroll
            for (int m = 0; m < 4; ++m) { const int row = row0 + ai * HALF + m * 16; const float r = cs[row]; bf16_t* rowp = VT + (size_t)((b * 8 + (row >> 7)) * 128 + (row & 127)) * 2304 + tokb;
#pragma unroll
                for (int bj = 0; bj < 2; ++bj) { float v[8];
#pragma unroll
                    for (int j = 0; j < 4; ++j) { v[j] = (float)__float_as_int(acc[ai][bj][m][0][j]) * (r * cv[bj][0][j]); v[4 + j] = (float)__float_as_int(acc[ai][bj][m][1][j]) * (r * cv[bj][1][j]); }
                    u32x4 w; w.x = cvt_pk_bf16(v[0], v[1]); w.y = cvt_pk_bf16(v[2], v[3]); w.z = cvt_pk_bf16(v[4], v[5]); w.w = cvt_pk_bf16(v[6], v[7]);
                    *(u32x4*)(rowp + bj * HALF) = w; } }
    }
};
struct EpiResidPart {
    static constexpr bool PERM = false, AFTER_DRAIN = false;
    float* part; const float* modv; int gidx; float scale;
    __device__ __forceinline__ void operator()(const f32x4 (&acc)[2][2][4][2], const Unit& u, int wr, int wc, int fr, int fq) const {
        const float* gv = modv + (size_t)8 * 18432 + gidx * 2048;
        float* o = part + ((size_t)u.kq * 2048 + (size_t)(u.pm - 64) * 256) * 2048;
        const int rowl = wr * 64 + fr, col0 = u.pn * BM + wc * 32 + 4 * fq;
        f32x4 gvv[2][2];
#pragma unroll
        for (int bj = 0; bj < 2; ++bj)
#pragma unroll
            for (int n = 0; n < 2; ++n) gvv[bj][n] = *(const f32x4*)(gv + col0 + bj * HALF + n * 16) * scale;
#pragma unroll
        for (int ai = 0; ai < 2; ++ai)
#pragma unroll
            for (int m = 0; m < 4; ++m) { const size_t off = (size_t)(rowl + ai * HALF + m * 16) * 2048 + col0;
#pragma unroll
                for (int bj = 0; bj < 2; ++bj)
#pragma unroll
                    for (int n = 0; n < 2; ++n) *(f32x4*)(o + off + bj * HALF + n * 16) = gvv[bj][n] * acc[ai][bj][m][n];
                asm volatile("" ::: "memory"); }
    }
};
struct SplitCtxOrder {
    int G, c, ns;
    __device__ bool next(int i, Unit& u) const { const long L = (long)i * G + c; if (L >= 64 * ns) return false; u.kq = (int)(L % ns); const int q = (int)(L / ns); u.pn = q & 7; u.pm = 64 + (q >> 3); return true; }
    __device__ __forceinline__ void a_ready(const Unit&) const {}
    __device__ __forceinline__ void done(const Unit&) const {}
};
struct OddInOrder {
    StaticOrder S; int G, c;
    __device__ void init(int G_, int c_) { S.init(16384, 6400, G_, c_); G = G_; c = c_; }
    __device__ bool next(int i, Unit& u) const { const long L = (long)i * G + c; if (L < 1600) return S.next(i, u); const int l2 = (int)(L - 1600); if (l2 >= 72) return false; u.pm = 64 + (l2 & 7); u.pn = 16 + (l2 >> 3); u.kq = 0; return true; }
    __device__ __forceinline__ void a_ready(const Unit&) const {}
    __device__ __forceinline__ void done(const Unit&) const {}
};
struct EpiGlu {
    static constexpr bool PERM = true, AFTER_DRAIN = false;
    const bf16_t* G; const float* bias; bf16_t* O;
    __device__ __forceinline__ void operator()(const f32x4 (&acc)[2][2][4][2], const Unit& u, int wr, int wc, int fr, int fq) const {
        const int row0 = u.pm * BM + wr * 64 + fr, col0 = u.pn * BM + wc * 32 + 8 * fq;
#pragma unroll
        for (int ai = 0; ai < 2; ++ai)
#pragma unroll
            for (int m = 0; m < 4; ++m) { const size_t row = (size_t)(row0 + ai * HALF + m * 16);
#pragma unroll
                for (int bj = 0; bj < 2; ++bj) { const int c = col0 + bj * HALF;
                    const u32x4 gw = *(const u32x4*)(G + row * 1024 + c);
                    const f32x4 b0 = *(const f32x4*)(bias + c), b1 = *(const f32x4*)(bias + c + 4);
                    const f32x4 v0 = acc[ai][bj][m][0] + b0, v1 = acc[ai][bj][m][1] + b1;
                    float o[8];
#pragma unroll
                    for (int j = 0; j < 4; ++j) { const unsigned gq = gw[j]; const float ga = __uint_as_float(gq << 16), gb = __uint_as_float(gq & 0xffff0000u);
                        const float sa = (j < 2) ? v0[2 * j] : v1[2 * j - 4], sb = (j < 2) ? v0[2 * j + 1] : v1[2 * j - 3];
                        o[2 * j] = ga * fast_sigmoid(sa); o[2 * j + 1] = gb * fast_sigmoid(sb); }
                    u32x4 w; w.x = cvt_pk_bf16(o[0], o[1]); w.y = cvt_pk_bf16(o[2], o[3]); w.z = cvt_pk_bf16(o[4], o[5]); w.w = cvt_pk_bf16(o[6], o[7]);
                    *(u32x4*)(O + row * 2048 + c) = w; } }
    }
};
typedef int i32x4 __attribute__((ext_vector_type(4)));
template <bool I8> __device__ __forceinline__ f32x4 mma_step(bf16x8 b, bf16x8 a, f32x4 c) {
#if defined(I8_VIA_BF16)
    if constexpr (I8) { const i32x4 bi = __builtin_bit_cast(i32x4, b), ai = __builtin_bit_cast(i32x4, a); const i32x4 ci = __builtin_bit_cast(i32x4, c); f32x4 r = (f32x4){(float)ci[0], (float)ci[1], (float)ci[2], (float)ci[3]};
#pragma unroll
        for (int h = 0; h < 2; ++h) { bf16x8 bb, aa;
#pragma unroll
            for (int j = 0; j < 8; ++j) { const int wb = bi[2 * h + (j >> 2)], wa = ai[2 * h + (j >> 2)]; const float fb = (float)((wb << (24 - 8 * (j & 3))) >> 24), fa = (float)((wa << (24 - 8 * (j & 3))) >> 24);
                bb[j] = (short)(__float_as_uint(fb) >> 16); aa[j] = (short)(__float_as_uint(fa) >> 16); }
            r = __builtin_amdgcn_mfma_f32_16x16x32_bf16(bb, aa, r, 0, 0, 0); }
        return __builtin_bit_cast(f32x4, (i32x4){(int)r[0], (int)r[1], (int)r[2], (int)r[3]}); }
#endif
    if constexpr (I8) return __builtin_bit_cast(f32x4, __builtin_amdgcn_mfma_i32_16x16x64_i8(__builtin_bit_cast(i32x4, b), __builtin_bit_cast(i32x4, a), __builtin_bit_cast(i32x4, c), 0, 0, 0));
    else return __builtin_amdgcn_mfma_f32_16x16x32_bf16(b, a, c, 0, 0, 0);
}
typedef int i32x8 __attribute__((ext_vector_type(8)));
__device__ __forceinline__ void mma_f8(bf16x8 b0, bf16x8 b1, bf16x8 a0, bf16x8 a1, f32x4& c, int one) {
    const i32x4 bl = __builtin_bit_cast(i32x4, b0), bh = __builtin_bit_cast(i32x4, b1), al = __builtin_bit_cast(i32x4, a0), ah = __builtin_bit_cast(i32x4, a1);
    const i32x8 bb = {bl[0], bl[1], bl[2], bl[3], bh[0], bh[1], bh[2], bh[3]}, aa = {al[0], al[1], al[2], al[3], ah[0], ah[1], ah[2], ah[3]};
    asm volatile("v_mfma_scale_f32_16x16x128_f8f6f4 %0, %1, %2, %0, %3, %3 op_sel_hi:[0,0,0]" : "+v"(c) : "v"(bb), "v"(aa), "v"(one));
}
template <class Epi, class Sched, bool ALIGN_EPI = false, bool SP2 = false, bool I8 = false, bool F8 = false>
__device__ __forceinline__ void gemm_phase(PG8_LAS unsigned char* lds, const Gemm g, const Sched& S, const Epi& E) {
    const int tid = threadIdx.x, wid = __builtin_amdgcn_readfirstlane(tid >> 6), lane = tid & 63, wr = wid >> 2, wc = wid & 3, fr = lane & 15, fq = lane >> 4;
    const int K = g.ld ? g.ld : g.K, nt = g.K / BK;
    unsigned voffA[2], voffB[2];
#pragma unroll
    for (int i = 0; i < 2; ++i) { int R, C; stage_rc(tid * 16 + i * 8192, R, C); const int Rb = Epi::PERM ? ((R & ~31) + perm32(R & 31)) : R;
        voffA[i] = (unsigned)(R * K + C) * 2u; voffB[i] = (unsigned)(Rb * K + C) * 2u; }
    const size_t kstep = (size_t)(BK * 2);
    const size_t hstep = (size_t)HALF * K * 2;
    const size_t tstep = 2 * hstep;
    const unsigned ldsw = (unsigned)wid * 1024u;
    const int aoff = lds_byte(wr * 64 + fr, fq * 8), boff = lds_byte(wc * 32 + fr, fq * 8);
#define PG8_SA(b, h) (((b) * 2 + (h)) * HTB)
#define PG8_SB(b, h) ((4 + (b) * 2 + (h)) * HTB)
#define PG8_STAGE(bufoff, gbase, voff) do { _Pragma("unroll") for (int _i = 0; _i < 2; ++_i) \
        __builtin_amdgcn_global_load_lds((const unsigned*)((const char*)(gbase) + (voff)[_i]), (PG8_LAS unsigned*)(lds + (bufoff) + ldsw + _i * 8192), 16, 0, 0); } while (0)
#define PG8_LDA(dst, b, h) do { _Pragma("unroll") for (int m = 0; m < 4; ++m) _Pragma("unroll") for (int k = 0; k < 2; ++k) dst[m][k] = *(const PG8_LAS bf16x8*)(lds + PG8_SA(b, h) + aoff + m * 2048 + k * 1024); } while (0)
#define PG8_LDB(dst, b, h) do { _Pragma("unroll") for (int n = 0; n < 2; ++n) _Pragma("unroll") for (int k = 0; k < 2; ++k) dst[n][k] = *(const PG8_LAS bf16x8*)(lds + PG8_SB(b, h) + boff + n * 2048 + k * 1024); } while (0)
#define PG8_MMA(ai, bj, At, Bt) do { __builtin_amdgcn_s_setprio(1); if constexpr (F8) { _Pragma("unroll") for (int m = 0; m < 4; ++m) _Pragma("unroll") for (int n = 0; n < 2; ++n) \
        mma_f8(Bt[n][0], Bt[n][1], At[m][0], At[m][1], acc[ai][bj][m][n], f8one); } else { _Pragma("unroll") for (int m = 0; m < 4; ++m) _Pragma("unroll") for (int n = 0; n < 2; ++n) _Pragma("unroll") for (int k = 0; k < 2; ++k) \
        acc[ai][bj][m][n] = mma_step<I8>(Bt[n][k], At[m][k], acc[ai][bj][m][n]); } __builtin_amdgcn_s_setprio(0); } while (0)
#define PG8_WAIT_V(n) asm volatile("s_waitcnt vmcnt(" #n ")" ::: "memory")
#define PG8_WAIT_L(n) asm volatile("s_waitcnt lgkmcnt(" #n ")" ::: "memory")
#define PG8_BAR __builtin_amdgcn_s_barrier()
#define PG8_SCHED __builtin_amdgcn_sched_barrier(0)
    Unit cur, nxt; int ui = 0;
    if (!S.next(0, cur)) return;
    f32x4 acc[2][2][4][2]; int f8one = 0x7f7f7f7f; asm volatile("" : "+v"(f8one));
#pragma unroll
    for (int a = 0; a < 2; ++a)
#pragma unroll
        for (int b = 0; b < 2; ++b)
#pragma unroll
            for (int m = 0; m < 4; ++m)
#pragma unroll
                for (int n = 0; n < 2; ++n) acc[a][b][m][n] = (f32x4){0.f, 0.f, 0.f, 0.f};
    bf16x8 At[4][2], B0[2][2], B1[2][2];
    const char* cA = (const char*)g.A + (size_t)cur.pm * tstep + (size_t)cur.kq * g.kcb; const char* cB = (const char*)g.Bt + (size_t)cur.pn * tstep + (size_t)cur.kq * g.kcb;
    S.a_ready(cur);
    if constexpr (SP2) {
        PG8_STAGE(PG8_SB(0, 0), cB, voffB); PG8_STAGE(PG8_SB(0, 1), cB + hstep, voffB); PG8_STAGE(PG8_SA(0, 0), cA, voffA); PG8_STAGE(PG8_SA(0, 1), cA + hstep, voffA);
        if (wr == 1) PG8_BAR;
        PG8_WAIT_V(2); PG8_BAR;
        PG8_STAGE(PG8_SB(1, 0), cB + kstep, voffB); PG8_STAGE(PG8_SA(1, 0), cA + kstep, voffA); PG8_STAGE(PG8_SB(1, 1), cB + hstep + kstep, voffB);
        PG8_WAIT_V(6); PG8_BAR;
    } else {
        PG8_STAGE(PG8_SB(0, 0), cB, voffB); PG8_STAGE(PG8_SA(0, 0), cA, voffA); PG8_STAGE(PG8_SB(0, 1), cB + hstep, voffB); PG8_STAGE(PG8_SA(0, 1), cA + hstep, voffA);
        if (wr == 1) PG8_BAR;
        PG8_WAIT_V(4); PG8_BAR;
        PG8_STAGE(PG8_SB(1, 0), cB + kstep, voffB); PG8_STAGE(PG8_SA(1, 0), cA + kstep, voffA); PG8_STAGE(PG8_SB(1, 1), cB + hstep + kstep, voffB);
        PG8_WAIT_V(6); PG8_BAR;
    }
    for (;;) {
        const bool has_next = S.next(ui + 1, nxt);
        const char* nA = has_next ? (const char*)g.A + (size_t)nxt.pm * tstep + (size_t)nxt.kq * g.kcb : cA; const char* nB = has_next ? (const char*)g.Bt + (size_t)nxt.pn * tstep + (size_t)nxt.kq * g.kcb : cB;
        for (int t = 0; t < nt; t += 2) {
            const bool last = (t == nt - 2);
            const char* a1 = cA + (size_t)(t + 1) * kstep;
            const char* a2 = last ? nA : cA + (size_t)(t + 2) * kstep; const char* b2 = last ? nB : cB + (size_t)(t + 2) * kstep;
            const char* a3 = a2 + kstep; const char* b3 = b2 + kstep;
            if (last && has_next) S.a_ready(nxt);
            if constexpr (SP2) {
            PG8_LDB(B0, 0, 0); PG8_LDB(B1, 0, 1); PG8_SCHED; PG8_LDA(At, 0, 0); PG8_STAGE(PG8_SA(1, 1), a1 + hstep, voffA);
            PG8_WAIT_V(8); PG8_WAIT_L(0); PG8_BAR; PG8_MMA(0, 0, At, B0); PG8_MMA(0, 1, At, B1); PG8_BAR; PG8_SCHED;
            PG8_LDA(At, 0, 1); PG8_STAGE(PG8_SB(0, 0), b2, voffB); PG8_STAGE(PG8_SB(0, 1), b2 + hstep, voffB); PG8_STAGE(PG8_SA(0, 0), a2, voffA);
            PG8_WAIT_V(8); PG8_WAIT_L(0); PG8_BAR; PG8_MMA(1, 0, At, B0); PG8_MMA(1, 1, At, B1); PG8_BAR; PG8_SCHED;
            PG8_LDB(B0, 1, 0); PG8_LDB(B1, 1, 1); PG8_SCHED; PG8_LDA(At, 1, 0); PG8_STAGE(PG8_SA(0, 1), a2 + hstep, voffA);
            PG8_WAIT_V(8); PG8_WAIT_L(0); PG8_BAR; PG8_MMA(0, 0, At, B0); PG8_MMA(0, 1, At, B1); PG8_BAR; PG8_SCHED;
            PG8_LDA(At, 1, 1); PG8_STAGE(PG8_SB(1, 0), b3, voffB); PG8_STAGE(PG8_SB(1, 1), b3 + hstep, voffB); PG8_STAGE(PG8_SA(1, 0), a3, voffA);
            PG8_WAIT_V(8); PG8_WAIT_L(0); PG8_BAR; PG8_MMA(1, 0, At, B0); PG8_MMA(1, 1, At, B1); PG8_BAR; PG8_SCHED;
            } else {
            PG8_LDB(B0, 0, 0); PG8_SCHED; PG8_LDA(At, 0, 0); PG8_STAGE(PG8_SA(1, 1), a1 + hstep, voffA);
            PG8_WAIT_L(8); PG8_BAR; PG8_WAIT_L(0); PG8_MMA(0, 0, At, B0); PG8_BAR; PG8_SCHED;
            PG8_LDB(B1, 0, 1); PG8_STAGE(PG8_SB(0, 0), b2, voffB);
            PG8_BAR; PG8_WAIT_L(0); PG8_MMA(0, 1, At, B1); PG8_BAR;
            PG8_LDA(At, 0, 1); PG8_STAGE(PG8_SA(0, 0), a2, voffA);
            PG8_BAR; PG8_WAIT_L(0); PG8_MMA(1, 0, At, B0); PG8_BAR; PG8_SCHED;
            PG8_STAGE(PG8_SB(0, 1), b2 + hstep, voffB);
            PG8_WAIT_V(6); PG8_BAR; PG8_MMA(1, 1, At, B1); PG8_BAR;
            PG8_LDB(B0, 1, 0); PG8_SCHED; PG8_LDA(At, 1, 0); PG8_STAGE(PG8_SA(0, 1), a2 + hstep, voffA);
            PG8_WAIT_L(8); PG8_BAR; PG8_WAIT_L(0); PG8_MMA(0, 0, At, B0); PG8_BAR; PG8_SCHED;
            PG8_LDB(B1, 1, 1); PG8_STAGE(PG8_SB(1, 0), b3, voffB);
            PG8_BAR; PG8_WAIT_L(0); PG8_MMA(0, 1, At, B1); PG8_BAR;
            PG8_LDA(At, 1, 1); PG8_STAGE(PG8_SA(1, 0), a3, voffA);
            PG8_BAR; PG8_WAIT_L(0); PG8_MMA(1, 0, At, B0); PG8_BAR; PG8_SCHED;
            PG8_STAGE(PG8_SB(1, 1), b3 + hstep, voffB);
            PG8_WAIT_V(6); PG8_BAR; PG8_MMA(1, 1, At, B1); PG8_BAR;
            }
        }
        if constexpr (F8) asm volatile("s_nop 15\n\ts_nop 15" ::: "memory");
        if constexpr (ALIGN_EPI) { if (wr == 0) PG8_BAR; }
        if constexpr (!Epi::AFTER_DRAIN) { E(acc, cur, wr, wc, fr, fq); if (REP_CODE == 3001 && I8) E(acc, cur, wr, wc, fr, fq); S.done(cur); }
        if (!has_next) break;
#pragma unroll
        for (int a = 0; a < 2; ++a)
#pragma unroll
            for (int b = 0; b < 2; ++b)
#pragma unroll
                for (int m = 0; m < 4; ++m)
#pragma unroll
                    for (int n = 0; n < 2; ++n) acc[a][b][m][n] = (f32x4){0.f, 0.f, 0.f, 0.f};
        cur = nxt; cA = nA; cB = nB; ++ui;
        if constexpr (ALIGN_EPI) { if (wr == 1) PG8_BAR; }
    }
    PG8_WAIT_V(0);
    if constexpr (!ALIGN_EPI) { if (wr == 0) PG8_BAR; }
    PG8_BAR;
    if constexpr (Epi::AFTER_DRAIN) { E.fused(acc, cur, wr, wc, fr, fq, lds, wid, lane); S.done(cur); }
#undef PG8_SA
#undef PG8_SB
#undef PG8_STAGE
#undef PG8_LDA
#undef PG8_LDB
#undef PG8_MMA
#undef PG8_WAIT_V
#undef PG8_WAIT_L
#undef PG8_BAR
#undef PG8_SCHED
}
}

#define LAS __attribute__((address_space(3)))
typedef unsigned short bf16;
typedef float f32x4 __attribute__((ext_vector_type(4)));
typedef unsigned v4u __attribute__((ext_vector_type(4)));
typedef unsigned v2u __attribute__((ext_vector_type(2)));
constexpr int NWAVES = 8;
constexpr int DM = 2048, NB = 8, SEQ = 2048, CTXL = 256, DFF = 5632;
constexpr int ML = NB * SEQ, MC = NB * CTXL, MT = ML + MC;
constexpr int NMODC = 9 * DM;
constexpr int EVEN_IN = 4096, ODD_IN = 6176, ODD_INP = 6400, ODD_LD = 6144;
constexpr int XBC_LD = 2048 + 64, EVEN_LD = EVEN_IN;
constexpr float EPS = 1e-6f;
enum { I_X = 0, I_C, I_CTX, I_CCTX, I_MODW, I_MODB, I_NORMG, I_WG, I_WU, I_WD, I_FINALG, I_EVWIN, I_EVWOUT, I_S5ARE, I_S5AIM, I_S5LOGDT, I_S5BRE, I_S5BIM, I_S5CRE, I_S5CIM,
       I_S5D, I_GLUW, I_GLUB, I_RPB, I_ODWIN, I_ODWOUT, I_HYSW, I_HYSB, I_HYWIN, I_HYBIN, I_HYWMID, I_HYBMID, I_HYWOUT, I_HYFREQ, I_HYFBIAS, I_SSDCW, I_SSDCB, I_SSDDTB, I_SSDALOG,
       I_SSDD, I_SSDNG, N_IN };
constexpr size_t MiB = 1u << 20;
constexpr size_t WS_CTL = 0, CTL_ZERO_BYTES = 1 * MiB;
constexpr size_t SZ_WGU = (size_t)2 * DFF * DM * 2, SZ_WGU8 = (size_t)2 * DFF * DM, SZ_WD = (size_t)DM * DFF * 2;
constexpr size_t WS_WGU = 1 * MiB;
constexpr size_t WS_WD = WS_WGU + 4 * SZ_WGU8;
constexpr size_t WS_WEVIN = WS_WD + 4 * SZ_WD;
constexpr size_t WS_WEVOUT = WS_WEVIN + (size_t)EVEN_IN * DM * 2;
constexpr size_t WS_WGLU = WS_WEVOUT + (size_t)DM * DM * 2;
constexpr size_t WS_WODIN = WS_WGLU + (size_t)1024 * 1024 * 2;
constexpr size_t WS_WODOUT = WS_WODIN + (size_t)ODD_INP * DM * 2;
constexpr size_t WS_MODP = WS_WODOUT + (size_t)DM * DM * 2;
constexpr size_t WS_MODV = WS_MODP + (size_t)2 * 32 * 9 * NMODC * 4;
constexpr size_t WS_CS = WS_MODV + (size_t)2 * 9 * NMODC * 4;
constexpr size_t WS_RS = WS_CS + (size_t)4 * 2 * DFF * 4;
constexpr size_t WS_CS2 = WS_RS + (size_t)MT * 4;
constexpr size_t WS_XS = WS_CS2 + (size_t)(EVEN_IN + ODD_INP) * 4;
constexpr size_t WS_H = WS_XS + (size_t)MT * DM * 4;
constexpr size_t WS_BIG = WS_H + (size_t)MT * DM * 2;
constexpr size_t SZ_BIG = (size_t)MT * ODD_LD * 2;
constexpr size_t WS_MIX = WS_BIG + SZ_BIG;
constexpr size_t WS_FILT = WS_MIX + (size_t)MT * DM * 2;
constexpr size_t WS_SCR = WS_FILT + (size_t)2 * 1024 * 4096 * 4;
constexpr size_t WS_G = WS_SCR, WS_VT = WS_G + (size_t)MT * 1024 * 2;
constexpr size_t WS_S5KF = WS_VT + (size_t)64 * 128 * (SEQ + CTXL) * 2;
constexpr size_t WS_S5W = WS_S5KF + (size_t)64 * 2 * 64 * 256 * 4;
constexpr size_t WS_S5V = WS_S5W + (size_t)64 * 256 * 1024 * 2;
constexpr size_t WS_S5SLOC = WS_S5V + (size_t)64 * 1024 * 256 * 2;
constexpr size_t WS_S5SIN = WS_S5SLOC + (size_t)64 * 288 * 256 * 4;
constexpr size_t WS_SCR0_END = WS_S5SIN + (size_t)64 * 288 * 256 * 2;
constexpr size_t SZ_CM = (size_t)1024 * ML * 2;
constexpr size_t WS_X1C = WS_SCR, WS_X2C = WS_X1C + SZ_CM, WS_VC = WS_X2C + SZ_CM, WS_ZC = WS_VC + SZ_CM, WS_XBC = WS_ZC + SZ_CM, WS_DT = WS_XBC + (size_t)MT * XBC_LD * 2, WS_SCR1_END = WS_DT + (size_t)MT * 32 * 4;
constexpr size_t WS_YS = WS_H;
constexpr size_t WS_PART = (WS_SCR0_END > WS_SCR1_END ? WS_SCR0_END : WS_SCR1_END);
constexpr size_t WS_H3 = WS_PART + (size_t)4 * MC * DM * 4;
constexpr size_t WS_XS16 = WS_H3 + (size_t)SEQ * 64 * 4;
constexpr size_t WS_END = WS_XS16 + (size_t)ML * DM * 2;
static_assert(WS_END <= (size_t)1152 * MiB, "workspace map exceeds the guaranteed d_ws size");
static_assert((size_t)2 * ML * 1024 * 2 <= (size_t)MT * DM * 2, "YS fits in H");
constexpr int CW_TMO = 0, CW_BAR = 4096, CW_XRANK = 8192, CW_CMAX = 16384, CW_CMAX_EV = CW_CMAX + 4 * 2 * DFF, CW_CMAX_OD = CW_CMAX_EV + EVEN_IN, CW_CMAX_END = CW_CMAX_OD + ODD_INP;
static_assert(CW_CMAX_END * 4 <= (int)CTL_ZERO_BYTES, "control words");
constexpr int RING_BYTES = 131072, SCR_BYTES = 139264, LDSCTL_OFF = SCR_BYTES, MISC_OFF = LDSCTL_OFF + 320, LDS_BYTES = 147456;

__device__ __forceinline__ float bf2f(unsigned v) { return __uint_as_float(v << 16); }
__device__ __forceinline__ unsigned f2bf(float f) { unsigned u = __float_as_uint(f); return (u + 0x7fffu + ((u >> 16) & 1u)) >> 16; }
__device__ __forceinline__ unsigned pk2(float lo, float hi) { return f2bf(lo) | (f2bf(hi) << 16); }
__device__ __forceinline__ float wave_sum(float v) {
#pragma unroll
    for (int o = 1; o < 64; o <<= 1) v += __shfl_xor(v, o);
    return v;
}
__device__ __forceinline__ float wave_max(float v) {
#pragma unroll
    for (int o = 1; o < 64; o <<= 1) v = fmaxf(v, __shfl_xor(v, o));
    return v;
}
__device__ __forceinline__ float silu_f(float x) { return x / (1.0f + __expf(-x)); }
__device__ __forceinline__ float rdlane(float v, int l) { return __int_as_float(__builtin_amdgcn_readlane(__float_as_int(v), l)); }

#ifndef I8_INPROJ
#define I8_INPROJ 1
#endif
#ifndef F8_DOWN
#define F8_DOWN 1
#endif
#define NSPLIT (F8_DOWN ? 2 : 4)
#ifndef EXP_A
#define EXP_A 0
#endif
#define I8_EV ((I8_INPROJ) & 1)
#define I8_OD (((I8_INPROJ) >> 1) & 1)
#ifndef SPLIT_CTX
#define SPLIT_CTX 1
#endif
#ifndef GU_ONEPASS
#define GU_ONEPASS 1
#endif
#ifndef EV_ONEPASS
#define EV_ONEPASS 0
#endif
#ifndef DEFER_Q
#define DEFER_Q 0
#endif
#ifndef EMU_GU
#define EMU_GU 0
#endif
#ifndef EMU_D
#define EMU_D 0
#endif
__device__ __forceinline__ float q_e4m3(float x) {
    const float ax = fabsf(x);
    if (ax < 0.015625f) return rintf(x * 512.0f) * (1.0f / 512.0f);
    unsigned u = __float_as_uint(x); u += 0x7FFFFu + ((u >> 20) & 1u); u &= 0xFFF00000u; const float r = __uint_as_float(u);
    return fabsf(r) > 448.0f ? copysignf(448.0f, x) : r;
}
struct Args { const float* in[N_IN]; float* out; unsigned char* ws; int ph_lo, ph_hi; };
struct Frame {
    LAS unsigned char* lds; const float* const* in; float* out; unsigned char* ws;
    int tid, lane, wave, gw, ngw, G, xcd, xrank;
};

__device__ __forceinline__ void transpose_item(const float* W, int K, int N, bf16* WT, int k0, int n0, int drow0, LAS float* scr, int lane, float wscale = 0.f) {
#pragma unroll
    for (int i = 0; i < 32; ++i) { const int kk = 2 * i + (lane >> 5); float wv = __builtin_nontemporal_load(W + (size_t)(k0 + kk) * N + n0 + (lane & 31)); if (wscale > 0.f) wv = q_e4m3(wv * wscale) / wscale; else if (wscale < 0.f) { const float st = 5.5f * 0.02209708691f / 127.0f; wv = fminf(fmaxf(rintf(wv / st), -127.f), 127.f) * st; } scr[kk * 33 + (lane & 31)] = wv; }
    asm volatile("s_waitcnt lgkmcnt(0)" ::: "memory");
    const int c = lane & 7;
#pragma unroll
    for (int j = 0; j < 4; ++j) { const int n = (lane >> 3) + 8 * j; const LAS float* s = scr + (8 * c) * 33 + n;
        v4u o; o.x = pk2(s[0 * 33], s[1 * 33]); o.y = pk2(s[2 * 33], s[3 * 33]); o.z = pk2(s[4 * 33], s[5 * 33]); o.w = pk2(s[6 * 33], s[7 * 33]);
        *(v4u*)(WT + (size_t)(drow0 + n) * K + k0 + 8 * c) = o; }
    asm volatile("s_waitcnt lgkmcnt(0)" ::: "memory");
}
#ifndef REP_CODE
#define REP_CODE -1
#endif
#define P0REP(code) for (int _pr = 0; _pr < ((code) == REP_CODE ? 2 : 1); ++_pr)
__device__ __forceinline__ void transpose_f8_item(const float* W, int K, int N, unsigned char* WT, int k0, int n0, LAS float* scr, int lane, float wscale) {
#pragma unroll
    for (int i = 0; i < 32; ++i) { const int kk = 2 * i + (lane >> 5); scr[kk * 33 + (lane & 31)] = __builtin_nontemporal_load(W + (size_t)(k0 + kk) * N + n0 + (lane & 31)) * wscale; }
    asm volatile("s_waitcnt lgkmcnt(0)" ::: "memory");
    const int c = lane & 7;
#pragma unroll
    for (int j = 0; j < 4; ++j) { const int n = (lane >> 3) + 8 * j; const LAS float* sp = scr + (8 * c) * 33 + n;
        *(v2u*)(WT + (size_t)(n0 + n) * K + k0 + 8 * c) = (v2u){pg8::pack4_fp8(sp[0], sp[33], sp[66], sp[99]), pg8::pack4_fp8(sp[132], sp[165], sp[198], sp[231])}; }
    asm volatile("s_waitcnt lgkmcnt(0)" ::: "memory");
}
__device__ __forceinline__ void p0_prologue(Frame& F, int part) {
    LAS float* scr = (LAS float*)(F.lds + F.wave * 16384);
    const float* const* in = F.in; unsigned char* ws = F.ws; const int lane = F.lane;
    if (part == 0) {
    constexpr int I_FFN1 = (DM / 64) * (DFF / 32);
    constexpr int I_FFN = 4 * I_FFN1;
    constexpr int I_EVIN = (DM / 64) * (EVEN_IN / 32), I_EVOUT = (DM / 64) * (DM / 32), I_GLU = (1024 / 64) * (1024 / 32), I_ODIN = (DM / 64) * (ODD_IN / 32), I_ODOUT = I_EVOUT;
    constexpr int NITEMS = I_FFN + I_EVOUT + I_GLU + I_ODOUT + I_EVIN + I_ODIN;
    P0REP(1001) for (int it = F.gw; it < NITEMS; it += F.ngw) {
        int r = it;
        if (r < I_FFN) { const int lab = r / I_FFN1, rr = r % I_FFN1; const int nblk = DM / 32, kb = rr / nblk, nb = rr % nblk;
            if (F8_DOWN) transpose_f8_item(in[I_WD] + (size_t)lab * DFF * DM, DFF, DM, ws + WS_WD + (size_t)lab * SZ_WD, kb * 64, nb * 32, scr, lane, 1024.f);
            else transpose_item(in[I_WD] + (size_t)lab * DFF * DM, DFF, DM, (bf16*)(ws + WS_WD + (size_t)lab * SZ_WD), kb * 64, nb * 32, nb * 32, scr, lane, EMU_D ? 1024.f : 0.f);
            continue; }
        r -= I_FFN;
        if (r < I_EVOUT) { const int nblk = DM / 32; transpose_item(in[I_EVWOUT], DM, DM, (bf16*)(ws + WS_WEVOUT), (r / nblk) * 64, (r % nblk) * 32, (r % nblk) * 32, scr, lane); continue; }
        r -= I_EVOUT;
        if (r < I_GLU) { const int nblk = 1024 / 32; transpose_item(in[I_GLUW], 1024, 1024, (bf16*)(ws + WS_WGLU), (r / nblk) * 64, (r % nblk) * 32, (r % nblk) * 32, scr, lane); continue; }
        r -= I_GLU;
        if (r < I_ODOUT) { const int nblk = DM / 32; transpose_item(in[I_ODWOUT], DM, DM, (bf16*)(ws + WS_WODOUT), (r / nblk) * 64, (r % nblk) * 32, (r % nblk) * 32, scr, lane); continue; }
        r -= I_ODOUT;
        if (r < I_EVIN) { if (I8_EV && !EXP_A) continue; const int nblk = EVEN_IN / 32; transpose_item(in[I_EVWIN], DM, EVEN_IN, (bf16*)(ws + WS_WEVIN), (r / nblk) * 64, (r % nblk) * 32, (r % nblk) * 32, scr, lane); continue; }
        r -= I_EVIN;
        if (!I8_OD) { const int nblk = ODD_IN / 32; transpose_item(in[I_ODWIN], DM, ODD_IN, (bf16*)(ws + WS_WODIN), (r / nblk) * 64, (r % nblk) * 32, (r % nblk) * 32, scr, lane); }
    }
    { v4u* z = (v4u*)(ws + WS_WODIN + (size_t)ODD_IN * DM * (I8_OD ? 1 : 2)); const int nz = (ODD_INP - ODD_IN) * DM * (I8_OD ? 1 : 2) / 16;
      for (int i = F.gw * 64 + lane; i < nz; i += F.ngw * 64) z[i] = (v4u){0u, 0u, 0u, 0u}; }
    { LAS float* sv = scr;
      P0REP(1003) for (int it = F.gw; it < 2 * 72 * 32; it += F.ngw) {
          const int kc = it & 31, cb = (it >> 5) % 72, l = it / (72 * 32);
          for (int idx = lane; idx < 9 * 64; idx += 64) { const int r = idx >> 6, kk = idx & 63; const float v = r < 8 ? in[I_C][r * DM + kc * 64 + kk] : in[I_CCTX][kc * 64 + kk]; sv[idx] = silu_f(v); }
          asm volatile("s_waitcnt lgkmcnt(0)" ::: "memory");
          f32x4 acc[9];
#pragma unroll
          for (int r = 0; r < 9; ++r) acc[r] = (f32x4){0.f, 0.f, 0.f, 0.f};
          const float* wp = in[I_MODW] + ((size_t)l * DM + kc * 64) * NMODC + cb * 256 + lane * 4;
#pragma unroll 16
          for (int kk = 0; kk < 64; ++kk) { const f32x4 w = __builtin_nontemporal_load((const f32x4*)(wp + (size_t)kk * NMODC));
#pragma unroll
              for (int r = 0; r < 9; ++r) acc[r] += w * sv[r * 64 + kk]; }
          float* op = (float*)(ws + WS_MODP) + ((size_t)(l * 32 + kc) * 9) * NMODC + cb * 256 + lane * 4;
#pragma unroll
          for (int r = 0; r < 9; ++r) *(f32x4*)(op + (size_t)r * NMODC) = acc[r];
          asm volatile("s_waitcnt lgkmcnt(0)" ::: "memory");
      } }
    { unsigned* CM = (unsigned*)(ws + WS_CTL);
      constexpr int NI_GU = 8 * 32 * 22, NI_EV = 32 * 16, NI_OD = 32 * 25;
      P0REP(1002) for (int it = (GU_ONEPASS ? NI_GU + (EV_ONEPASS ? NI_EV : 0) : 0) + F.gw; it < NI_GU + (I8_INPROJ ? NI_EV + NI_OD : 0); it += F.ngw) {
          const float* W; int N, nb, kc, mode; unsigned* cm;
          if (it < NI_GU) { nb = it % 22; kc = (it / 22) & 31; const int mm = it / (22 * 32); mode = 1 + (mm & 1); W = (mode == 1 ? in[I_WG] : in[I_WU]) + (size_t)(mm >> 1) * DM * DFF; N = DFF; cm = CM + CW_CMAX + (mm >> 1) * 2 * DFF; }
          else if (it < NI_GU + NI_EV) { if (!I8_EV) continue; const int r = it - NI_GU; nb = r & 15; kc = r >> 4; mode = 0; W = in[I_EVWIN]; N = EVEN_IN; cm = CM + CW_CMAX_EV; }
          else { if (!I8_OD) continue; const int r = it - NI_GU - NI_EV; nb = r % 25; kc = r / 25; mode = 0; W = in[I_ODWIN]; N = ODD_IN; cm = CM + CW_CMAX_OD; }
          const int n0 = nb * 256 + lane * 4;
          if (n0 < N) { const float* wp = W + (size_t)(kc * 64) * N + n0; f32x4 mx = (f32x4){0.f, 0.f, 0.f, 0.f};
#pragma unroll 16
              for (int kk = 0; kk < 64; ++kk) { const f32x4 w = *(const f32x4*)(wp + (size_t)kk * N); mx.x = fmaxf(mx.x, fabsf(w.x)); mx.y = fmaxf(mx.y, fabsf(w.y)); mx.z = fmaxf(mx.z, fabsf(w.z)); mx.w = fmaxf(mx.w, fabsf(w.w)); }
              unsigned* cp = cm + (mode == 0 ? n0 : (n0 >> 7) * 256 + (n0 & 127) + (mode - 1) * 128);
              atomicMax(cp, __float_as_uint(mx.x)); atomicMax(cp + 1, __float_as_uint(mx.y)); atomicMax(cp + 2, __float_as_uint(mx.z)); atomicMax(cp + 3, __float_as_uint(mx.w)); } } }
    }
    if (part == 1) {
    { const float PI2 = 6.283185307179586f; float* H3 = (float*)(ws + WS_H3); LAS float* hl = scr; LAS float* zl = hl + 64;
      P0REP(1004) for (int pos = F.gw; pos < SEQ; pos += F.ngw) {
          const float w = PI2 * (float)pos / 2048.0f, tt = (float)pos / 2047.0f;
          if (lane < 32) { const int i = lane & 15; const float f = 1e-4f + (float)i * ((15.0f - 1e-4f) / 15.0f); const float a = f * w; zl[lane] = lane < 16 ? cosf(a) : -sinf(a); }
          asm volatile("s_waitcnt lgkmcnt(0)" ::: "memory");
          float pre = in[I_HYBIN][lane] + tt * in[I_HYWIN][lane];
#pragma unroll 4
          for (int e = 0; e < 32; e += 4) { const f32x4 z4 = *(const LAS f32x4*)(zl + e);
              pre += z4.x * in[I_HYWIN][(1 + e) * 64 + lane] + z4.y * in[I_HYWIN][(2 + e) * 64 + lane] + z4.z * in[I_HYWIN][(3 + e) * 64 + lane] + z4.w * in[I_HYWIN][(4 + e) * 64 + lane]; }
          const float fr = in[I_HYFREQ][lane]; float hv = sinf(fr * pre);
#pragma unroll
          for (int l2 = 0; l2 < 2; ++l2) { hl[lane] = hv; asm volatile("s_waitcnt lgkmcnt(0)" ::: "memory");
              float p0 = in[I_HYBMID][l2 * 64 + lane]; const float* wm = in[I_HYWMID] + l2 * 4096 + lane;
#pragma unroll 8
              for (int i = 0; i < 64; i += 4) { const f32x4 a0 = *(const LAS f32x4*)(hl + i); p0 += a0.x * wm[i * 64] + a0.y * wm[(i + 1) * 64] + a0.z * wm[(i + 2) * 64] + a0.w * wm[(i + 3) * 64]; }
              asm volatile("s_waitcnt lgkmcnt(0)" ::: "memory");
              hv = sinf(fr * p0); }
          H3[(size_t)pos * 64 + lane] = hv;
      } }
    }
}
__device__ __forceinline__ void p1_filter_proj(Frame& F) {
    const float* const* in = F.in; unsigned char* ws = F.ws; const int lane = F.lane;
    const float* H3 = (const float*)(ws + WS_H3); float* FILT = (float*)(ws + WS_FILT); LAS float* hl = (LAS float*)(F.lds + F.wave * 16384);
    const float min_decay = -3.0701134573253943f, max_decay = -15.350567286626972f;
    for (int item = F.gw; item < 128 * 64; item += F.ngw) {
        const int pb = item >> 6, cbk = item & 63, col = cbk * 64 + lane;
#pragma unroll
        for (int p = 0; p < 16; ++p) hl[p * 64 + lane] = H3[(size_t)(16 * pb + p) * 64 + lane];
        asm volatile("s_waitcnt lgkmcnt(0)" ::: "memory");
        float acc[16];
#pragma unroll
        for (int p = 0; p < 16; ++p) acc[p] = 0.f;
        const float* wo = in[I_HYWOUT] + col;
#pragma unroll 4
        for (int i = 0; i < 64; i += 4) { const float w0 = wo[i * 4096], w1 = wo[(i + 1) * 4096], w2 = wo[(i + 2) * 4096], w3 = wo[(i + 3) * 4096];
#pragma unroll
            for (int p = 0; p < 16; ++p) { const f32x4 h4 = *(const LAS f32x4*)(hl + p * 64 + i); acc[p] += h4.x * w0 + h4.y * w1 + h4.z * w2 + h4.w * w3; } }
        const int o = col >> 11, d = (col >> 10) & 1, c = col & 1023;
        const float delta = fabsf(min_decay + (float)c * ((max_decay - min_decay) / 1023.0f));
        float* fp = FILT + (size_t)(o * 1024 + c) * 4096;
#pragma unroll
        for (int p = 0; p < 16; ++p) { const int pos = 16 * pb + p; const float val = acc[p] * expf(-((float)pos / 2047.0f) * delta);
            if (d == 0) fp[2047 + pos] = val; else if (pos >= 1) fp[2047 - pos] = val; }
        asm volatile("s_waitcnt lgkmcnt(0)" ::: "memory");
    }
}
__device__ __forceinline__ void p1_modred(Frame& F) {
    const float* MP = (const float*)(F.ws + WS_MODP); float* MV = (float*)(F.ws + WS_MODV);
    for (int i = blockIdx.x * 512 + F.tid; i < 2 * 9 * NMODC; i += F.G * 512) {
        const int col = i % NMODC, r = (i / NMODC) % 9, l = i / (9 * NMODC); float s = F.in[I_MODB][l * NMODC + col];
#pragma unroll
        for (int kc = 0; kc < 32; ++kc) s += MP[((size_t)(l * 32 + kc) * 9 + r) * NMODC + col];
        MV[i] = s; }
}
__device__ __forceinline__ void quant_item(const float* W, int N, int k0, int n0, int drow0, const unsigned* cmax, float* cs, unsigned char* WT, LAS float* scr, int lane) {
    const float cm = fmaxf(__uint_as_float(cmax[drow0 + (lane & 31)]), 1e-30f), isc = 127.0f / cm;
    if (k0 == 0 && lane < 32) cs[drow0 + lane] = cm * (1.0f / 127.0f);
#pragma unroll
    for (int i = 0; i < 32; ++i) { const int kk = 2 * i + (lane >> 5); scr[kk * 33 + (lane & 31)] = rintf(__builtin_nontemporal_load(W + (size_t)(k0 + kk) * N + n0 + (lane & 31)) * isc); }
    asm volatile("s_waitcnt lgkmcnt(0)" ::: "memory");
    const int c = lane & 7;
#pragma unroll
    for (int j = 0; j < 4; ++j) { const int n = (lane >> 3) + 8 * j; const LAS float* sp = scr + (8 * c) * 33 + n; unsigned lo = 0u, hi = 0u;
#pragma unroll
        for (int q = 0; q < 4; ++q) { lo |= ((unsigned)((int)sp[q * 33]) & 255u) << (8 * q); hi |= ((unsigned)((int)sp[(4 + q) * 33]) & 255u) << (8 * q); }
        *(v2u*)(WT + (size_t)(drow0 + n) * DM + k0 + 8 * c) = (v2u){lo, hi}; }
    asm volatile("s_waitcnt lgkmcnt(0)" ::: "memory");
}
__device__ __forceinline__ void p1_quant_weights(Frame& F) {
    LAS float* scr = (LAS float*)(F.lds + F.wave * 16384); const float* const* in = F.in; unsigned char* ws = F.ws; const int lane = F.lane;
    const unsigned* CM = (const unsigned*)(ws + WS_CTL);
    constexpr int I1 = (DM / 64) * (DFF / 32), NI_GU = 8 * I1, NI_EV = (DM / 64) * (EVEN_IN / 32), NI_OD = (DM / 64) * (ODD_IN / 32);
    constexpr int NI_ALL = NI_GU + (I8_INPROJ ? NI_EV + NI_OD : 0);
    for (int it0 = F.gw; it0 < NI_ALL - (GU_ONEPASS ? NI_GU + (I8_INPROJ && EV_ONEPASS ? NI_EV : 0) : 0); it0 += F.ngw) { const int it = NI_ALL - 1 - it0;
        if (it < NI_GU) { const int mm = it / I1, rr = it % I1, mat = mm & 1, lab = mm >> 1, nblk = DFF / 32, kb = rr / nblk, n0 = (rr % nblk) * 32;
            quant_item((mat == 0 ? in[I_WG] : in[I_WU]) + (size_t)lab * DM * DFF, DFF, kb * 64, n0, (n0 >> 7) * 256 + (n0 & 127) + mat * 128, CM + CW_CMAX + lab * 2 * DFF, (float*)(ws + WS_CS) + lab * 2 * DFF, ws + WS_WGU + (size_t)lab * SZ_WGU8, scr, lane); }
        else if (it < NI_GU + NI_EV) { if (!I8_EV) continue; const int r = it - NI_GU, nblk = EVEN_IN / 32; quant_item(in[I_EVWIN], EVEN_IN, (r / nblk) * 64, (r % nblk) * 32, (r % nblk) * 32, CM + CW_CMAX_EV, (float*)(ws + WS_CS2), ws + WS_WEVIN, scr, lane); }
        else { if (!I8_OD) continue; const int r = it - NI_GU - NI_EV, nblk = ODD_IN / 32; quant_item(in[I_ODWIN], ODD_IN, (r / nblk) * 64, (r % nblk) * 32, (r % nblk) * 32, CM + CW_CMAX_OD, (float*)(ws + WS_CS2) + EVEN_IN, ws + WS_WODIN, scr, lane); }
    }
}
constexpr int QP_RS = 4112;
__device__ __forceinline__ const float* qp_src(const float* const* in, int unit, int kb, int lane, int& N) {
    if (unit >= 8 * 176) { N = EVEN_IN; return in[I_EVWIN] + (size_t)kb * EVEN_IN + (unit - 8 * 176) * 32 + (lane & 31); }
    const int mm = unit / 176, nb = unit % 176; N = DFF; return ((mm & 1) == 0 ? in[I_WG] : in[I_WU]) + (size_t)(mm >> 1) * DM * DFF + (size_t)kb * DFF + nb * 32 + (lane & 31);
}
__device__ __forceinline__ void p1_quant_gateup(Frame& F, int ubeg, int uend, int rank, int nranks) {
    const float* const* in = F.in; unsigned char* ws = F.ws; const int lane = F.lane, tid = F.tid, w = F.wave;
    LAS unsigned char* L = F.lds; LAS float* wm = (LAS float*)(F.lds + 32 * QP_RS);
    const int NU = uend;
    const int kb = w * 256 + (lane >> 5);
    float pre[32];
    if (ubeg + rank < NU) { int N; const float* W = qp_src(in, ubeg + rank, kb, lane, N);
#pragma unroll
        for (int i = 0; i < 32; ++i) pre[i] = __builtin_nontemporal_load(W + (size_t)(2 * i) * N); }
    for (int unit = ubeg + rank; unit < NU; unit += nranks) {
        const bool ev = unit >= 8 * 176; const int mm = unit / 176, nb = ev ? unit - 8 * 176 : unit % 176, mat = mm & 1, lab = mm >> 1, n0 = nb * 32;
        int N; const float* W = qp_src(in, unit, kb, lane, N);
        __syncthreads();
        float mx = 0.f; LAS unsigned char* lw = L + (lane & 31) * QP_RS + 2 * kb;
#pragma unroll
        for (int i = 0; i < 32; ++i) { const unsigned hb = f2bf(pre[i]); mx = fmaxf(mx, fabsf(bf2f(hb))); *(LAS unsigned short*)(lw + 4 * i) = (unsigned short)hb; }
#pragma unroll 32
        for (int i = 32; i < 128; ++i) { const float v = __builtin_nontemporal_load(W + (size_t)(2 * i) * N); const unsigned hb = f2bf(v); mx = fmaxf(mx, fabsf(bf2f(hb))); *(LAS unsigned short*)(lw + 4 * i) = (unsigned short)hb; }
        mx = fmaxf(mx, __shfl_xor(mx, 32));
        if (lane < 32) wm[w * 32 + lane] = mx;
        __syncthreads();
        if (unit + nranks < NU) { int Nn; const float* Wn = qp_src(in, unit + nranks, kb, lane, Nn);
#pragma unroll
            for (int i = 0; i < 32; ++i) pre[i] = __builtin_nontemporal_load(Wn + (size_t)(2 * i) * Nn); }
        unsigned char* WT = ev ? ws + WS_WEVIN : ws + WS_WGU + (size_t)lab * SZ_WGU8; float* cs = ev ? (float*)(ws + WS_CS2) : (float*)(ws + WS_CS) + lab * 2 * DFF;
        for (int idx = tid; idx < 32 * 256; idx += 512) { const int n = idx >> 8, kg = idx & 255;
            float cm = wm[n];
#pragma unroll
            for (int ww = 1; ww < 8; ++ww) cm = fmaxf(cm, wm[ww * 32 + n]);
            cm = fmaxf(cm, 1e-30f); const float isc = 127.0f / cm;
            const v4u q = *(const LAS v4u*)(L + n * QP_RS + 16 * kg);
            const unsigned qq[4] = {q.x, q.y, q.z, q.w}; unsigned o[2] = {0u, 0u};
#pragma unroll
            for (int e = 0; e < 4; ++e) {
                const unsigned a = __float_as_uint(fmaf(bf2f(qq[e] & 0xffffu), isc, 12582912.0f)) & 255u, b = __float_as_uint(fmaf(bf2f(qq[e] >> 16), isc, 12582912.0f)) & 255u;
                o[e >> 1] |= (a | (b << 8)) << (16 * (e & 1)); }
            const int nn = n0 + n, drow = ev ? nn : (nn >> 7) * 256 + (nn & 127) + mat * 128;
            *(v2u*)(WT + (size_t)drow * DM + 8 * kg) = (v2u){o[0], o[1]};
            if (kg == 0) cs[drow] = cm * (1.0f / 127.0f); }
    }
    __syncthreads();
}
__device__ __forceinline__ void tail_quant(Frame& F, int lo, int hi, int dbeg, int dend) {
    if (lo >= hi) { lo = 0; hi = F.G; }
    const int c = blockIdx.x; if (c >= lo && c < hi) p1_quant_gateup(F, 352 + dbeg, 352 + dend, c - lo, hi - lo);
}
#define PN_C(j) (8 * (F.lane + 64 * ((j) >> 1)) + 4 * ((j) & 1))
__device__ __forceinline__ void pn_load16(const bf16* p, int lane, v4u (&q)[4]) {
#pragma unroll
    for (int jj = 0; jj < 4; ++jj) q[jj] = *(const v4u*)(p + 8 * (lane + 64 * jj));
}
__device__ __forceinline__ void pn_unpack16(const v4u (&q)[4], f32x4 (&v)[8]) {
#pragma unroll
    for (int jj = 0; jj < 4; ++jj) { v[2 * jj] = (f32x4){bf2f(q[jj].x & 0xffffu), bf2f(q[jj].x >> 16), bf2f(q[jj].y & 0xffffu), bf2f(q[jj].y >> 16)}; v[2 * jj + 1] = (f32x4){bf2f(q[jj].z & 0xffffu), bf2f(q[jj].z >> 16), bf2f(q[jj].w & 0xffffu), bf2f(q[jj].w >> 16)}; }
}
__device__ __forceinline__ void prenorm_phase(Frame& F, const float* xl, const float* xc, int rows, int layer, int sub, int fold_part = 0, const bf16* xl16 = nullptr) {
    const float* g = F.in[I_NORMG] + (layer * 3 + sub) * DM; const float* MV = (const float*)(F.ws + WS_MODV) + (size_t)layer * 9 * NMODC; bf16* H = (bf16*)(F.ws + WS_H);
    const int rows16 = xl16 != nullptr ? min(rows, ML) : 0; v4u qn[4];
    if (F.gw < rows16) pn_load16(xl16 + (size_t)F.gw * DM, F.lane, qn);
    for (int row = F.gw; row < rows; row += F.ngw) {
        const float* xr = row < ML ? xl + (size_t)row * DM : xc + (size_t)(row - ML) * DM; const int r = row < ML ? row / SEQ : 8;
        const float* sh = MV + (size_t)r * NMODC + (3 * sub) * DM; const float* sc = sh + DM;
        f32x4 v[8]; float s = 0.f;
        if (row < rows16) { pn_unpack16(qn, v); if (row + F.ngw < rows16) pn_load16(xl16 + (size_t)(row + F.ngw) * DM, F.lane, qn); }
        else {
#pragma unroll
            for (int j = 0; j < 8; ++j) v[j] = *(const f32x4*)(xr + PN_C(j)); }
#pragma unroll
        for (int j = 0; j < 8; ++j) s += (v[j].x * v[j].x + v[j].y * v[j].y) + (v[j].z * v[j].z + v[j].w * v[j].w);
        if (fold_part && row >= ML) { const float* pp = (const float*)(F.ws + WS_PART) + (size_t)(row - ML) * DM; s = 0.f; float* xo = (float*)(F.ws + WS_XS) + (size_t)row * DM;
#pragma unroll
            for (int j = 0; j < 8; ++j) { const int c = PN_C(j); { f32x4 ps = *(const f32x4*)(pp + c) + *(const f32x4*)(pp + (size_t)MC * DM + c); if (fold_part == 4) ps += *(const f32x4*)(pp + (size_t)2 * MC * DM + c) + *(const f32x4*)(pp + (size_t)3 * MC * DM + c); v[j] += ps; }
                s += (v[j].x * v[j].x + v[j].y * v[j].y) + (v[j].z * v[j].z + v[j].w * v[j].w); *(f32x4*)(xo + c) = v[j]; } }
        const float rstd = 1.0f / sqrtf(wave_sum(s) * (1.0f / DM) + EPS);
#pragma unroll
        for (int j = 0; j < 8; ++j) { const int c = PN_C(j); const f32x4 gg = *(const f32x4*)(g + c), ss = *(const f32x4*)(sc + c), hh = *(const f32x4*)(sh + c);
            v[j] = (v[j] * rstd * gg) * (ss + 1.0f) + hh; }
#pragma unroll
        for (int jj = 0; jj < 4; ++jj) { const f32x4 y0 = v[2 * jj], y1 = v[2 * jj + 1]; *(v4u*)(H + (size_t)row * DM + 8 * (F.lane + 64 * jj)) = (v4u){pk2(y0.x, y0.y), pk2(y0.z, y0.w), pk2(y1.x, y1.y), pk2(y1.z, y1.w)}; }
    }
}
__device__ __forceinline__ void prenorm8_phase(Frame& F, const float* xl, const float* xc, int rows, int layer, int sub, bool copy_ctx = false, int fold_part = 0, const bf16* xl16 = nullptr) {
    const float* g = F.in[I_NORMG] + (layer * 3 + sub) * DM; const float* MV = (const float*)(F.ws + WS_MODV) + (size_t)layer * 9 * NMODC; unsigned char* H8 = (unsigned char*)(F.ws + WS_H); float* RS = (float*)(F.ws + WS_RS);
    const int rows16 = xl16 != nullptr ? min(rows, ML) : 0; v4u qn[4]; f32x4 fnx[8]; const bool pf32 = xl16 == nullptr;
    if (F.gw < rows16) pn_load16(xl16 + (size_t)F.gw * DM, F.lane, qn);
    if (pf32 && F.gw < rows) { const float* x0 = F.gw < ML ? xl + (size_t)F.gw * DM : xc + (size_t)(F.gw - ML) * DM;
#pragma unroll
        for (int j = 0; j < 8; ++j) fnx[j] = *(const f32x4*)(x0 + PN_C(j)); }
    for (int row = F.gw; row < rows; row += F.ngw) {
        const float* xr = row < ML ? xl + (size_t)row * DM : xc + (size_t)(row - ML) * DM; const int r = row < ML ? row / SEQ : 8;
        const float* sh = MV + (size_t)r * NMODC + (3 * sub) * DM; const float* sc = sh + DM;
        f32x4 v[8]; float s = 0.f;
        if (row < rows16) { pn_unpack16(qn, v); if (row + F.ngw < rows16) pn_load16(xl16 + (size_t)(row + F.ngw) * DM, F.lane, qn); }
        else if (pf32) {
#pragma unroll
            for (int j = 0; j < 8; ++j) v[j] = fnx[j];
            const int nr = row + F.ngw; if (nr < rows) { const float* xn = nr < ML ? xl + (size_t)nr * DM : xc + (size_t)(nr - ML) * DM;
#pragma unroll
                for (int j = 0; j < 8; ++j) fnx[j] = *(const f32x4*)(xn + PN_C(j)); } }
        else {
#pragma unroll
            for (int j = 0; j < 8; ++j) v[j] = *(const f32x4*)(xr + PN_C(j)); }
#pragma unroll
        for (int j = 0; j < 8; ++j) s += (v[j].x * v[j].x + v[j].y * v[j].y) + (v[j].z * v[j].z + v[j].w * v[j].w);
        if (fold_part && row >= ML) { const float* pp = (const float*)(F.ws + WS_PART) + (size_t)(row - ML) * DM; s = 0.f;
#pragma unroll
            for (int j = 0; j < 8; ++j) { const int c = PN_C(j); { f32x4 ps = *(const f32x4*)(pp + c) + *(const f32x4*)(pp + (size_t)MC * DM + c); if (fold_part == 4) ps += *(const f32x4*)(pp + (size_t)2 * MC * DM + c) + *(const f32x4*)(pp + (size_t)3 * MC * DM + c); v[j] += ps; }
                s += (v[j].x * v[j].x + v[j].y * v[j].y) + (v[j].z * v[j].z + v[j].w * v[j].w); } }
        if ((copy_ctx || fold_part) && row >= ML) { float* xo = (float*)(F.ws + WS_XS) + (size_t)row * DM;
#pragma unroll
            for (int j = 0; j < 8; ++j) *(f32x4*)(xo + PN_C(j)) = v[j]; }
        const float rstd = 1.0f / sqrtf(wave_sum(s) * (1.0f / DM) + EPS); float mx = 1e-20f;
#pragma unroll
        for (int j = 0; j < 8; ++j) { const int c = PN_C(j); const f32x4 gg = *(const f32x4*)(g + c), ss = *(const f32x4*)(sc + c), hh = *(const f32x4*)(sh + c);
            v[j] = (v[j] * rstd * gg) * (ss + 1.0f) + hh; mx = fmaxf(mx, fmaxf(fmaxf(fabsf(v[j].x), fabsf(v[j].y)), fmaxf(fabsf(v[j].z), fabsf(v[j].w)))); }
        mx = wave_max(mx); const float isc = 127.0f / mx;
        if (F.lane == 0) RS[row] = mx * (1.0f / 127.0f);
#pragma unroll
        for (int jj = 0; jj < 4; ++jj) { unsigned w2[2];
#pragma unroll
            for (int e = 0; e < 2; ++e) { const f32x4 y = v[2 * jj + e]; const int q0 = (int)rintf(y.x * isc), q1 = (int)rintf(y.y * isc), q2 = (int)rintf(y.z * isc), q3 = (int)rintf(y.w * isc);
                w2[e] = (unsigned)(q0 & 255) | ((unsigned)(q1 & 255) << 8) | ((unsigned)(q2 & 255) << 16) | ((unsigned)(q3 & 255) << 24); }
            *(v2u*)(H8 + (size_t)row * DM + 8 * (F.lane + 64 * jj)) = (v2u){w2[0], w2[1]}; }
    }
}
__device__ __forceinline__ void final_norm_phase(Frame& F) {
    const bf16* X = (const bf16*)(F.ws + WS_XS); const float* g = F.in[I_FINALG]; v4u qn[4];
    if (F.gw < ML) pn_load16(X + (size_t)F.gw * DM, F.lane, qn);
    for (int row = F.gw; row < ML; row += F.ngw) {
        f32x4 v[8]; float s = 0.f; pn_unpack16(qn, v); if (row + F.ngw < ML) pn_load16(X + (size_t)(row + F.ngw) * DM, F.lane, qn);
#pragma unroll
        for (int j = 0; j < 8; ++j) s += (v[j].x * v[j].x + v[j].y * v[j].y) + (v[j].z * v[j].z + v[j].w * v[j].w);
        const float rstd = 1.0f / sqrtf(wave_sum(s) * (1.0f / DM) + EPS);
#pragma unroll
        for (int j = 0; j < 8; ++j) { const int c = PN_C(j); *(f32x4*)(F.out + (size_t)row * DM + c) = v[j] * rstd * *(const f32x4*)(g + c); }
    }
}
__device__ __forceinline__ int s5_row(int i, int dir, int b) { if (i < CTXL) { const int j = dir ? CTXL - 1 - i : i; return ML + b * CTXL + j; } const int t = i - CTXL; return b * SEQ + (dir ? SEQ - 1 - t : t); }
typedef short bf16x8v __attribute__((ext_vector_type(8)));
constexpr int NTOK = SEQ + CTXL;
__device__ __forceinline__ void vt_transpose_phase(Frame& F) {
    const bf16* P = (const bf16*)(F.ws + WS_BIG); bf16* VT = (bf16*)(F.ws + WS_VT); const int lane = F.lane;
    LAS unsigned* tile = (LAS unsigned*)(F.lds + F.wave * 16384);
    for (int item = F.gw; item < 64 * 2 * 36; item += F.ngw) {
        const int tb = item % 36, db = (item / 36) & 1, bh = item / 72, b = bh >> 3, h = bh & 7;
        const int row0 = tb < 32 ? b * SEQ + tb * 64 : ML + b * CTXL + (tb - 32) * 64;
        const bf16* src = P + (size_t)row0 * EVEN_LD + 3072 + h * 128 + db * 64 + 8 * (lane & 7);
#pragma unroll
        for (int i = 0; i < 8; ++i) { const int tl = (lane >> 3) + 8 * i; const v4u v = *(const v4u*)(src + (size_t)tl * EVEN_LD);
            LAS unsigned* tp = tile + tl * 33 + 4 * (lane & 7); tp[0] = v.x; tp[1] = v.y; tp[2] = v.z; tp[3] = v.w; }
        asm volatile("s_waitcnt lgkmcnt(0)" ::: "memory");
        bf16* dst = VT + ((size_t)bh * 128 + db * 64) * NTOK + tb * 64 + lane;
#pragma unroll 8
        for (int dp = 0; dp < 32; ++dp) { const unsigned w = tile[lane * 33 + dp]; dst[(size_t)(2 * dp) * NTOK] = (bf16)(w & 0xffffu); dst[(size_t)(2 * dp + 1) * NTOK] = (bf16)(w >> 16); }
        asm volatile("s_waitcnt lgkmcnt(0)" ::: "memory");
    }
}
constexpr int NA_KS = 272, NA_VS = 528, NA_VOFF = 256 * NA_KS;
template <bool LOCAL, bool CL>
__device__ __forceinline__ void na_item(const bf16* P, const bf16* VT, bf16* MIX, const float* rpb, int b, int h, int qrow0, int r, int c, int lane, const LAS unsigned char* cl) {
    constexpr int NT = LOCAL ? 32 : 16, NLT = LOCAL ? 16 : 0;
    const int i = lane & 15, g = lane >> 4;
    const int rs = min(max(r - 4, 0), 24), w0 = (c == 0) ? 0 : (c == 1) ? 8 : (c == 2) ? 24 : 32;
    bf16x8v qf[4];
    { const bf16* qp = P + (size_t)(qrow0 + i) * EVEN_LD + 1024 + h * 128 + 8 * g;
#pragma unroll
      for (int ks = 0; ks < 4; ++ks) qf[ks] = *(const bf16x8v*)(qp + 32 * ks); }
    f32x4 S[NT];
    const int ik = 8 * (i >> 2) + (i & 3);
    unsigned klo = (unsigned)(ik * NA_KS + 16 * g), vlo = (unsigned)(NA_VOFF + i * NA_VS + 16 * g); asm volatile("" : "+v"(klo), "+v"(vlo));
    const LAS unsigned char* klb = cl + klo; const LAS unsigned char* vlb = cl + vlo;
#pragma unroll
    for (int T0 = 0; T0 < NT; T0 += 2) {
        bf16x8v kf[2][4];
#pragma unroll
        for (int e = 0; e < 2; ++e) { const int T = T0 + e;
            if (CL && T >= NLT) { const LAS unsigned char* kl = klb + (32 * ((T - NLT) >> 1) + 4 * e) * NA_KS;
#pragma unroll
                for (int ks = 0; ks < 4; ++ks) kf[e][ks] = *(const LAS bf16x8v*)(kl + 64 * ks); }
            else { size_t krow;
                if (T < NLT) krow = (size_t)b * SEQ + (rs + (T >> 1)) * 64 + w0 + ik + 4 * e; else krow = (size_t)ML + b * CTXL + 32 * ((T - NLT) >> 1) + ik + 4 * e;
                const bf16* kp = P + krow * EVEN_LD + 2048 + h * 128 + 8 * g;
#pragma unroll
                for (int ks = 0; ks < 4; ++ks) kf[e][ks] = *(const bf16x8v*)(kp + 32 * ks); } }
#pragma unroll
        for (int e = 0; e < 2; ++e) { f32x4 acc = (f32x4){0.f, 0.f, 0.f, 0.f};
#pragma unroll
            for (int ks = 0; ks < 4; ++ks) acc = __builtin_amdgcn_mfma_f32_16x16x32_bf16(kf[e][ks], qf[ks], acc, 0, 0, 0);
            S[T0 + e] = acc; }
    }
    const float scale = 0.08838834764831845f; float mx = -3.0e38f;
    const int qc = 16 * c + i, cs = min(max(qc - 8, 0), 48);
#pragma unroll
    for (int T = 0; T < NT; ++T) {
        if (T < NLT) { const float* rp = rpb + (h * 15 + (rs + (T >> 1) - r + 7)) * 31;
#pragma unroll
            for (int q = 0; q < 4; ++q) { const int col = w0 + 8 * g + 4 * (T & 1) + q; const bool ok = (col >= cs) && (col < cs + 16); const int dc = min(max(col - qc + 15, 0), 30);
                S[T][q] = ok ? S[T][q] * scale + rp[dc] : -3.0e38f; } }
        else S[T] = S[T] * scale;
        mx = fmaxf(mx, fmaxf(fmaxf(S[T][0], S[T][1]), fmaxf(S[T][2], S[T][3]))); }
    mx = fmaxf(mx, __shfl_xor(mx, 16)); mx = fmaxf(mx, __shfl_xor(mx, 32));
    float sum = 0.f; bf16x8v pf[NT / 2];
#pragma unroll
    for (int s = 0; s < NT / 2; ++s) { float p[8];
#pragma unroll
        for (int q = 0; q < 4; ++q) { p[q] = __expf(S[2 * s][q] - mx); p[4 + q] = __expf(S[2 * s + 1][q] - mx); }
#pragma unroll
        for (int q = 0; q < 8; ++q) sum += p[q];
        v4u w; w.x = pk2(p[0], p[1]); w.y = pk2(p[2], p[3]); w.z = pk2(p[4], p[5]); w.w = pk2(p[6], p[7]);
        pf[s] = __builtin_bit_cast(bf16x8v, w); }
    sum += __shfl_xor(sum, 16); sum += __shfl_xor(sum, 32);
    const float inv = 1.0f / sum;
    const unsigned voff = (unsigned)((((b * 8 + h) * 128 + i) * NTOK + 8 * g) * 2);
#pragma unroll
    for (int dt = 0; dt < 8; ++dt) {
        f32x4 o = (f32x4){0.f, 0.f, 0.f, 0.f};
#pragma unroll
        for (int s0 = 0; s0 < NT / 2; s0 += 8) {
            bf16x8v vf[8];
#pragma unroll
            for (int s1 = 0; s1 < 8; ++s1) { const int s = s0 + s1;
                if (CL && s >= NLT / 2) vf[s1] = *(const LAS bf16x8v*)(vlb + (16 * dt) * NA_VS + 64 * (s - NLT / 2));
                else { const int tok = (s < NLT / 2) ? (rs + s) * 64 + w0 : SEQ + 32 * (s - NLT / 2); vf[s1] = *(const bf16x8v*)((const char*)VT + (voff + (unsigned)(((16 * dt) * NTOK + tok) * 2))); } }
#pragma unroll
            for (int s1 = 0; s1 < 8; ++s1) o = __builtin_amdgcn_mfma_f32_16x16x32_bf16(vf[s1], pf[s0 + s1], o, 0, 0, 0);
        }
        v2u w; w.x = pk2(o[0] * inv, o[1] * inv); w.y = pk2(o[2] * inv, o[3] * inv);
        *(v2u*)(MIX + (size_t)(qrow0 + i) * DM + 1024 + h * 128 + 16 * dt + 4 * g) = w;
    }
}
__device__ __forceinline__ void na_mfma_phase(Frame& F) {
    const bf16* P = (const bf16*)(F.ws + WS_BIG); const bf16* VT = (const bf16*)(F.ws + WS_VT); bf16* MIX = (bf16*)(F.ws + WS_MIX); const float* rpb = F.in[I_RPB];
    for (int unit = blockIdx.x; unit < 64 * 4; unit += F.G) {
        const int bh = unit >> 2, q = unit & 3, b = bh >> 3, h = bh & 7;
        __syncthreads();
        for (int t = F.tid; t < 4096; t += 512) { const int key = t >> 4, ch = t & 15;
            *(LAS v4u*)(F.lds + key * NA_KS + ch * 16) = *(const v4u*)(P + (size_t)(ML + b * CTXL + key) * EVEN_LD + 2048 + h * 128 + ch * 8); }
        for (int t = F.tid; t < 4096; t += 512) { const int d = t >> 5, ch = t & 31;
            *(LAS v4u*)(F.lds + NA_VOFF + d * NA_VS + ch * 16) = *(const v4u*)(VT + ((size_t)bh * 128 + d) * NTOK + SEQ + ch * 8); }
        __syncthreads();
        for (int n = F.wave; n < 36; n += NWAVES) {
            if (n < 32) { const int c = n & 3, r = 8 * q + (n >> 2); na_item<true, true>(P, VT, MIX, rpb, b, h, b * SEQ + r * 64 + 16 * c, r, c, F.lane, F.lds); }
            else na_item<false, true>(P, VT, MIX, rpb, b, h, ML + b * CTXL + 16 * (4 * q + n - 32), 0, 0, F.lane, F.lds); }
    }
    __syncthreads();
}
constexpr int S5COLS = NB * 36;
__device__ __forceinline__ int s5_colrow(int col) { const int b = col / 36, ch = col % 36; return ch < 4 ? ML + b * CTXL + 64 * ch : b * SEQ + 64 * (ch - 4); }
__device__ __forceinline__ void s5_disc(const float* const* in, int dir, int g, int p, float& are_dt, float& aim_dt, float& cr, float& ci) {
    const int gp = (dir * 64 + g) * 64 + p; const float are = in[I_S5ARE][gp], aim = in[I_S5AIM][gp], dt = expf(in[I_S5LOGDT][dir * 64 + g]);
    const float er = expf(are * dt); float sn, cs; sincosf(aim * dt, &sn, &cs);
    const float nr = er * cs - 1.0f, ni = er * sn, den = are * are + aim * aim;
    cr = (nr * are + ni * aim) / den; ci = (ni * are - nr * aim) / den; are_dt = are * dt; aim_dt = aim * dt;
}
__device__ __forceinline__ void s5_prep_items(Frame& F) {
    const float* const* in = F.in; const int lane = F.lane;
    LAS float* Bl = (LAS float*)(F.lds + F.wave * 16384); LAS float* Zl = Bl + 2048;
    float* KF = (float*)(F.ws + WS_S5KF); bf16* W = (bf16*)(F.ws + WS_S5W); bf16* V = (bf16*)(F.ws + WS_S5V);
    for (int item = F.gw; item < 64 * 2 * 32; item += F.ngw) {
        const int nb = item & 31, dir = (item >> 5) & 1, g = item >> 6, p = lane, gp = (dir * 64 + g) * 64 + p;
        float ared, aimd, cr, ci; s5_disc(in, dir, g, p, ared, aimd, cr, ci);
        float Br[16], Bi[16], Cr[16], Ci[16];
#pragma unroll
        for (int h = 0; h < 16; ++h) { const float br = in[I_S5BRE][(size_t)gp * 16 + h], bi = in[I_S5BIM][(size_t)gp * 16 + h]; Br[h] = cr * br - ci * bi; Bi[h] = cr * bi + ci * br;
            Cr[h] = in[I_S5CRE][((size_t)(dir * 64 + g) * 16 + h) * 64 + p]; Ci[h] = in[I_S5CIM][((size_t)(dir * 64 + g) * 16 + h) * 64 + p];
            Bl[(p * 16 + h) * 2] = Br[h]; Bl[(p * 16 + h) * 2 + 1] = Bi[h]; }
        float pr[3], pi[3];
#pragma unroll
        for (int k = 0; k < 3; ++k) { const float e = (float)(2 * nb + k); const float er = expf(ared * e); float sn, cs; sincosf(aimd * e, &sn, &cs); pr[k] = er * cs; pi[k] = er * sn; }
#pragma unroll
        for (int k = 0; k < 2; ++k) {
            const int e = 2 * nb + k;
#pragma unroll
            for (int h = 0; h < 16; ++h) { Zl[(p * 16 + h) * 2] = Cr[h] * pr[k] - Ci[h] * pi[k]; Zl[(p * 16 + h) * 2 + 1] = Cr[h] * pi[k] + Ci[h] * pr[k]; }
            asm volatile("s_waitcnt lgkmcnt(0)" ::: "memory");
            { const int h = lane >> 2, hp0 = 4 * (lane & 3); float a4[4] = {0.f, 0.f, 0.f, 0.f};
              for (int pp = 0; pp < 64; ++pp) { const float zr = Zl[(pp * 16 + h) * 2], zi = Zl[(pp * 16 + h) * 2 + 1];
#pragma unroll
                  for (int q = 0; q < 4; ++q) a4[q] += zr * Bl[(pp * 16 + hp0 + q) * 2] - zi * Bl[(pp * 16 + hp0 + q) * 2 + 1]; }
              *(f32x4*)(KF + ((size_t)((g * 2 + dir) * 64 + e)) * 256 + h * 16 + hp0) = (f32x4){a4[0], a4[1], a4[2], a4[3]}; }
            asm volatile("s_waitcnt lgkmcnt(0)" ::: "memory");
            { const int s = dir ? e : 63 - e; unsigned wr[8], wi[8];
#pragma unroll
              for (int q = 0; q < 8; ++q) { const float r0 = pr[k] * Br[2 * q] - pi[k] * Bi[2 * q], r1 = pr[k] * Br[2 * q + 1] - pi[k] * Bi[2 * q + 1];
                  const float i0 = pr[k] * Bi[2 * q] + pi[k] * Br[2 * q], i1 = pr[k] * Bi[2 * q + 1] + pi[k] * Br[2 * q + 1]; wr[q] = pk2(r0, r1); wi[q] = pk2(i0, i1); }
              bf16* wp = W + ((size_t)g * 256 + dir * 128 + 2 * p) * 1024 + s * 16;
              *(v4u*)wp = (v4u){wr[0], wr[1], wr[2], wr[3]}; *(v4u*)(wp + 8) = (v4u){wr[4], wr[5], wr[6], wr[7]};
              *(v4u*)(wp + 1024) = (v4u){wi[0], wi[1], wi[2], wi[3]}; *(v4u*)(wp + 1024 + 8) = (v4u){wi[4], wi[5], wi[6], wi[7]}; }
            { const int l = dir ? 63 - e : e;
#pragma unroll
              for (int h = 0; h < 16; ++h) { const float zr = Cr[h] * pr[k + 1] - Ci[h] * pi[k + 1], zi = Cr[h] * pi[k + 1] + Ci[h] * pr[k + 1];
                  *(unsigned*)(V + ((size_t)g * 1024 + l * 16 + h) * 256 + dir * 128 + 2 * p) = pk2(zr, -zi); } }
        }
    }
}
__device__ __forceinline__ void s5_statein_phase(Frame& F) {
    const bf16* P = (const bf16*)(F.ws + WS_BIG); const bf16* W = (const bf16*)(F.ws + WS_S5W); float* SL = (float*)(F.ws + WS_S5SLOC);
    const int i = F.lane & 15, gq = F.lane >> 4;
    for (int item = F.gw; item < 64 * 9 * 8; item += F.ngw) {
        const int me = item & 7, cb = (item >> 3) % 9, g = item / 72;
        const bf16* bp[2]; const bf16* ap[2];
#pragma unroll
        for (int ct = 0; ct < 2; ++ct) bp[ct] = P + (size_t)(s5_colrow(cb * 32 + 16 * ct + i) + (gq >> 1)) * EVEN_LD + g * 16 + 8 * (gq & 1);
#pragma unroll
        for (int mt = 0; mt < 2; ++mt) ap[mt] = W + ((size_t)g * 256 + 32 * me + 16 * mt + i) * 1024 + 8 * gq;
        f32x4 acc[2][2];
#pragma unroll
        for (int mt = 0; mt < 2; ++mt)
#pragma unroll
            for (int ct = 0; ct < 2; ++ct) acc[mt][ct] = (f32x4){0.f, 0.f, 0.f, 0.f};
#pragma unroll 8
        for (int ks = 0; ks < 32; ++ks) {
            bf16x8v bfr[2], afr[2];
#pragma unroll
            for (int ct = 0; ct < 2; ++ct) bfr[ct] = *(const bf16x8v*)(bp[ct] + (size_t)(2 * ks) * EVEN_LD);
#pragma unroll
            for (int mt = 0; mt < 2; ++mt) afr[mt] = *(const bf16x8v*)(ap[mt] + 32 * ks);
#pragma unroll
            for (int mt = 0; mt < 2; ++mt)
#pragma unroll
                for (int ct = 0; ct < 2; ++ct) acc[mt][ct] = __builtin_amdgcn_mfma_f32_16x16x32_bf16(afr[mt], bfr[ct], acc[mt][ct], 0, 0, 0);
        }
#pragma unroll
        for (int mt = 0; mt < 2; ++mt)
#pragma unroll
            for (int ct = 0; ct < 2; ++ct) *(f32x4*)(SL + ((size_t)g * S5COLS + cb * 32 + 16 * ct + i) * 256 + 32 * me + 16 * mt + 4 * gq) = acc[mt][ct];
    }
}
__device__ __forceinline__ void s5_chain_phase(Frame& F) {
    const float* SL = (const float*)(F.ws + WS_S5SLOC); bf16* SIN = (bf16*)(F.ws + WS_S5SIN);
    for (int idx = blockIdx.x * 512 + F.tid; idx < NB * 64 * 2 * 64; idx += F.G * 512) {
        const int p = idx & 63, dir = (idx >> 6) & 1, g = (idx >> 7) & 63, b = idx >> 13;
        float ared, aimd, cr, ci; s5_disc(F.in, dir, g, p, ared, aimd, cr, ci);
        const float er = expf(ared * 64.0f); float sn, cs; sincosf(aimd * 64.0f, &sn, &cs); const float qr = er * cs, qi = er * sn;
        const size_t base = ((size_t)g * S5COLS + b * 36) * 256 + dir * 128 + 2 * p;
        float sr = 0.f, si = 0.f;
#pragma unroll 6
        for (int j = 0; j < 36; ++j) {
            const int k = dir ? (j < 4 ? 3 - j : 39 - j) : j;
            const float2 v = *(const float2*)(SL + base + (size_t)k * 256); const float xr = v.x, xi = v.y;
            *(unsigned*)(SIN + base + (size_t)k * 256) = pk2(sr, si);
            const float nr = qr * sr - qi * si + xr, ni = qr * si + qi * sr + xi; sr = nr; si = ni; }
    }
}
constexpr int KT_ROWB = 48;
__device__ __forceinline__ float gelu_tanh2(float x) { const float u = 0.7978845608028654f * (x + 0.044715f * x * x * x); const float e = __expf(2.0f * u); return x * (1.0f - 1.0f / (e + 1.0f)); }
constexpr int S5_UOFF = 127 * 16 * KT_ROWB, S5_US = 2064;
__device__ __forceinline__ void s5_out_phase(Frame& F) {
    const bf16* P = (const bf16*)(F.ws + WS_BIG); const float* KF = (const float*)(F.ws + WS_S5KF); const bf16* V = (const bf16*)(F.ws + WS_S5V); const bf16* SIN = (const bf16*)(F.ws + WS_S5SIN);
    bf16* G = (bf16*)(F.ws + WS_G); const float* dd = F.in[I_S5D];
    const int i = F.lane & 15, gq = F.lane >> 4, w = F.wave;
    for (int unit = blockIdx.x; unit < 64 * 18; unit += F.G) {
        const int g = unit / 18, cb = unit % 18;
        v4u ur[4];
#pragma unroll
        for (int j = 0; j < 4; ++j) { const int id = F.tid + 512 * j, cl = id >> 7, sh = id & 127; ur[j] = *(const v4u*)(P + (size_t)(s5_colrow(cb * 16 + cl) + (sh >> 1)) * EVEN_LD + g * 16 + 8 * (sh & 1)); }
        __syncthreads();
        for (int idx = F.tid; idx < 127 * 32; idx += 512) { const int nn = idx >> 5, h = (idx >> 1) & 15, half = idx & 1; float v[8];
            if (nn == 63) { const float* k0 = KF + ((size_t)(g * 2 + 0) * 64) * 256 + h * 16 + 8 * half; const float* k1 = KF + ((size_t)(g * 2 + 1) * 64) * 256 + h * 16 + 8 * half;
#pragma unroll
                for (int j = 0; j < 8; ++j) v[j] = k0[j] + k1[j] + ((8 * half + j) == h ? dd[g * 16 + h] : 0.f); }
            else { const float* k0 = nn > 63 ? KF + ((size_t)(g * 2 + 0) * 64 + (nn - 63)) * 256 + h * 16 + 8 * half : KF + ((size_t)(g * 2 + 1) * 64 + (63 - nn)) * 256 + h * 16 + 8 * half;
#pragma unroll
                for (int j = 0; j < 8; ++j) v[j] = k0[j]; }
            *(LAS v4u*)(F.lds + (nn * 16 + h) * KT_ROWB + half * 16) = (v4u){pk2(v[0], v[1]), pk2(v[2], v[3]), pk2(v[4], v[5]), pk2(v[6], v[7])}; }
#pragma unroll
        for (int j = 0; j < 4; ++j) { const int id = F.tid + 512 * j, cl = id >> 7, sh = id & 127; *(LAS v4u*)(F.lds + S5_UOFF + cl * S5_US + sh * 16) = ur[j]; }
        __syncthreads();
        const int col = cb * 16 + i, rowbase = s5_colrow(col);
        f32x4 acc[8];
#pragma unroll
        for (int lt = 0; lt < 8; ++lt) acc[lt] = (f32x4){0.f, 0.f, 0.f, 0.f};
        unsigned kto = (unsigned)(((8 * w - (gq >> 1) + 63) * 16 + i) * KT_ROWB + (gq & 1) * 16), uo = (unsigned)(S5_UOFF + i * S5_US + gq * 16); asm volatile("" : "+v"(kto), "+v"(uo));
        const LAS unsigned char* kt = F.lds + kto;
        const LAS unsigned char* ub = F.lds + uo;
        bf16x8v fr[8];
#pragma unroll
        for (int d = 0; d < 8; ++d) fr[d] = *(const LAS bf16x8v*)(kt + d * (16 * KT_ROWB));
#pragma unroll
        for (int ks = 0; ks < 32; ++ks) {
            if (ks > 0) { fr[(8 - 2 * (ks & 3)) & 7] = *(const LAS bf16x8v*)(kt + (-2 * ks) * (16 * KT_ROWB)); fr[(9 - 2 * (ks & 3)) & 7] = *(const LAS bf16x8v*)(kt + (1 - 2 * ks) * (16 * KT_ROWB)); }
            const bf16x8v bfr = *(const LAS bf16x8v*)(ub + 64 * ks);
#pragma unroll
            for (int lt = 0; lt < 8; ++lt) acc[lt] = __builtin_amdgcn_mfma_f32_16x16x32_bf16(fr[(lt - 2 * ks) & 7], bfr, acc[lt], 0, 0, 0);
        }
        const bf16* sp = SIN + ((size_t)g * S5COLS + col) * 256 + 8 * gq; const bf16* vp = V + ((size_t)g * 1024 + (8 * w) * 16 + i) * 256 + 8 * gq;
#pragma unroll 2
        for (int k2 = 0; k2 < 8; ++k2) {
            const bf16x8v bf2 = *(const bf16x8v*)(sp + 32 * k2);
#pragma unroll
            for (int lt = 0; lt < 8; ++lt) { const bf16x8v afr = *(const bf16x8v*)(vp + (size_t)lt * 16 * 256 + 32 * k2); acc[lt] = __builtin_amdgcn_mfma_f32_16x16x32_bf16(afr, bf2, acc[lt], 0, 0, 0); }
        }
#pragma unroll
        for (int lt = 0; lt < 8; ++lt) { v2u o; o.x = pk2(gelu_tanh2(acc[lt][0]), gelu_tanh2(acc[lt][1])); o.y = pk2(gelu_tanh2(acc[lt][2]), gelu_tanh2(acc[lt][3]));
            *(v2u*)(G + (size_t)(rowbase + 8 * w + lt) * 1024 + g * 16 + 4 * gq) = o; }
    }
    __syncthreads();
}
__device__ __forceinline__ void ssd_prep_phase(Frame& F) {
    const bf16* P1 = (const bf16*)(F.ws + WS_BIG); bf16* XBC = (bf16*)(F.ws + WS_XBC); const float* cw = F.in[I_SSDCW]; const float* cb = F.in[I_SSDCB];
    const int c0 = (F.tid & 255) * 8; float w0[8], w1[8], w2[8], bb[8];
#pragma unroll
    for (int j = 0; j < 8; ++j) { w0[j] = cw[c0 + j]; w1[j] = cw[2048 + c0 + j]; w2[j] = cw[4096 + c0 + j]; bb[j] = cb[c0 + j]; }
    for (int row0 = blockIdx.x * 8 + (F.tid >> 8); row0 < MT; row0 += F.G * 8) {
        v4u a[4], m[4], n[4]; const v4u z4 = (v4u){0u, 0u, 0u, 0u};
#pragma unroll
        for (int q = 0; q < 4; ++q) { const int row = row0 + 2 * q; int pos, len; if (row < ML) { pos = row & 2047; len = SEQ; } else { pos = (row - ML) & 255; len = CTXL; }
            const bf16* pr = P1 + (size_t)row * ODD_LD + 4096 + c0;
            a[q] = pos > 0 ? *(const v4u*)(pr - ODD_LD) : z4; m[q] = *(const v4u*)pr; n[q] = pos < len - 1 ? *(const v4u*)(pr + ODD_LD) : z4; }
#pragma unroll
        for (int q = 0; q < 4; ++q) { const int row = row0 + 2 * q; unsigned o[4];
#pragma unroll
            for (int j = 0; j < 4; ++j) {
                const float y0 = w0[2 * j] * bf2f(a[q][j] & 0xffffu) + w1[2 * j] * bf2f(m[q][j] & 0xffffu) + w2[2 * j] * bf2f(n[q][j] & 0xffffu) + bb[2 * j];
                const float y1 = w0[2 * j + 1] * bf2f(a[q][j] >> 16) + w1[2 * j + 1] * bf2f(m[q][j] >> 16) + w2[2 * j + 1] * bf2f(n[q][j] >> 16) + bb[2 * j + 1];
                o[j] = pk2(silu_f(y0), silu_f(y1)); }
            *(v4u*)(XBC + (size_t)row * XBC_LD + c0) = (v4u){o[0], o[1], o[2], o[3]}; }
    }
}
__device__ __forceinline__ float softplus_f(float x) { return x > 20.f ? x : log1pf(expf(x)); }
__device__ __forceinline__ void ssd_scan_phase(Frame& F) {
    const bf16* XBC = (const bf16*)(F.ws + WS_XBC); const float* DT = (const float*)(F.ws + WS_DT); bf16* YS = (bf16*)(F.ws + WS_YS);
    for (int item = blockIdx.x; item < NB * 16 * 2; item += F.G) {
        const int dir = item & 1, hd = (item >> 1) & 15, b = item >> 5, g = hd >> 2, p = F.tid >> 3, ns = F.tid & 7;
        const float dtb = F.in[I_SSDDTB][dir * 16 + hd], a = -expf(F.in[I_SSDALOG][dir * 16 + hd]);
        float S[16];
#pragma unroll
        for (int i = 0; i < 16; ++i) S[i] = 0.f;
        int row = s5_row(0, dir, b);
        float dtr = DT[(size_t)row * 32 + dir * 16 + hd]; unsigned xr = XBC[(size_t)row * XBC_LD + hd * 64 + p];
        v4u bq0 = *(const v4u*)(XBC + (size_t)row * XBC_LD + 1024 + g * 128 + ns * 16), bq1 = *(const v4u*)(XBC + (size_t)row * XBC_LD + 1024 + g * 128 + ns * 16 + 8);
        v4u cq0 = *(const v4u*)(XBC + (size_t)row * XBC_LD + 1536 + g * 128 + ns * 16), cq1 = *(const v4u*)(XBC + (size_t)row * XBC_LD + 1536 + g * 128 + ns * 16 + 8);
        for (int i = 0; i < CTXL + SEQ; ++i) {
            const int rown = s5_row(i + 1 < CTXL + SEQ ? i + 1 : i, dir, b);
            const float dtr_n = DT[(size_t)rown * 32 + dir * 16 + hd]; const unsigned xr_n = XBC[(size_t)rown * XBC_LD + hd * 64 + p];
            const v4u bn0 = *(const v4u*)(XBC + (size_t)rown * XBC_LD + 1024 + g * 128 + ns * 16), bn1 = *(const v4u*)(XBC + (size_t)rown * XBC_LD + 1024 + g * 128 + ns * 16 + 8);
            const v4u cn0 = *(const v4u*)(XBC + (size_t)rown * XBC_LD + 1536 + g * 128 + ns * 16), cn1 = *(const v4u*)(XBC + (size_t)rown * XBC_LD + 1536 + g * 128 + ns * 16 + 8);
            const float dt = softplus_f(dtr + dtb), dA = __expf(dt * a), dx = dt * bf2f(xr);
            float y = 0.f;
#pragma unroll
            for (int j = 0; j < 4; ++j) {
                S[2 * j] = S[2 * j] * dA + dx * bf2f(bq0[j] & 0xffffu); S[2 * j + 1] = S[2 * j + 1] * dA + dx * bf2f(bq0[j] >> 16);
                S[8 + 2 * j] = S[8 + 2 * j] * dA + dx * bf2f(bq1[j] & 0xffffu); S[8 + 2 * j + 1] = S[8 + 2 * j + 1] * dA + dx * bf2f(bq1[j] >> 16);
                y += S[2 * j] * bf2f(cq0[j] & 0xffffu) + S[2 * j + 1] * bf2f(cq0[j] >> 16) + S[8 + 2 * j] * bf2f(cq1[j] & 0xffffu) + S[8 + 2 * j + 1] * bf2f(cq1[j] >> 16); }
            y += __shfl_xor(y, 1); y += __shfl_xor(y, 2); y += __shfl_xor(y, 4);
            if (ns == 0 && row < ML) YS[((size_t)dir * ML + row) * 1024 + hd * 64 + p] = (bf16)f2bf(y);
            row = rown; dtr = dtr_n; xr = xr_n; bq0 = bn0; bq1 = bn1; cq0 = cn0; cq1 = cn1;
        }
    }
}

constexpr int SSD_XT = 0, SSD_XWT = 9216, SSD_BT = 18432, SSD_BN = 36864, SSD_CN = 54272, SSD_SBF = 71680, SSD_SM = SSD_SBF + 2 * 17408;
__device__ __forceinline__ void ssd_mfma_phase(Frame& F) {
    const bf16* XBC = (const bf16*)(F.ws + WS_XBC); const float* DT = (const float*)(F.ws + WS_DT); bf16* YS = (bf16*)(F.ws + WS_YS);
    const int lane = F.lane, w = F.wave, i = lane & 15, gq = lane >> 4;
    LAS unsigned char* L = F.lds;
    for (int item = blockIdx.x; item < NB * 16 * 2; item += F.G) {
        const int dir = item & 1, hd = (item >> 1) & 15, b = item >> 5, g = hd >> 2;
        const float dtb = F.in[I_SSDDTB][dir * 16 + hd], a = -expf(F.in[I_SSDALOG][dir * 16 + hd]);
        __syncthreads();
        for (int q = F.tid; q < 17408 / 4; q += 512) ((LAS unsigned*)(L + SSD_SBF))[q] = 0u;
        f32x4 accS[4];
#pragma unroll
        for (int pt = 0; pt < 4; ++pt) accS[pt] = (f32x4){0.f, 0.f, 0.f, 0.f};
        int rowt = s5_row(lane, dir, b);
        const bf16* rp = XBC + (size_t)rowt * XBC_LD;
        v4u xr = *(const v4u*)(rp + hd * 64 + 8 * w);
        v4u br0 = *(const v4u*)(rp + 1024 + g * 128 + 16 * w), br1 = *(const v4u*)(rp + 1024 + g * 128 + 16 * w + 8);
        v4u cr0 = *(const v4u*)(rp + 1536 + g * 128 + 16 * w), cr1 = *(const v4u*)(rp + 1536 + g * 128 + 16 * w + 8);
        float dtr = DT[(size_t)rowt * 32 + dir * 16 + hd];
        for (int k = 0; k < 36; ++k) {
            LAS float* sm = (LAS float*)(L + SSD_SM + (k & 1) * 1024);
            const float dt = softplus_f(dtr + dtb); float c = dt * a;
#pragma unroll
            for (int o = 1; o < 64; o <<= 1) { const float t = __shfl_up(c, o); if (lane >= o) c += t; }
            const float c63 = rdlane(c, 63), we = dt * __expf(c63 - c);
            if (w == 0) { sm[lane] = c; sm[64 + lane] = dt; if (lane == 0) sm[192] = __expf(c63); }
            __syncthreads();
#pragma unroll
            for (int j = 0; j < 4; ++j) { const float x0 = bf2f(xr[j] & 0xffffu), x1 = bf2f(xr[j] >> 16);
                *(LAS bf16*)(L + SSD_XT + (8 * w + 2 * j) * 144 + lane * 2) = (bf16)(xr[j] & 0xffffu); *(LAS bf16*)(L + SSD_XT + (8 * w + 2 * j + 1) * 144 + lane * 2) = (bf16)(xr[j] >> 16);
                *(LAS bf16*)(L + SSD_XWT + (8 * w + 2 * j) * 144 + lane * 2) = (bf16)f2bf(x0 * we); *(LAS bf16*)(L + SSD_XWT + (8 * w + 2 * j + 1) * 144 + lane * 2) = (bf16)f2bf(x1 * we); }
#pragma unroll
            for (int j = 0; j < 4; ++j) {
                *(LAS bf16*)(L + SSD_BT + (16 * w + 2 * j) * 144 + lane * 2) = (bf16)(br0[j] & 0xffffu); *(LAS bf16*)(L + SSD_BT + (16 * w + 2 * j + 1) * 144 + lane * 2) = (bf16)(br0[j] >> 16);
                *(LAS bf16*)(L + SSD_BT + (16 * w + 8 + 2 * j) * 144 + lane * 2) = (bf16)(br1[j] & 0xffffu); *(LAS bf16*)(L + SSD_BT + (16 * w + 8 + 2 * j + 1) * 144 + lane * 2) = (bf16)(br1[j] >> 16); }
            *(LAS v4u*)(L + SSD_BN + lane * 272 + 32 * w) = br0; *(LAS v4u*)(L + SSD_BN + lane * 272 + 32 * w + 16) = br1;
            *(LAS v4u*)(L + SSD_CN + lane * 272 + 32 * w) = cr0; *(LAS v4u*)(L + SSD_CN + lane * 272 + 32 * w + 16) = cr1;
            if (k + 1 < 36) { rowt = s5_row(64 * (k + 1) + lane, dir, b); rp = XBC + (size_t)rowt * XBC_LD;
                xr = *(const v4u*)(rp + hd * 64 + 8 * w);
                br0 = *(const v4u*)(rp + 1024 + g * 128 + 16 * w); br1 = *(const v4u*)(rp + 1024 + g * 128 + 16 * w + 8);
                cr0 = *(const v4u*)(rp + 1536 + g * 128 + 16 * w); cr1 = *(const v4u*)(rp + 1536 + g * 128 + 16 * w + 8);
                dtr = DT[(size_t)rowt * 32 + dir * 16 + hd]; }
            __syncthreads();
            const LAS unsigned char* Scur = L + SSD_SBF + (k & 1) * 17408; LAS unsigned char* Snxt = L + SSD_SBF + ((k + 1) & 1) * 17408;
            for (int rep_ = 0; rep_ < (REP_CODE == 2001 ? 2 : 1); ++rep_)
            if (k >= 4) {
                const int lt = w & 3, pt0 = 2 * (w >> 2), l = 16 * lt + i, rowl = s5_row(64 * k + l, dir, b);
                bf16x8v cf[4];
#pragma unroll
                for (int ks = 0; ks < 4; ++ks) cf[ks] = *(const LAS bf16x8v*)(L + SSD_CN + l * 272 + (32 * ks + 8 * gq) * 2);
                f32x4 acc[2];
#pragma unroll
                for (int pt = 0; pt < 2; ++pt) { acc[pt] = (f32x4){0.f, 0.f, 0.f, 0.f};
#pragma unroll
                    for (int ks = 0; ks < 4; ++ks) { const bf16x8v sf = *(const LAS bf16x8v*)(Scur + (16 * (pt0 + pt) + i) * 272 + (32 * ks + 8 * gq) * 2); acc[pt] = __builtin_amdgcn_mfma_f32_16x16x32_bf16(sf, cf[ks], acc[pt], 0, 0, 0); } }
                const float cl = sm[l], ecl = __expf(cl);
                acc[0] = acc[0] * ecl; acc[1] = acc[1] * ecl;
                const int npair = lt >= 2 ? 2 : 1;
                for (int pr = 0; pr < npair; ++pr) {
                    f32x4 cb[2];
#pragma unroll
                    for (int e = 0; e < 2; ++e) { const int srow = 32 * pr + 8 * (i >> 2) + 4 * e + (i & 3); cb[e] = (f32x4){0.f, 0.f, 0.f, 0.f};
#pragma unroll
                        for (int ks = 0; ks < 4; ++ks) { const bf16x8v bfr = *(const LAS bf16x8v*)(L + SSD_BN + srow * 272 + (32 * ks + 8 * gq) * 2); cb[e] = __builtin_amdgcn_mfma_f32_16x16x32_bf16(bfr, cf[ks], cb[e], 0, 0, 0); } }
                    const int s0 = 32 * pr + 8 * gq; float m[8];
                    const f32x4 c0 = *(const LAS f32x4*)(sm + s0), c1 = *(const LAS f32x4*)(sm + s0 + 4), d0 = *(const LAS f32x4*)(sm + 64 + s0), d1 = *(const LAS f32x4*)(sm + 64 + s0 + 4);
#pragma unroll
                    for (int j = 0; j < 4; ++j) { m[j] = (s0 + j <= l) ? cb[0][j] * d0[j] * __expf(cl - c0[j]) : 0.f; m[4 + j] = (s0 + 4 + j <= l) ? cb[1][j] * d1[j] * __expf(cl - c1[j]) : 0.f; }
                    const v4u mw = (v4u){pk2(m[0], m[1]), pk2(m[2], m[3]), pk2(m[4], m[5]), pk2(m[6], m[7])}; const bf16x8v mf = __builtin_bit_cast(bf16x8v, mw);
#pragma unroll
                    for (int pt = 0; pt < 2; ++pt) { const bf16x8v xf = *(const LAS bf16x8v*)(L + SSD_XT + (16 * (pt0 + pt) + i) * 144 + s0 * 2); acc[pt] = __builtin_amdgcn_mfma_f32_16x16x32_bf16(xf, mf, acc[pt], 0, 0, 0); }
                }
#pragma unroll
                for (int pt = 0; pt < 2; ++pt) { v2u o; o.x = pk2(acc[pt][0], acc[pt][1]); o.y = pk2(acc[pt][2], acc[pt][3]);
                    *(v2u*)(YS + ((size_t)dir * ML + rowl) * 1024 + hd * 64 + 16 * (pt0 + pt) + 4 * gq) = o; }
            }
            { const float dec = sm[192];
              bf16x8v bt[2];
#pragma unroll
              for (int ks = 0; ks < 2; ++ks) bt[ks] = *(const LAS bf16x8v*)(L + SSD_BT + (16 * w + i) * 144 + (32 * ks + 8 * gq) * 2);
#pragma unroll
              for (int pt = 0; pt < 4; ++pt) { accS[pt] = accS[pt] * dec;
#pragma unroll
                  for (int ks = 0; ks < 2; ++ks) { const bf16x8v xw = *(const LAS bf16x8v*)(L + SSD_XWT + (16 * pt + i) * 144 + (32 * ks + 8 * gq) * 2); accS[pt] = __builtin_amdgcn_mfma_f32_16x16x32_bf16(bt[ks], xw, accS[pt], 0, 0, 0); }
                  v2u o; o.x = pk2(accS[pt][0], accS[pt][1]); o.y = pk2(accS[pt][2], accS[pt][3]);
                  *(LAS v2u*)(Snxt + (16 * pt + i) * 272 + (16 * w + 4 * gq) * 2) = o; } }
        }
    }
    __syncthreads();
}

__device__ __forceinline__ void ssd_out_phase(Frame& F) {
    const bf16* XBC = (const bf16*)(F.ws + WS_XBC); const bf16* YS = (const bf16*)(F.ws + WS_YS); const bf16* P1 = (const bf16*)(F.ws + WS_BIG); bf16* MIX = (bf16*)(F.ws + WS_MIX);
    const float* dsk = F.in[I_SSDD]; const float* ng = F.in[I_SSDNG];
    for (int row = F.gw; row < ML; row += F.ngw) {
        float y[16]; float s = 0.f;
#pragma unroll
        for (int j = 0; j < 2; ++j) { const int c0 = 8 * F.lane + 512 * j;
            const v4u a0 = *(const v4u*)(YS + (size_t)row * 1024 + c0), a1 = *(const v4u*)(YS + ((size_t)ML + row) * 1024 + c0), xx = *(const v4u*)(XBC + (size_t)row * XBC_LD + c0), zz = *(const v4u*)(P1 + (size_t)row * ODD_LD + 3072 + c0);
            const float dk = dsk[c0 >> 6];
#pragma unroll
            for (int q = 0; q < 4; ++q) {
                const float v0 = (bf2f(a0[q] & 0xffffu) + bf2f(a1[q] & 0xffffu) + dk * bf2f(xx[q] & 0xffffu)) * silu_f(bf2f(zz[q] & 0xffffu));
                const float v1 = (bf2f(a0[q] >> 16) + bf2f(a1[q] >> 16) + dk * bf2f(xx[q] >> 16)) * silu_f(bf2f(zz[q] >> 16));
                y[8 * j + 2 * q] = v0; y[8 * j + 2 * q + 1] = v1; s += v0 * v0 + v1 * v1; } }
        const float rstd = 1.0f / sqrtf(wave_sum(s) * (1.0f / 1024.0f) + EPS);
#pragma unroll
        for (int j = 0; j < 2; ++j) { const int c0 = 8 * F.lane + 512 * j; unsigned o[4];
#pragma unroll
            for (int q = 0; q < 4; ++q) o[q] = pk2(y[8 * j + 2 * q] * rstd * ng[c0 + 2 * q], y[8 * j + 2 * q + 1] * rstd * ng[c0 + 2 * q + 1]);
            *(v4u*)(MIX + (size_t)row * DM + 1024 + c0) = (v4u){o[0], o[1], o[2], o[3]}; }
    }
}
__device__ __forceinline__ void hyena_prep_load(const bf16* P1, int item, int lane, v4u (&v)[9]) {
    const int tb = item & 31, b = (item >> 5) & 7, cbk = (item >> 8) & 15, part = item >> 12;
    const bf16* base = P1 + (size_t)(b * SEQ) * ODD_LD + part * 1024 + cbk * 64 + 8 * (lane & 7);
#pragma unroll
    for (int i = 0; i < 9; ++i) { const int tl = (lane >> 3) + 8 * i, t = tb * 64 - 1 + tl; v[i] = (v4u){0u, 0u, 0u, 0u}; if (tl < 66 && t >= 0 && t < SEQ) v[i] = *(const v4u*)(base + (size_t)t * ODD_LD); }
}
__device__ __forceinline__ void hyena_prep_phase(Frame& F) {
    const bf16* P1 = (const bf16*)(F.ws + WS_BIG); const float* sw = F.in[I_HYSW]; const float* sb = F.in[I_HYSB]; const int lane = F.lane;
    LAS unsigned* tile = (LAS unsigned*)(F.lds + F.wave * 16384);
    LAS float* wl = (LAS float*)(F.lds + F.wave * 16384 + 9216);
    constexpr int NI = 3 * 16 * NB * 32; v4u vn[9];
    if (F.gw < NI) hyena_prep_load(P1, F.gw, lane, vn);
    for (int item = F.gw; item < NI; item += F.ngw) {
        const int tb = item & 31, b = (item >> 5) & 7, cbk = (item >> 8) & 15, part = item >> 12;
        const int col0 = part * 1024 + cbk * 64, t0 = tb * 64;
        wl[lane] = sw[col0 + lane]; wl[64 + lane] = sw[3072 + col0 + lane]; wl[128 + lane] = sw[6144 + col0 + lane]; wl[192 + lane] = sb[col0 + lane];
#pragma unroll
        for (int i = 0; i < 9; ++i) { const int tl = (lane >> 3) + 8 * i;
            if (tl < 66) { LAS unsigned* tp = tile + tl * 33 + 4 * (lane & 7); tp[0] = vn[i].x; tp[1] = vn[i].y; tp[2] = vn[i].z; tp[3] = vn[i].w; } }
        if (item + F.ngw < NI) hyena_prep_load(P1, item + F.ngw, lane, vn);
        asm volatile("s_waitcnt lgkmcnt(0)" ::: "memory");
        bf16* dst = (bf16*)(F.ws + (part == 0 ? WS_X1C : part == 1 ? WS_X2C : WS_VC)) + ((size_t)(cbk * 64) * NB + b) * SEQ + t0 + lane;
#pragma unroll 4
        for (int cp = 0; cp < 32; ++cp) { const unsigned a = tile[lane * 33 + cp], m = tile[(lane + 1) * 33 + cp], n = tile[(lane + 2) * 33 + cp];
            const float y0 = wl[2 * cp] * bf2f(a & 0xffffu) + wl[64 + 2 * cp] * bf2f(m & 0xffffu) + wl[128 + 2 * cp] * bf2f(n & 0xffffu) + wl[192 + 2 * cp];
            const float y1 = wl[2 * cp + 1] * bf2f(a >> 16) + wl[64 + 2 * cp + 1] * bf2f(m >> 16) + wl[128 + 2 * cp + 1] * bf2f(n >> 16) + wl[192 + 2 * cp + 1];
            dst[(size_t)(2 * cp) * NB * SEQ] = (bf16)f2bf(y0); dst[(size_t)(2 * cp + 1) * NB * SEQ] = (bf16)f2bf(y1); }
        asm volatile("s_waitcnt lgkmcnt(0)" ::: "memory");
    }
}
__device__ __forceinline__ void hyena_conv_phase(Frame& F, int order) {
    LAS float* kf = (LAS float*)F.lds; LAS float* ub = kf + 4096;
    const float* FILT = (const float*)(F.ws + WS_FILT); const bf16* U = (const bf16*)(F.ws + (order == 0 ? WS_VC : WS_ZC)); const bf16* GT = (const bf16*)(F.ws + (order == 0 ? WS_X1C : WS_X2C));
    bf16* ZC = (bf16*)(F.ws + WS_ZC); bf16* MIX = (bf16*)(F.ws + WS_MIX);
    for (int c = blockIdx.x; c < 1024; c += F.G) {
        __syncthreads();
        for (int i = F.tid; i < 4096; i += 512) kf[i] = i < 4095 ? FILT[(size_t)(order * 1024 + c) * 4096 + i] : 0.f;
        for (int i = F.tid; i < NB * SEQ; i += 512) ub[i] = bf2f(U[(size_t)c * NB * SEQ + i]);
        __syncthreads();
        float acc[4][8];
#pragma unroll
        for (int i = 0; i < 4; ++i)
#pragma unroll
            for (int b = 0; b < 8; ++b) acc[i][b] = 0.f;
        const LAS float* kp = kf + F.tid + 2047;
#pragma unroll 2
        for (int s = 0; s < SEQ; ++s) {
            float u8[8];
#pragma unroll
            for (int b = 0; b < 8; ++b) u8[b] = ub[b * SEQ + s];
#pragma unroll
            for (int i = 0; i < 4; ++i) { const float kv = kp[512 * i - s];
#pragma unroll
                for (int b = 0; b < 8; ++b) acc[i][b] += kv * u8[b]; } }
        const float fb = F.in[I_HYFBIAS][order * 1024 + c];
#pragma unroll
        for (int i = 0; i < 4; ++i) { const int t = F.tid + 512 * i;
#pragma unroll
            for (int b = 0; b < 8; ++b) { const float gt = bf2f(GT[((size_t)c * NB + b) * SEQ + t]); const float v = gt * (acc[i][b] + ub[b * SEQ + t] * fb);
                if (order == 0) ZC[((size_t)c * NB + b) * SEQ + t] = (bf16)f2bf(v); else MIX[((size_t)b * SEQ + t) * DM + c] = (bf16)f2bf(v); } }
    }
    __syncthreads();
}

constexpr int HY_CPY = 16384, HY_CPYS = 8224, HY_UB = HY_CPY + 8 * HY_CPYS, HY_UBS = 4112;
__device__ __forceinline__ void hyena_mfma_phase(Frame& F, int order) {
    LAS unsigned char* L = F.lds; LAS float* kf = (LAS float*)L;
    const float* FILT = (const float*)(F.ws + WS_FILT); const bf16* U = (const bf16*)(F.ws + (order == 0 ? WS_VC : WS_ZC)); const bf16* GT = (const bf16*)(F.ws + (order == 0 ? WS_X1C : WS_X2C));
    bf16* OUT = (bf16*)(F.ws + (order == 0 ? WS_ZC : WS_X1C));
    const int lane = F.lane, w = F.wave, i = lane & 15, gq = lane >> 4, tid = F.tid;
    f32x4 kfr[2]; v4u ubr[4];
    int c = blockIdx.x;
    if (c < 1024) {
#pragma unroll
        for (int q = 0; q < 2; ++q) kfr[q] = *(const f32x4*)(FILT + (size_t)(order * 1024 + c) * 4096 + 4 * (tid + 512 * q));
#pragma unroll
        for (int q = 0; q < 4; ++q) { const int qq = tid + 512 * q; ubr[q] = *(const v4u*)(U + ((size_t)c * NB + (qq >> 8)) * SEQ + (qq & 255) * 8); } }
    for (; c < 1024; c += F.G) {
        __syncthreads();
#pragma unroll
        for (int q = 0; q < 2; ++q) { f32x4 v = kfr[q]; if (tid + 512 * q == 1023) v.w = 0.f; *(LAS f32x4*)(kf + 4 * (tid + 512 * q)) = v; }
#pragma unroll
        for (int q = 0; q < 4; ++q) { const int qq = tid + 512 * q; *(LAS v4u*)(L + HY_UB + (qq >> 8) * HY_UBS + (qq & 255) * 16) = ubr[q]; }
        { const int cn = c + F.G; if (cn < 1024) {
#pragma unroll
            for (int q = 0; q < 2; ++q) kfr[q] = *(const f32x4*)(FILT + (size_t)(order * 1024 + cn) * 4096 + 4 * (tid + 512 * q));
#pragma unroll
            for (int q = 0; q < 4; ++q) { const int qq = tid + 512 * q; ubr[q] = *(const v4u*)(U + ((size_t)cn * NB + (qq >> 8)) * SEQ + (qq & 255) * 8); } } }
        __syncthreads();
        for (int rep2_ = 0; rep2_ < (REP_CODE == 2012 ? 2 : 1); ++rep2_)
        for (int q = tid; q < 8 * 512; q += 512) { const int a = q >> 9, y8 = q & 511; unsigned o[4];
#pragma unroll
            for (int j = 0; j < 4; ++j) { const int x0 = 8 * y8 + a + 2 * j, x1 = x0 + 1; const float v0 = x0 <= 4094 ? kf[4094 - x0] : 0.f, v1 = x1 <= 4094 ? kf[4094 - x1] : 0.f; o[j] = pk2(v0, v1); }
            *(LAS v4u*)(L + HY_CPY + a * HY_CPYS + y8 * 16) = (v4u){o[0], o[1], o[2], o[3]}; }
        __syncthreads();
        v2u gg[16];
        if (i < 8) {
#pragma unroll
            for (int j = 0; j < 16; ++j) gg[j] = *(const v2u*)(GT + ((size_t)c * NB + i) * SEQ + 256 * w + 16 * j + 4 * gq); }
        f32x4 acc[16];
        for (int rep_ = 0; rep_ < (REP_CODE == 2011 ? 2 : 1); ++rep_) {
#pragma unroll
        for (int j = 0; j < 16; ++j) { acc[j] = (f32x4){0.f, 0.f, 0.f, 0.f}; asm volatile("" : "+v"(acc[j])); }
        const int a = (7 - i) & 7, ybase = 2040 + 8 * gq - 8 * (i >> 3) - 256 * w;
        const LAS unsigned char* ap = L + HY_CPY + a * HY_CPYS + 2 * ybase;
        const LAS unsigned char* bp = L + HY_UB + (i & 7) * HY_UBS + 16 * gq;
        bf16x8v fr[16];
#pragma unroll
        for (int dd = 0; dd < 16; ++dd) fr[(dd + 1) & 15] = *(const LAS bf16x8v*)(ap + 32 * (dd - 15));
        for (int ks0 = 0; ks0 < 64; ks0 += 8) {
#pragma unroll
            for (int kk = 0; kk < 8; ++kk) { const int ks = ks0 + kk;
                fr[(2 * kk + 15) & 15] = *(const LAS bf16x8v*)(ap + 32 * (2 * ks - 1)); fr[(2 * kk) & 15] = *(const LAS bf16x8v*)(ap + 32 * (2 * ks));
                const bf16x8v bfr = *(const LAS bf16x8v*)(bp + 64 * ks);
#pragma unroll
                for (int j = 0; j < 16; ++j) acc[j] = __builtin_amdgcn_mfma_f32_16x16x32_bf16(fr[(2 * kk - j + 16) & 15], bfr, acc[j], 0, 0, 0); }
        }
        }
        for (int rep3_ = 0; rep3_ < (REP_CODE == 2013 ? 2 : 1); ++rep3_)
        if (i < 8) { const float fb = F.in[I_HYFBIAS][order * 1024 + c];
#pragma unroll
            for (int j = 0; j < 16; ++j) { const int t = 256 * w + 16 * j + 4 * gq; const v2u uu = *(const LAS v2u*)(L + HY_UB + i * HY_UBS + 2 * t);
                const float o0 = bf2f(gg[j].x & 0xffffu) * (acc[j][0] + bf2f(uu.x & 0xffffu) * fb), o1 = bf2f(gg[j].x >> 16) * (acc[j][1] + bf2f(uu.x >> 16) * fb);
                const float o2 = bf2f(gg[j].y & 0xffffu) * (acc[j][2] + bf2f(uu.y & 0xffffu) * fb), o3 = bf2f(gg[j].y >> 16) * (acc[j][3] + bf2f(uu.y >> 16) * fb);
                *(v2u*)(OUT + ((size_t)c * NB + i) * SEQ + t) = (v2u){pk2(o0, o1), pk2(o2, o3)}; } }
    }
    __syncthreads();
}
__device__ __forceinline__ void hyena_untranspose_phase(Frame& F) {
    const bf16* YC = (const bf16*)(F.ws + WS_X1C); bf16* MIX = (bf16*)(F.ws + WS_MIX); const int lane = F.lane;
    LAS float* tile = (LAS float*)(F.lds + F.wave * 16640);
    for (int item = F.gw; item < 16 * NB * 32; item += F.ngw) {
        const int tb = item & 31, b = (item >> 5) & 7, cbk = item >> 8;
        const bf16* src = YC + ((size_t)(cbk * 64) * NB + b) * SEQ + tb * 64 + lane;
        for (int cc = 0; cc < 64; ++cc) tile[cc * 65 + lane] = bf2f(src[(size_t)cc * NB * SEQ]);
        asm volatile("s_waitcnt lgkmcnt(0)" ::: "memory");
        bf16* dst = MIX + (size_t)(b * SEQ + tb * 64) * DM + cbk * 64 + lane;
        for (int tl = 0; tl < 64; ++tl) dst[(size_t)tl * DM] = (bf16)f2bf(tile[lane * 65 + tl]);
        asm volatile("s_waitcnt lgkmcnt(0)" ::: "memory");
    }
}

__device__ __forceinline__ void dt_exact_phase(Frame& F) {
    const float* XSp = (const float*)(F.ws + WS_XS); const float* g = F.in[I_NORMG] + (1 * 3 + 1) * DM; const float* MV = (const float*)(F.ws + WS_MODV) + (size_t)1 * 9 * NMODC; float* DT = (float*)(F.ws + WS_DT);
    const float* W = F.in[I_ODWIN];
    for (int row = F.gw; row < MT; row += F.ngw) {
        const float* xr = XSp + (size_t)row * DM; const int r = row < ML ? row / SEQ : 8;
        const float* sh = MV + (size_t)r * NMODC + 3 * DM; const float* sc = sh + DM;
        f32x4 v[8]; float s = 0.f;
#pragma unroll
        for (int j = 0; j < 8; ++j) { if (row < ML) { const v2u q = *(const v2u*)((const bf16*)(F.ws + WS_XS) + (size_t)row * DM + 4 * (F.lane + 64 * j)); v[j] = (f32x4){bf2f(q.x & 0xffffu), bf2f(q.x >> 16), bf2f(q.y & 0xffffu), bf2f(q.y >> 16)}; } else v[j] = *(const f32x4*)(xr + 4 * (F.lane + 64 * j));
            s += (v[j].x * v[j].x + v[j].y * v[j].y) + (v[j].z * v[j].z + v[j].w * v[j].w); }
        const float rstd = 1.0f / sqrtf(wave_sum(s) * (1.0f / DM) + EPS);
#pragma unroll
        for (int j = 0; j < 8; ++j) { const int c = 4 * (F.lane + 64 * j); const f32x4 gg = *(const f32x4*)(g + c), ss = *(const f32x4*)(sc + c), hh = *(const f32x4*)(sh + c); v[j] = (v[j] * rstd * gg) * (ss + 1.0f) + hh; }
        for (int o = 0; o < 32; ++o) { float a = 0.f;
#pragma unroll
            for (int j = 0; j < 8; ++j) { const int c = 4 * (F.lane + 64 * j); a += v[j].x * W[(size_t)c * ODD_IN + 6144 + o] + v[j].y * W[(size_t)(c + 1) * ODD_IN + 6144 + o] + v[j].z * W[(size_t)(c + 2) * ODD_IN + 6144 + o] + v[j].w * W[(size_t)(c + 3) * ODD_IN + 6144 + o]; }
            a = wave_sum(a); if (F.lane == 0) DT[(size_t)row * 32 + o] = a; }
    }
}
#define XB_TMO      128
#define XB_XCNT(j)  (256  + 64 * (j))
#define XB_XSUB(j)  (1280 + 64 * (j))
#define XB_XGEN(j)  (2304 + 64 * (j))
#define XB_TOP      3328
#define XB_TOPGEN   3392
#define XCD_BAR_WORDS 3456
#define XB_SPIN_CAP (1u << 18)

__device__ __forceinline__ unsigned xb_ld(unsigned* p)              { return __hip_atomic_load(p, __ATOMIC_RELAXED, __HIP_MEMORY_SCOPE_AGENT); }
__device__ __forceinline__ unsigned xb_add(unsigned* p, unsigned v) { return __hip_atomic_fetch_add(p, v, __ATOMIC_RELAXED, __HIP_MEMORY_SCOPE_AGENT); }
__device__ __forceinline__ unsigned xb_xcc_id() { return (unsigned)__builtin_amdgcn_s_getreg((3 << 11) | 20) & 0xFu; }
#define XB_SPIN(cond, bar) do { unsigned _sp = 0; while (cond) { __builtin_amdgcn_s_sleep(1); \
    if ((++_sp & 255u) == 0u) { if (xb_ld(&(bar)[XB_TMO])) break; if (_sp > XB_SPIN_CAP) { atomicAdd(&(bar)[XB_TMO], 1u); break; } } } } while (0)

struct XcdBarrier {
    unsigned* bar; unsigned x;
    volatile LAS unsigned* st;
};

__device__ __forceinline__ XcdBarrier xcd_barrier_post(unsigned* bar, volatile LAS unsigned* st) {
    XcdBarrier b; b.bar = bar; b.x = xb_xcc_id(); b.st = st;
    if (threadIdx.x == 0) (void)xb_add(&bar[XB_XCNT(b.x)], 1u);
    return b;
}
__device__ __forceinline__ void xcd_barrier_complete(unsigned* bar, unsigned x, unsigned& nloc, unsigned& nx) {
    const unsigned G = gridDim.x * gridDim.y * gridDim.z;
    unsigned sum, cnt, mine, sp = 0u;
    for (;;) {
        sum = 0u; cnt = 0u; mine = 0u;
#pragma unroll
        for (unsigned j = 0; j < 16; ++j) { const unsigned c = xb_ld(&bar[XB_XCNT(j)]); sum += c; cnt += (c > 0u) ? 1u : 0u; mine = (j == x) ? c : mine; }
        if (sum == G) break;
        __builtin_amdgcn_s_sleep(1);
        if ((++sp & 255u) == 0u) { if (xb_ld(&bar[XB_TMO])) break; if (sp > XB_SPIN_CAP) { atomicAdd(&bar[XB_TMO], 1u); break; } }
    }
    nloc = mine > 0u ? mine : 1u; nx = cnt > 0u ? cnt : 1u;
}

__device__ __forceinline__ void xcd_barrier(const XcdBarrier& b) {
    asm volatile("s_waitcnt vmcnt(0)" ::: "memory");
    __syncthreads();
    if (threadIdx.x == 0) {
        unsigned* bar = b.bar;
        __builtin_amdgcn_s_waitcnt(0);
        unsigned nloc = b.st[0], nx = b.st[1];
        if (nloc == 0u) { xcd_barrier_complete(bar, b.x, nloc, nx); b.st[0] = nloc; b.st[1] = nx; }
        const unsigned old = xb_add(&bar[XB_XSUB(b.x)], 1u);
        const unsigned gen = old / nloc;
        if (old + 1u == (gen + 1u) * nloc) {
            __builtin_amdgcn_fence(__ATOMIC_RELEASE, "agent");
            asm volatile("s_waitcnt vmcnt(0)" ::: "memory");
            const unsigned og = xb_add(&bar[XB_TOP], 1u);
            const unsigned tg = og / nx;
            if (og + 1u == (tg + 1u) * nx) xb_add(&bar[XB_TOPGEN], 1u);
            else XB_SPIN(xb_ld(&bar[XB_TOPGEN]) == tg, bar);
            __builtin_amdgcn_fence(__ATOMIC_ACQUIRE, "agent");
            xb_add(&bar[XB_XGEN(b.x)], 1u);
            asm volatile("s_waitcnt vmcnt(0)" ::: "memory");
        } else {
            XB_SPIN(xb_ld(&bar[XB_XGEN(b.x)]) == gen, bar);
            __builtin_amdgcn_fence(__ATOMIC_ACQUIRE, "agent");
            asm volatile("s_waitcnt vmcnt(0)" ::: "memory");
        }
    }
    __syncthreads();
}

#ifndef MK_ONE_LAUNCH
#define MK_ONE_LAUNCH 1
#endif
#ifndef RUN_MASK
#define RUN_MASK 0xFFFFFFFFu
#endif
constexpr int NPH = 29;
#if DEFER_Q && (!I8_EV || I8_OD || !GU_ONEPASS)
#error "DEFER_Q needs the int8 even / bf16 odd in-projection phase variants (the tail sites live there)"
#endif
#define REPS(code) (((code) == REP_CODE) ? 2 : 1)
#define REPEAT(code, ...) do { for (int _r = 0; _r < REPS(code); ++_r) { __VA_ARGS__; if (_r + 1 < REPS(code)) __syncthreads(); } } while (0)
__global__ void __launch_bounds__(NWAVES * 64, 2) mega_fwd(Args args) {
    extern __shared__ __attribute__((aligned(16))) unsigned char lds_raw[];
    Frame F;
    F.lds = (LAS unsigned char*)lds_raw; F.in = args.in; F.out = args.out; F.ws = args.ws;
    F.tid = threadIdx.x; F.lane = F.tid & 63; F.wave = __builtin_amdgcn_readfirstlane(F.tid >> 6); F.G = gridDim.x;
    F.gw = blockIdx.x * NWAVES + F.wave; F.ngw = F.G * NWAVES;
    volatile LAS unsigned* MISC = (volatile LAS unsigned*)(F.lds + MISC_OFF);
    for (int u = F.tid; u < (LDS_BYTES - LDSCTL_OFF) / 4; u += NWAVES * 64) ((LAS unsigned*)(F.lds + LDSCTL_OFF))[u] = 0u;
    __syncthreads();
    unsigned* ctl = (unsigned*)(args.ws + WS_CTL);
    if (F.tid == 0) { const unsigned x = xb_xcc_id() & 7u; MISC[16] = x; MISC[17] = __hip_atomic_fetch_add(ctl + CW_XRANK + 64 * x, 1u, __ATOMIC_RELAXED, __HIP_MEMORY_SCOPE_AGENT); }
    __syncthreads();
    F.xcd = __builtin_amdgcn_readfirstlane((int)MISC[16]); F.xrank = __builtin_amdgcn_readfirstlane((int)MISC[17]);
    XcdBarrier bar; bar.bar = ctl + CW_BAR; bar.x = 0; bar.st = nullptr;
    const int lo = args.ph_lo, hi = args.ph_hi;
    if (hi - lo > 1) bar = xcd_barrier_post(ctl + CW_BAR, MISC + 8);
#define IN(k) (lo <= (k) && (k) < hi)
#define SEAM(k) do { if ((k) + 1 < hi) { xcd_barrier(bar); if (REP_CODE == 9999) xcd_barrier(bar); } } while (0)
    unsigned char* ws = args.ws;
    bf16* H = (bf16*)(ws + WS_H); bf16* BIG = (bf16*)(ws + WS_BIG); bf16* MIX = (bf16*)(ws + WS_MIX); float* XS = (float*)(ws + WS_XS);
    const float* MV0 = (const float*)(ws + WS_MODV); const float* MV1 = MV0 + (size_t)9 * NMODC;
    LAS unsigned char* ring = F.lds; bf16* XS16 = (bf16*)(ws + WS_XS);

#define GEMM_GATEUP(lab, Mrows) do { pg8::Gemm g{H, (const bf16*)(ws + WS_WGU + (size_t)(lab) * SZ_WGU8), (Mrows), 2 * DFF, DM / 2}; pg8::StaticOrder S; S.init((Mrows), 2 * DFF, F.G, (int)blockIdx.x); \
        pg8::EpiSwigluI8 E{BIG, DFF, (const float*)(ws + WS_RS), (const float*)(ws + WS_CS) + (size_t)(lab) * 2 * DFF}; pg8::gemm_phase<pg8::EpiSwigluI8, pg8::StaticOrder, true, true, true>(ring, g, S, E); } while (0)
#if F8_DOWN
#define GEMM_DOWN(lab, Mrows, bL, bC, mv, gi, sc) do { pg8::Gemm g{BIG, (const bf16*)(ws + WS_WD + (size_t)(lab) * SZ_WD), ML, DM, DFF / 2}; pg8::StaticOrder S; S.init(ML, DM, F.G, (int)blockIdx.x); \
        pg8::EpiResid16 E{(lab) == 0 ? (bL) : nullptr, (lab) == 0 ? nullptr : XS16, (bC), XS16, XS, (mv), (gi), (sc) * (1.0f / 8192.0f)}; pg8::gemm_phase<pg8::EpiResid16, pg8::StaticOrder, true, true, false, true>(ring, g, S, E); \
        if ((Mrows) > ML) { __syncthreads(); pg8::Gemm g2{BIG, (const bf16*)(ws + WS_WD + (size_t)(lab) * SZ_WD), MT, DM, DFF / 4, DFF / 2, DFF / 2}; pg8::SplitCtxOrder S2{F.G, (int)blockIdx.x, 2}; \
            pg8::EpiResidPart E2{(float*)(ws + WS_PART), (mv), (gi), (sc) * (1.0f / 8192.0f)}; pg8::gemm_phase<pg8::EpiResidPart, pg8::SplitCtxOrder, true, true, false, true>(ring, g2, S2, E2); } } while (0)
#else
#define GEMM_DOWN(lab, Mrows, bL, bC, mv, gi, sc) do { const int m1_ = SPLIT_CTX ? ML : (Mrows); pg8::Gemm g{BIG, (const bf16*)(ws + WS_WD + (size_t)(lab) * SZ_WD), m1_, DM, DFF}; pg8::StaticOrder S; S.init(m1_, DM, F.G, (int)blockIdx.x); \
        pg8::EpiResid E{(bL), (bC), XS, (mv), (gi), (sc)}; pg8::gemm_phase<pg8::EpiResid, pg8::StaticOrder, true, true>(ring, g, S, E); \
        if (SPLIT_CTX && (Mrows) > ML) { __syncthreads(); pg8::Gemm g2{BIG, (const bf16*)(ws + WS_WD + (size_t)(lab) * SZ_WD), MT, DM, DFF / 4, DFF, (DFF / 4) * 2}; pg8::SplitCtxOrder S2{F.G, (int)blockIdx.x, 4}; \
            pg8::EpiResidPart E2{(float*)(ws + WS_PART), (mv), (gi), (sc)}; pg8::gemm_phase<pg8::EpiResidPart, pg8::SplitCtxOrder, true, true>(ring, g2, S2, E2); } } while (0)
#endif

#ifdef ONLY_PH
#define PH(k, ...) if ((k) == ONLY_PH && lo <= (k) && (k) < hi) { __VA_ARGS__; SEAM(k); }
#else
#define PH(k, ...) if (lo <= (k) && (k) < hi) { __VA_ARGS__; SEAM(k); }
#endif
    PH(0, { if ((F.wave & 1) == 0) { p0_prologue(F, 0); p0_prologue(F, 1); s5_prep_items(F); } else { p0_prologue(F, 1); s5_prep_items(F); p0_prologue(F, 0); } })
    PH(1, { p1_modred(F); REPEAT(1006, p1_filter_proj(F)); REPEAT(1005, p1_quant_weights(F)); if (GU_ONEPASS) p1_quant_gateup(F, 0, DEFER_Q ? 352 : 8 * 176, (int)blockIdx.x, F.G); })
    PH(2, REPEAT(2, prenorm8_phase(F, F.in[I_X], F.in[I_CTX], MT, 0, 0, true)))
    PH(3, { REPEAT(3, GEMM_GATEUP(0, MT)); if (DEFER_Q) tail_quant(F, 3168 % F.G, F.G, 0, 160); })
    PH(4, GEMM_DOWN(0, MT, F.in[I_X], F.in[I_CTX], MV0, 2, 0.5f))
#if I8_EV
    PH(5, prenorm8_phase(F, XS, XS + (size_t)ML * DM, MT, 0, 1, false, SPLIT_CTX, XS16))
#else
    PH(5, prenorm_phase(F, XS, XS + (size_t)ML * DM, MT, 0, 1, SPLIT_CTX, XS16))
#endif
#if I8_EV
    PH(6, { { pg8::Gemm g{H, (const bf16*)(ws + WS_WEVIN), MT, 3072, DM / 2}; pg8::StaticOrder S; S.init(MT, 3072, F.G, (int)blockIdx.x);
              pg8::EpiPlainI8 E{BIG, EVEN_LD, nullptr, (const float*)(ws + WS_RS), (const float*)(ws + WS_CS2)}; pg8::gemm_phase<pg8::EpiPlainI8, pg8::StaticOrder, true, true, true>(ring, g, S, E); }
            { pg8::Gemm g{(const bf16*)(ws + WS_WEVIN + (size_t)3072 * DM), H, 1024, MT, DM / 2}; pg8::StaticOrder S; S.init(1024, MT, F.G, F.G - 1 - (int)blockIdx.x);
              pg8::EpiVT8 E{(bf16*)(ws + WS_VT), (const float*)(ws + WS_RS), (const float*)(ws + WS_CS2) + 3072}; pg8::gemm_phase<pg8::EpiVT8, pg8::StaticOrder, true, true, true>(ring, g, S, E); }
            if (DEFER_Q) tail_quant(F, 864 % F.G, F.G - 288 % F.G, 160, 288); })
#else
    PH(6, { pg8::Gemm g{H, (const bf16*)(ws + WS_WEVIN), MT, EVEN_IN, DM}; pg8::StaticOrder S; S.init(MT, EVEN_IN, F.G, (int)blockIdx.x);
            pg8::EpiPlain E{BIG, EVEN_LD, nullptr}; pg8::gemm_phase<pg8::EpiPlain, pg8::StaticOrder, true, true>(ring, g, S, E); })
#endif
    PH(7, { REPEAT(70, s5_statein_phase(F)); if (!I8_EV) vt_transpose_phase(F); })
    PH(8, { s5_chain_phase(F); REPEAT(81, na_mfma_phase(F)); })
    PH(9, REPEAT(9, s5_out_phase(F)))
    PH(10, { pg8::Gemm g{(const bf16*)(ws + WS_G), (const bf16*)(ws + WS_WGLU), MT, 1024, 1024}; pg8::StaticOrder S; S.init(MT, 1024, F.G, (int)blockIdx.x);
            pg8::EpiGlu E{(const bf16*)(ws + WS_G), F.in[I_GLUB], MIX}; pg8::gemm_phase<pg8::EpiGlu, pg8::StaticOrder, true, true>(ring, g, S, E); if (DEFER_Q) tail_quant(F, 288 % F.G, F.G, 288, 512); })
    PH(11, { pg8::Gemm g{MIX, (const bf16*)(ws + WS_WEVOUT), MT, DM, DM}; pg8::StaticOrder S; S.init(MT, DM, F.G, (int)blockIdx.x);
            pg8::EpiResid16 E{nullptr, XS16, XS + (size_t)ML * DM, XS16, XS, MV0, 5, 1.0f}; pg8::gemm_phase<pg8::EpiResid16, pg8::StaticOrder, true, true>(ring, g, S, E); if (DEFER_Q) tail_quant(F, 576 % F.G, F.G, 512, 704); })
    PH(12, prenorm8_phase(F, XS, XS + (size_t)ML * DM, MT, 0, 2, false, 0, XS16))
    PH(13, { GEMM_GATEUP(1, MT); if (DEFER_Q) tail_quant(F, 3168 % F.G, F.G, 704, 864); })
    PH(14, GEMM_DOWN(1, MT, XS, XS + (size_t)ML * DM, MV0, 8, 0.5f))
    PH(15, prenorm8_phase(F, XS, XS + (size_t)ML * DM, MT, 1, 0, false, SPLIT_CTX, XS16))
    PH(16, { GEMM_GATEUP(2, MT); if (DEFER_Q) tail_quant(F, 3168 % F.G, F.G, 864, 1024); })
    PH(17, GEMM_DOWN(2, MT, XS, XS + (size_t)ML * DM, MV1, 2, 0.5f))
#if I8_OD
    PH(18, prenorm8_phase(F, XS, XS + (size_t)ML * DM, MT, 1, 1, false, SPLIT_CTX, XS16))
#else
    PH(18, prenorm_phase(F, XS, XS + (size_t)ML * DM, MT, 1, 1, SPLIT_CTX, XS16))
#endif
#if I8_OD
    PH(19, { pg8::Gemm g{H, (const bf16*)(ws + WS_WODIN), MT, ODD_INP, DM / 2}; pg8::OddInOrder S; S.init(F.G, (int)blockIdx.x);
            pg8::EpiPlainI8 E{BIG, ODD_LD, (float*)(ws + WS_DT), (const float*)(ws + WS_RS), (const float*)(ws + WS_CS2) + EVEN_IN}; pg8::gemm_phase<pg8::EpiPlainI8, pg8::OddInOrder, true, true, true>(ring, g, S, E); })
#else
    PH(19, { pg8::Gemm g{H, (const bf16*)(ws + WS_WODIN), MT, ODD_INP, DM}; pg8::OddInOrder S; S.init(F.G, (int)blockIdx.x);
            pg8::EpiPlain E{BIG, ODD_LD, (float*)(ws + WS_DT)}; pg8::gemm_phase<pg8::EpiPlain, pg8::OddInOrder, true, true>(ring, g, S, E); if (DEFER_Q) tail_quant(F, 1672 % F.G, F.G, 1024, 1056); })
#endif
#ifdef DT_EXACT_PROBE
    PH(20, { dt_exact_phase(F); REPEAT(190, hyena_prep_phase(F)); REPEAT(191, ssd_prep_phase(F)); })
#else
    PH(20, { REPEAT(190, hyena_prep_phase(F)); REPEAT(191, ssd_prep_phase(F)); })
#endif
    PH(21, { REPEAT(200, ssd_mfma_phase(F)); REPEAT(201, hyena_mfma_phase(F, 0)); })
    PH(22, { REPEAT(210, hyena_mfma_phase(F, 1)); REPEAT(211, ssd_out_phase(F)); })
    PH(23, hyena_untranspose_phase(F))
    PH(24, { pg8::Gemm g{MIX, (const bf16*)(ws + WS_WODOUT), ML, DM, DM}; pg8::StaticOrder S; S.init(ML, DM, F.G, (int)blockIdx.x);
            pg8::EpiResid16 E{nullptr, XS16, XS + (size_t)ML * DM, XS16, XS, MV1, 5, 1.0f}; pg8::gemm_phase<pg8::EpiResid16, pg8::StaticOrder, true, true>(ring, g, S, E); })
    PH(25, prenorm8_phase(F, XS, XS + (size_t)ML * DM, ML, 1, 2, false, 0, XS16))
    PH(26, REPEAT(24, GEMM_GATEUP(3, ML)))
    PH(27, GEMM_DOWN(3, ML, XS, XS + (size_t)ML * DM, MV1, 8, 0.5f))
    PH(28, final_norm_phase(F))
#undef PH
#undef IN
#undef SEAM
}

extern "C" void kernel_launch(void* const* d_in, const int* in_sizes, int n_in, void* d_out, int out_size, void* d_ws, size_t ws_size, hipStream_t stream) {
    static int grid = 0;
    if (grid == 0) {
        if (n_in != N_IN || out_size != ML * DM || ws_size < WS_END) { fprintf(stderr, "kernel_launch: unexpected shapes: n_in %d out %d ws %zu (need %zu)\n", n_in, out_size, ws_size, (size_t)WS_END); grid = -1; return; }
        int dev = 0, cus = 0, per_cu = 0;
        if (hipGetDevice(&dev) != hipSuccess || hipDeviceGetAttribute(&cus, hipDeviceAttributeMultiprocessorCount, dev) != hipSuccess) { grid = -1; return; }
        if (hipFuncSetAttribute((const void*)mega_fwd, hipFuncAttributeMaxDynamicSharedMemorySize, LDS_BYTES) != hipSuccess) { fprintf(stderr, "kernel_launch: hipFuncSetAttribute failed\n"); grid = -1; return; }
        if (hipOccupancyMaxActiveBlocksPerMultiprocessor(&per_cu, (const void*)mega_fwd, NWAVES * 64, LDS_BYTES) != hipSuccess || per_cu < 1) fprintf(stderr, "kernel_launch: occupancy query reports %d\n", per_cu);
        (void)hipGetLastError();
        grid = cus;
    }
    if (grid < 0) return;
    (void)in_sizes;
    if (hipMemsetAsync((char*)d_ws + WS_CTL, 0, CTL_ZERO_BYTES, stream) != hipSuccess) return;
    Args a{};
    for (int i = 0; i < N_IN; ++i) a.in[i] = (const float*)d_in[i];
    a.out = (float*)d_out; a.ws = (unsigned char*)d_ws;
#if MK_ONE_LAUNCH
    a.ph_lo = 0; a.ph_hi = NPH;
    hipLaunchKernelGGL(mega_fwd, dim3(grid), dim3(NWAVES * 64), LDS_BYTES, stream, a);
#else
    for (int p = 0; p < NPH; ++p) { a.ph_lo = p; a.ph_hi = p + 1; hipLaunchKernelGGL(mega_fwd, dim3(grid), dim3(NWAVES * 64), LDS_BYTES, stream, a); }
#endif
}
```
